# Optimizing an MI355X kernel written in HIP

```python
import jax
import jax.numpy as jnp
from jax import lax
import numpy as np

D_MODEL = 1024
BATCH = 32
SEQ = 256
DEPTH = 2
DEC_BATCH = 4
DEC_SEQ = 4096
PAST_LEN = 512

GRID_W = 64
EPS = 1e-6
D_CONV = 512
CONV_K = 31
NA_HEADS = 8
HEAD_DIM = 64
D_ATT = NA_HEADS * HEAD_DIM
NA_ROWS = 8
NA_COLS = 16
NA_QCB = 16
NA_KCB = NA_QCB + NA_COLS
ATT_SCALE = HEAD_DIM ** -0.5
Q_BLOCK = 128
D_IN_EVEN = 3 * D_CONV + 4 * D_ATT
SPLITS_EVEN = (D_CONV, 2 * D_CONV, 3 * D_CONV, 3 * D_CONV + D_ATT, 3 * D_CONV + 2 * D_ATT, 3 * D_CONV + 3 * D_ATT)
D_POOL = D_MODEL
POOL_WINDOWS = (2, 4, 8, 16)
POOL_GROUPS = 4
POOL_GD = D_POOL // POOL_GROUPS

kernel_name = 'hybrid_conv_natten_pool_diffusion_step'


def rms_norm(x, g):
    xf = x.astype(jnp.float32)
    y = xf * lax.rsqrt(jnp.mean(xf * xf, axis=-1, keepdims=True) + EPS)
    return (y * g.astype(jnp.float32)).astype(x.dtype)


def layer_norm(x, g, b):
    xf = x.astype(jnp.float32)
    mu = jnp.mean(xf, axis=-1, keepdims=True)
    var = jnp.mean(jnp.square(xf - mu), axis=-1, keepdims=True)
    y = (xf - mu) * lax.rsqrt(var + EPS)
    return (y * g.astype(jnp.float32) + b.astype(jnp.float32)).astype(x.dtype)


def ada_modulate(x, cond, norm_g, w_ada, b_ada):
    m = jax.nn.silu(cond) @ w_ada + b_ada
    shift, scale, gate = jnp.split(m, 3, axis=-1)
    h = rms_norm(x, norm_g) * (1.0 + scale[:, None, :]) + shift[:, None, :]
    return h, gate[:, None, :]


def conformer_conv(a, b, conv_w, conv_b, ln_g, ln_b):
    u = a * jax.nn.sigmoid(b)
    y = lax.conv_general_dilated(u, conv_w[:, None, :], window_strides=(1,),
                                 padding=((CONV_K // 2, CONV_K // 2),),
                                 dimension_numbers=('NWC', 'WIO', 'NWC'),
                                 feature_group_count=D_CONV)
    y = layer_norm(y + conv_b, ln_g, ln_b)
    return jax.nn.silu(y)


def even_projections(h, w_in, q_norm, k_norm):
    bsz, L, _ = h.shape
    a, b, ga, q, k, v, gb = jnp.split(h @ w_in, SPLITS_EVEN, axis=-1)
    q = rms_norm(q.reshape(bsz, L, NA_HEADS, HEAD_DIM), q_norm)
    k = rms_norm(k.reshape(bsz, L, NA_HEADS, HEAD_DIM), k_norm)
    v = v.reshape(bsz, L, NA_HEADS, HEAD_DIM)
    return a, b, ga, q, k, v, gb


def even_output(y_conv, ga, y_att, gb, w_out):
    bsz, L = y_conv.shape[0], y_conv.shape[1]
    z = jnp.concatenate([y_conv * jax.nn.silu(ga),
                         y_att.reshape(bsz, L, D_ATT) * jax.nn.silu(gb)], axis=-1)
    return z @ w_out


def context_attention(q, k, v):
    bsz, L, H, Dh = q.shape
    qb = q.reshape(bsz, L // Q_BLOCK, Q_BLOCK, H, Dh).transpose(1, 0, 2, 3, 4)

    def block(qi):
        s = jnp.einsum('bqhd,bkhd->bhqk', qi, k).astype(jnp.float32) * ATT_SCALE
        p = jax.nn.softmax(s, axis=-1).astype(v.dtype)
        return jnp.einsum('bhqk,bkhd->bqhd', p, v)

    o = lax.map(block, qb)
    return o.transpose(1, 0, 2, 3, 4).reshape(bsz, L, H, Dh)


def neighbourhood_attention(q, k, v, k_ctx, v_ctx, rpb):
    bsz, L, H, Dh = q.shape
    rows = L // GRID_W
    kr = min(NA_ROWS, rows)
    ncb = GRID_W // NA_QCB
    r_all = jnp.arange(rows)
    row_start = jnp.clip(r_all - NA_ROWS // 2, 0, rows - kr)
    row_idx = row_start[:, None] + jnp.arange(kr)[None, :]
    cols = jnp.arange(GRID_W)
    q_col_start = jnp.clip(cols - NA_COLS // 2, 0, GRID_W - NA_COLS).reshape(ncb, NA_QCB)
    cb_start = jnp.clip(jnp.arange(ncb) * NA_QCB - NA_COLS // 2, 0, GRID_W - NA_KCB)
    col_idx = cb_start[:, None] + jnp.arange(NA_KCB)[None, :]
    key_col = col_idx[:, None, :]
    col_ok = (key_col >= q_col_start[:, :, None]) & (key_col < q_col_start[:, :, None] + NA_COLS)
    rel_c = key_col - cols.reshape(ncb, NA_QCB)[:, :, None]
    rel_c_idx = jnp.clip(rel_c + NA_COLS - 1, 0, 2 * NA_COLS - 2)
    rpb_c = rpb.astype(jnp.float32)[:, :, rel_c_idx]
    kg = k.reshape(bsz, rows, GRID_W, H, Dh)
    vg = v.reshape(bsz, rows, GRID_W, H, Dh)
    q_rows = q.reshape(bsz, rows, ncb, NA_QCB, H, Dh).transpose(1, 0, 2, 3, 4, 5)
    n_win = kr * NA_KCB

    def row_step(args):
        q_r, r_idx, r_id = args
        gidx = (r_idx[:, None, None], col_idx[None, :, :])
        kw = kg[:, gidx[0], gidx[1]]
        vw = vg[:, gidx[0], gidx[1]]
        s_win = jnp.einsum('bjqhd,bkjwhd->bhjqkw', q_r, kw).astype(jnp.float32) * ATT_SCALE
        bias = rpb_c[:, r_idx - r_id + NA_ROWS - 1].transpose(0, 2, 3, 1, 4)
        s_win = jnp.where(col_ok[None, :, :, None, :], s_win + bias, -jnp.inf)
        s_ctx = jnp.einsum('bjqhd,bmhd->bhjqm', q_r, k_ctx).astype(jnp.float32) * ATT_SCALE
        s = jnp.concatenate([s_win.reshape(bsz, H, ncb, NA_QCB, n_win), s_ctx], axis=-1)
        p = jax.nn.softmax(s, axis=-1).astype(v.dtype)
        p_win = p[..., :n_win].reshape(bsz, H, ncb, NA_QCB, kr, NA_KCB)
        p_ctx = p[..., n_win:]
        return (jnp.einsum('bhjqkw,bkjwhd->bjqhd', p_win, vw)
                + jnp.einsum('bhjqm,bmhd->bjqhd', p_ctx, v_ctx))

    o = lax.map(row_step, (q_rows, row_idx, r_all))
    return o.transpose(1, 0, 2, 3, 4, 5).reshape(bsz, L, H, Dh)


def multiscale_pool(u, pool_w, pool_scale):
    bsz, L, C = u.shape
    uf = u.astype(jnp.float32)
    csum = jnp.concatenate([jnp.zeros((bsz, 1, C), jnp.float32), jnp.cumsum(uf, axis=1)], axis=1)
    t = jnp.arange(L)
    outs = []
    for gi, w in enumerate(POOL_WINDOWS):
        lo = jnp.clip(t - w // 2, 0, L)
        hi = jnp.clip(t + w - w // 2, 0, L)
        sl = slice(gi * POOL_GD, (gi + 1) * POOL_GD)
        cg = csum[:, :, sl]
        mean = (cg[:, hi] - cg[:, lo]) / (hi - lo).astype(jnp.float32)[:, None]
        outs.append(mean - uf[:, :, sl])
    d = jnp.stack(outs, axis=2).astype(u.dtype)
    y = jnp.einsum('blgc,gce->blge', d, pool_w).reshape(bsz, L, C)
    return y * pool_scale


def odd_mixer(h, w_in, pool_w, pool_scale, w_out):
    u, g = jnp.split(h @ w_in, 2, axis=-1)
    return (multiscale_pool(u, pool_w, pool_scale) * jax.nn.silu(g)) @ w_out


def setup_inputs(seed: int = 0) -> dict:
    key = jax.random.key(seed)
    ks = jax.random.split(key, 32)

    def nrm(k, shape, s):
        return jax.random.normal(k, shape, jnp.float32) * s

    d = D_MODEL
    return {
        'x_prompt': nrm(ks[0], (BATCH, SEQ, d), 1.0),
        'x_sample': nrm(ks[1], (DEC_BATCH, DEC_SEQ, d), 1.0),
        'cache_k_0': nrm(ks[2], (DEC_BATCH, PAST_LEN, NA_HEADS, HEAD_DIM), 1.0),
        'cache_v_0': nrm(ks[3], (DEC_BATCH, PAST_LEN, NA_HEADS, HEAD_DIM), 1.0),
        'c': nrm(ks[4], (DEC_BATCH, d), 1.0),
        'c_ctx': nrm(ks[5], (d,), 1.0),
        'norm_g_0': 1.0 + nrm(ks[6], (d,), 0.02),
        'w_ada_0': nrm(ks[7], (d, 3 * d), 0.5 * d ** -0.5),
        'b_ada_0': nrm(ks[8], (3 * d,), 0.02),
        'w_in_0': nrm(ks[9], (d, D_IN_EVEN), d ** -0.5),
        'conv_w_0': nrm(ks[10], (CONV_K, D_CONV), CONV_K ** -0.5),
        'conv_b_0': nrm(ks[11], (D_CONV,), 0.01),
        'conv_ln_g_0': 1.0 + nrm(ks[12], (D_CONV,), 0.02),
        'conv_ln_b_0': nrm(ks[13], (D_CONV,), 0.01),
        'q_norm_0': 1.0 + nrm(ks[14], (HEAD_DIM,), 0.02),
        'k_norm_0': 1.0 + nrm(ks[15], (HEAD_DIM,), 0.02),
        'rpb_0': nrm(ks[16], (NA_HEADS, 2 * NA_ROWS - 1, 2 * NA_COLS - 1), 0.1),
        'w_out_0': nrm(ks[17], (D_CONV + D_ATT, d), (D_CONV + D_ATT) ** -0.5),
        'norm_g_1': 1.0 + nrm(ks[18], (d,), 0.02),
        'w_ada_1': nrm(ks[19], (d, 3 * d), 0.5 * d ** -0.5),
        'b_ada_1': nrm(ks[20], (3 * d,), 0.02),
        'w_in_1': nrm(ks[21], (d, 2 * D_POOL), d ** -0.5),
        'pool_w_1': nrm(ks[22], (POOL_GROUPS, POOL_GD, POOL_GD), POOL_GD ** -0.5),
        'pool_scale_1': 1.0 + nrm(ks[23], (D_POOL,), 0.02),
        'w_out_1': nrm(ks[24], (D_POOL, d), D_POOL ** -0.5),
    }


def reference(x_prompt, x_sample, cache_k_0, cache_v_0, c, c_ctx,
              norm_g_0, w_ada_0, b_ada_0, w_in_0, conv_w_0, conv_b_0, conv_ln_g_0, conv_ln_b_0,
              q_norm_0, k_norm_0, rpb_0, w_out_0,
              norm_g_1, w_ada_1, b_ada_1, w_in_1, pool_w_1, pool_scale_1, w_out_1):
    even_params = {0: (norm_g_0, w_ada_0, b_ada_0, w_in_0, conv_w_0, conv_b_0, conv_ln_g_0, conv_ln_b_0,
                       q_norm_0, k_norm_0, rpb_0, w_out_0)}
    odd_params = {1: (norm_g_1, w_ada_1, b_ada_1, w_in_1, pool_w_1, pool_scale_1, w_out_1)}
    caches = {0: (cache_k_0, cache_v_0)}
    cond_ctx = jnp.broadcast_to(c_ctx[None, :], (x_prompt.shape[0], D_MODEL))
    y_prompt, y_sample = x_prompt, x_sample
    new_state = {}
    for i in range(DEPTH):
        if i % 2 == 0:
            (norm_g, w_ada, b_ada, w_in, conv_w, conv_b, ln_g, ln_b, qn, kn, rpb, w_out) = even_params[i]
            h, gate = ada_modulate(y_prompt, cond_ctx, norm_g, w_ada, b_ada)
            a, b, ga, q, k, v, gb = even_projections(h, w_in, qn, kn)
            out = even_output(conformer_conv(a, b, conv_w, conv_b, ln_g, ln_b), ga,
                              context_attention(q, k, v), gb, w_out)
            y_prompt = y_prompt + gate * out
            new_state[i] = (k, v)
            h, gate = ada_modulate(y_sample, c, norm_g, w_ada, b_ada)
            a, b, ga, q, k, v, gb = even_projections(h, w_in, qn, kn)
            k_c, v_c = caches[i]
            out = even_output(conformer_conv(a, b, conv_w, conv_b, ln_g, ln_b), ga,
                              neighbourhood_attention(q, k, v, k_c, v_c, rpb), gb, w_out)
            y_sample = y_sample + gate * out
        else:
            (norm_g, w_ada, b_ada, w_in, pool_w, pool_scale, w_out) = odd_params[i]
            h, gate = ada_modulate(y_prompt, cond_ctx, norm_g, w_ada, b_ada)
            y_prompt = y_prompt + gate * odd_mixer(h, w_in, pool_w, pool_scale, w_out)
            h, gate = ada_modulate(y_sample, c, norm_g, w_ada, b_ada)
            y_sample = y_sample + gate * odd_mixer(h, w_in, pool_w, pool_scale, w_out)
    k_ctx_0, v_ctx_0 = new_state[0]
    return (y_prompt, y_sample, k_ctx_0, v_ctx_0)
```

```cpp
#include <hip/hip_runtime.h>
#include <hip/hip_cooperative_groups.h>
#include <cstdio>
namespace cg = cooperative_groups;

#ifndef MK_MULTI
#define MK_MULTI 0
#endif

typedef unsigned short u16;
using bf16x8 = __attribute__((ext_vector_type(8))) short;
using f32x16 = __attribute__((ext_vector_type(16))) float;
#define DI __device__ __forceinline__
#define MFMA(a, b, c) __builtin_amdgcn_mfma_f32_32x32x16_bf16((a), (b), (c), 0, 0, 0)

constexpr int TP = 8192;
constexpr int TT = 24576;
constexpr float EPS = 1e-6f;

constexpr size_t WS_MOD   = 0;
constexpr size_t WS_WIN0  = 131072;
constexpr size_t WS_WOUT0 = WS_WIN0 + (size_t)3584 * 1024 * 2;
constexpr size_t WS_WIN1  = WS_WOUT0 + (size_t)1024 * 1024 * 2;
constexpr size_t WS_WPOOL = WS_WIN1 + (size_t)2048 * 1024 * 2;
constexpr size_t WS_WOUT1 = WS_WPOOL + (size_t)4 * 256 * 256 * 2;
constexpr size_t WS_KC    = WS_WOUT1 + (size_t)1024 * 1024 * 2;
constexpr size_t WS_VTC   = WS_KC + (size_t)4 * 8 * 512 * 64 * 2;
constexpr size_t WS_R0    = WS_VTC + (size_t)4 * 8 * 512 * 64 * 2;
constexpr size_t RSZ      = (size_t)TT * 1024 * 2;
constexpr size_t WS_R1    = WS_R0 + RSZ;
constexpr size_t WS_R2    = WS_R1 + RSZ;
constexpr size_t WS_R3    = WS_R2 + RSZ;
constexpr size_t WS_END   = WS_R3 + RSZ;
constexpr size_t HALF_R   = RSZ / 2;

struct P {
  const float *x_prompt, *x_sample, *cache_k, *cache_v, *c, *c_ctx;
  const float *norm_g0, *w_ada0, *b_ada0, *w_in0, *conv_w, *conv_b, *ln_g, *ln_b, *q_norm, *k_norm, *rpb, *w_out0;
  const float *norm_g1, *w_ada1, *b_ada1, *w_in1, *pool_w, *pool_scale, *w_out1;
  float* out;
  char* ws;
  int ph_lo, ph_hi;
};

DI u16 f2bf(float x) { unsigned u = __float_as_uint(x); u += 0x7fffu + ((u >> 16) & 1u); return (u16)(u >> 16); }
DI float bf2f(u16 v) { return __uint_as_float(((unsigned)v) << 16); }
DI unsigned pack2(float a, float b) { return (unsigned)f2bf(a) | ((unsigned)f2bf(b) << 16); }
DI float bflo(unsigned v) { return __uint_as_float(v << 16); }
DI float bfhi(unsigned v) { return __uint_as_float(v & 0xffff0000u); }
DI float silu_f(float x) { return x / (1.f + __expf(-x)); }
DI float sigm_f(float x) { return 1.f / (1.f + __expf(-x)); }
DI const float* xrow(const P& p, int t) { return t < TP ? p.x_prompt + (size_t)t * 1024 : p.x_sample + (size_t)(t - TP) * 1024; }
DI int midx(int t) { return t < TP ? 0 : 1 + ((t - TP) >> 12); }

constexpr int P0_ADA = 192, P0_TR = 2240, P0_KC = 256, P0_ITEMS = P0_ADA + P0_TR + P0_KC;

DI void p0_item(const P& p, int it, char* smem) {
  const int tid = threadIdx.x;
  if (it < P0_ADA) {
    const int layer = it / 96, n0 = (it % 96) * 32;
    float* sc = (float*)smem;
    float* red = (float*)(smem + 20480);
    for (int e = tid; e < 5120; e += 256) {
      const int j = e >> 10, k = e & 1023;
      const float v = (j == 0) ? p.c_ctx[k] : p.c[(j - 1) * 1024 + k];
      sc[e] = silu_f(v);
    }
    __syncthreads();
    const float* W = layer ? p.w_ada1 : p.w_ada0;
    const float* bias = layer ? p.b_ada1 : p.b_ada0;
    const int cq = tid & 7, kl = tid >> 3;
    float acc[5][4];
#pragma unroll
    for (int j = 0; j < 5; ++j) { acc[j][0] = acc[j][1] = acc[j][2] = acc[j][3] = 0.f; }
#pragma unroll 4
    for (int i = 0; i < 32; ++i) {
      const int k = kl + 32 * i;
      const float4 w = *(const float4*)(W + (size_t)k * 3072 + n0 + 4 * cq);
#pragma unroll
      for (int j = 0; j < 5; ++j) {
        const float s = sc[j * 1024 + k];
        acc[j][0] += s * w.x; acc[j][1] += s * w.y; acc[j][2] += s * w.z; acc[j][3] += s * w.w;
      }
    }
#pragma unroll
    for (int j = 0; j < 5; ++j)
#pragma unroll
      for (int a = 0; a < 4; ++a) red[((kl * 8 + cq) * 5 + j) * 4 + a] = acc[j][a];
    __syncthreads();
    if (tid < 160) {
      const int j = tid >> 5, col = tid & 31;
      float s = bias[n0 + col];
      for (int k2 = 0; k2 < 32; ++k2) s += red[((k2 * 8 + (col >> 2)) * 5 + j) * 4 + (col & 3)];
      ((float*)(p.ws + WS_MOD))[(layer * 5 + j) * 3072 + n0 + col] = s;
    }
  } else if (it < P0_ADA + P0_TR) {
    int j = it - P0_ADA;
    const float* src; u16* dst; int sstride, dstride, r0, n0; bool perm = false;
    if (j < 896) { src = p.w_in0; sstride = 3584; r0 = (j / 56) * 64; n0 = (j % 56) * 64; dst = (u16*)(p.ws + WS_WIN0); dstride = 1024; perm = true; }
    else if (j < 1152) { j -= 896; src = p.w_out0; sstride = 1024; r0 = (j / 16) * 64; n0 = (j % 16) * 64; dst = (u16*)(p.ws + WS_WOUT0); dstride = 1024; }
    else if (j < 1664) { j -= 1152; src = p.w_in1; sstride = 2048; r0 = (j / 32) * 64; n0 = (j % 32) * 64; dst = (u16*)(p.ws + WS_WIN1); dstride = 1024; }
    else if (j < 1728) { j -= 1664; const int g = j >> 4; src = p.pool_w + g * 65536; sstride = 256; r0 = ((j & 15) >> 2) * 64; n0 = (j & 3) * 64; dst = (u16*)(p.ws + WS_WPOOL) + g * 65536; dstride = 256; }
    else if (j < 1984) { j -= 1728; src = p.w_out1; sstride = 1024; r0 = (j / 16) * 64; n0 = (j % 16) * 64; dst = (u16*)(p.ws + WS_WOUT1); dstride = 1024; }
    else { j -= 1984; const int bh = j >> 3, mt = j & 7; src = p.cache_v + (size_t)(bh >> 3) * 512 * 512 + (bh & 7) * 64; sstride = 512; r0 = mt * 64; n0 = 0; dst = (u16*)(p.ws + WS_VTC) + (size_t)bh * 64 * 512; dstride = 512; }
    float* tile = (float*)smem;
    {
      int nn = n0 + (tid & 63);
      if (perm && nn < 1024) { const int w = nn >> 6, r = nn & 63; nn = (r < 32) ? (32 * w + r) : (512 + 32 * w + r - 32); }
#pragma unroll 4
      for (int i = 0; i < 16; ++i) {
        const int r = i * 4 + (tid >> 6);
        tile[r * 65 + (tid & 63)] = src[(size_t)(r0 + r) * sstride + nn];
      }
    }
    __syncthreads();
#pragma unroll 4
    for (int i = 0; i < 16; ++i) {
      const int n = i * 4 + (tid >> 6), k = tid & 63;
      dst[(size_t)(n0 + n) * dstride + r0 + k] = f2bf(tile[k * 65 + n]);
    }
  } else {
    const int it2 = it - P0_ADA - P0_TR;
    u16* kc = (u16*)(p.ws + WS_KC);
#pragma unroll 4
    for (int e = 0; e < 16; ++e) {
      const int o = it2 * 4096 + e * 256 + tid;
      const int d = o & 63, m = (o >> 6) & 511, bh = o >> 15;
      kc[o] = f2bf(p.cache_k[(((size_t)(bh >> 3) * 512 + m) * 8 + (bh & 7)) * 64 + d]);
    }
  }
}

DI void modnorm_item(const P& p, int it, int layer) {
  const int tid = threadIdx.x, lane = tid & 63, wave = tid >> 6;
  const int row0 = it * 32 + wave * 8;
  const float* g = layer ? p.norm_g1 : p.norm_g0;
  const float* mod = (const float*)(p.ws + WS_MOD) + (size_t)(layer * 5 + midx(row0)) * 3072;
  u16* H = (u16*)(p.ws + WS_R0);
  float4 a[4], b[4];
#pragma unroll
  for (int j = 0; j < 4; ++j) {
    const int col = j * 256 + lane * 4;
    const float4 gv = *(const float4*)(g + col);
    const float4 sh = *(const float4*)(mod + col);
    const float4 sv = *(const float4*)(mod + 1024 + col);
    a[j] = make_float4(gv.x * (1.f + sv.x), gv.y * (1.f + sv.y), gv.z * (1.f + sv.z), gv.w * (1.f + sv.w));
    b[j] = sh;
  }
#pragma unroll 2
  for (int r = 0; r < 8; ++r) {
    const int row = row0 + r;
    const float* xr = layer ? (p.out + (size_t)row * 1024) : xrow(p, row);
    float4 v[4];
    float ss = 0.f;
#pragma unroll
    for (int j = 0; j < 4; ++j) {
      v[j] = *(const float4*)(xr + j * 256 + lane * 4);
      ss += v[j].x * v[j].x + v[j].y * v[j].y + v[j].z * v[j].z + v[j].w * v[j].w;
    }
#pragma unroll
    for (int o = 32; o >= 1; o >>= 1) ss += __shfl_xor(ss, o);
    const float rinv = rsqrtf(ss * (1.f / 1024.f) + EPS);
#pragma unroll
    for (int j = 0; j < 4; ++j) {
      uint2 o2;
      o2.x = pack2(v[j].x * rinv * a[j].x + b[j].x, v[j].y * rinv * a[j].y + b[j].y);
      o2.y = pack2(v[j].z * rinv * a[j].z + b[j].z, v[j].w * rinv * a[j].w + b[j].w);
      *(uint2*)(H + (size_t)row * 1024 + j * 256 + lane * 4) = o2;
    }
  }
}

constexpr int LROW = 144;
constexpr int GSTAGE = 256 * LROW;
constexpr int SMEM_BYTES = 2 * GSTAGE;

DI void gemm_mainloop(const u16* __restrict__ Ag, int lda, const u16* __restrict__ Bg, int ldb, int K, char* smem, f32x16 (&acc)[2][2]) {
  const int tid = threadIdx.x, lane = tid & 63, wave = tid >> 6;
  const int wm = wave >> 1, wn = wave & 1;
  const int srow = tid >> 3, scol = tid & 7;
  const u16* ag = Ag + (size_t)srow * lda + scol * 8;
  const u16* bg = Bg + (size_t)srow * ldb + scol * 8;
  uint4 ra[4], rb[4];
#pragma unroll
  for (int i = 0; i < 4; ++i) { ra[i] = *(const uint4*)(ag + (size_t)(32 * i) * lda); rb[i] = *(const uint4*)(bg + (size_t)(32 * i) * ldb); }
  const int wofs = srow * LROW + scol * 16;
#pragma unroll
  for (int i = 0; i < 4; ++i) { *(uint4*)(smem + wofs + 32 * i * LROW) = ra[i]; *(uint4*)(smem + 128 * LROW + wofs + 32 * i * LROW) = rb[i]; }
  __syncthreads();
  const int aofs = (wm * 64 + (lane & 31)) * LROW + (lane >> 5) * 16;
  const int bofs = 128 * LROW + (wn * 64 + (lane & 31)) * LROW + (lane >> 5) * 16;
  const int nk = K >> 6;
  for (int kt = 0; kt < nk; ++kt) {
    const char* cur = smem + (kt & 1) * GSTAGE;
    char* nxt = smem + ((kt + 1) & 1) * GSTAGE;
    const bool more = (kt + 1 < nk);
    if (more) {
      const int ko = (kt + 1) * 64;
#pragma unroll
      for (int i = 0; i < 4; ++i) { ra[i] = *(const uint4*)(ag + (size_t)(32 * i) * lda + ko); rb[i] = *(const uint4*)(bg + (size_t)(32 * i) * ldb + ko); }
    }
#pragma unroll
    for (int ks = 0; ks < 4; ++ks) {
      bf16x8 af[2], bfr[2];
      af[0] = *(const bf16x8*)(cur + aofs + ks * 32);
      af[1] = *(const bf16x8*)(cur + aofs + 32 * LROW + ks * 32);
      bfr[0] = *(const bf16x8*)(cur + bofs + ks * 32);
      bfr[1] = *(const bf16x8*)(cur + bofs + 32 * LROW + ks * 32);
      acc[0][0] = MFMA(af[0], bfr[0], acc[0][0]);
      acc[0][1] = MFMA(af[0], bfr[1], acc[0][1]);
      acc[1][0] = MFMA(af[1], bfr[0], acc[1][0]);
      acc[1][1] = MFMA(af[1], bfr[1], acc[1][1]);
    }
    if (more) {
#pragma unroll
      for (int i = 0; i < 4; ++i) { *(uint4*)(nxt + wofs + 32 * i * LROW) = ra[i]; *(uint4*)(nxt + 128 * LROW + wofs + 32 * i * LROW) = rb[i]; }
    }
    __syncthreads();
  }
}

template <int EPI>
DI void gemm_item(const P& p, int item, char* smem) {
  const int tid = threadIdx.x, lane = tid & 63, wave = tid >> 6, l31 = lane & 31, hh = lane >> 5;
  const int wm = wave >> 1, wn = wave & 1;
  const u16 *A, *B; int lda, ldb, K, f0, t0, grp = 0;
  if (EPI == 1) { const int ft = item % 28, tt = item / 28; f0 = ft * 128; t0 = tt * 128; A = (const u16*)(p.ws + WS_WIN0) + (size_t)f0 * 1024; lda = 1024; B = (const u16*)(p.ws + WS_R0) + (size_t)t0 * 1024; ldb = 1024; K = 1024; }
  else if (EPI == 2) { const int ft = item % 8, tt = item / 8; f0 = ft * 128; t0 = tt * 128; A = (const u16*)(p.ws + WS_WOUT0) + (size_t)f0 * 1024; lda = 1024; B = (const u16*)(p.ws + WS_R0) + (size_t)t0 * 1024; ldb = 1024; K = 1024; }
  else if (EPI == 3) { const int ft = item % 16, tt = item / 16; f0 = ft * 128; t0 = tt * 128; A = (const u16*)(p.ws + WS_WIN1) + (size_t)f0 * 1024; lda = 1024; B = (const u16*)(p.ws + WS_R0) + (size_t)t0 * 1024; ldb = 1024; K = 1024; }
  else if (EPI == 4) { const int ft = item & 1, tt = item >> 3; grp = (item >> 1) & 3; f0 = ft * 128; t0 = tt * 128; A = (const u16*)(p.ws + WS_WPOOL) + grp * 65536 + (size_t)f0 * 256; lda = 256; B = (const u16*)(p.ws + WS_R3) + (size_t)t0 * 1024 + grp * 256; ldb = 1024; K = 256; }
  else { const int ft = item % 8, tt = item / 8; f0 = ft * 128; t0 = tt * 128; A = (const u16*)(p.ws + WS_WOUT1) + (size_t)f0 * 1024; lda = 1024; B = (const u16*)(p.ws + WS_R0) + (size_t)t0 * 1024; ldb = 1024; K = 1024; }

  f32x16 acc[2][2];
#pragma unroll
  for (int a = 0; a < 2; ++a)
#pragma unroll
    for (int b = 0; b < 2; ++b)
#pragma unroll
      for (int i = 0; i < 16; ++i) acc[a][b][i] = 0.f;
  gemm_mainloop(A, lda, B, ldb, K, smem, acc);

  const int fb = f0 + wm * 64;
  const int tokb = t0 + wn * 64;
  if (EPI == 1) {
    u16* U = (u16*)(p.ws + WS_R1);
    u16* SGA = (u16*)(p.ws + WS_R1 + HALF_R);
    u16* Q = (u16*)(p.ws + WS_R2);
    u16* Kb = (u16*)(p.ws + WS_R2 + HALF_R);
    u16* VT = (u16*)(p.ws + WS_R3);
    u16* SGB = (u16*)(p.ws + WS_R3 + HALF_R);
#pragma unroll
    for (int nj = 0; nj < 2; ++nj) {
      const int tok = tokb + nj * 32 + l31;
      if (fb < 1024) {
        const int cb = (fb >> 6) * 32;
#pragma unroll
        for (int g = 0; g < 4; ++g) {
          float u[4];
#pragma unroll
          for (int a = 0; a < 4; ++a) u[a] = acc[0][nj][4 * g + a] * sigm_f(acc[1][nj][4 * g + a]);
          uint2 o; o.x = pack2(u[0], u[1]); o.y = pack2(u[2], u[3]);
          *(uint2*)(U + (size_t)tok * 512 + cb + 8 * g + 4 * hh) = o;
        }
      } else if (fb < 1536 || fb >= 3072) {
        u16* dst = (fb < 1536) ? (SGA + (size_t)tok * 512 + (fb - 1024)) : (SGB + (size_t)tok * 512 + (fb - 3072));
#pragma unroll
        for (int mi = 0; mi < 2; ++mi)
#pragma unroll
          for (int g = 0; g < 4; ++g) {
            uint2 o;
            o.x = pack2(silu_f(acc[mi][nj][4 * g]), silu_f(acc[mi][nj][4 * g + 1]));
            o.y = pack2(silu_f(acc[mi][nj][4 * g + 2]), silu_f(acc[mi][nj][4 * g + 3]));
            *(uint2*)(dst + mi * 32 + 8 * g + 4 * hh) = o;
          }
      } else if (fb < 2560) {
        const bool isq = fb < 2048;
        const int hc = isq ? (fb - 1536) : (fb - 2048);
        float ss = 0.f;
#pragma unroll
        for (int mi = 0; mi < 2; ++mi)
#pragma unroll
          for (int i = 0; i < 16; ++i) ss += acc[mi][nj][i] * acc[mi][nj][i];
        ss += __shfl_xor(ss, 32);
        float rinv = rsqrtf(ss * (1.f / 64.f) + EPS);
        const float* nw = isq ? p.q_norm : p.k_norm;
        const float qs = isq ? 0.125f : 1.f;
        u16* dst = (isq ? Q : Kb) + (size_t)tok * 512 + hc;
#pragma unroll
        for (int mi = 0; mi < 2; ++mi)
#pragma unroll
          for (int g = 0; g < 4; ++g) {
            const int d = mi * 32 + 8 * g + 4 * hh;
            const float4 w = *(const float4*)(nw + d);
            float4 v;
            v.x = acc[mi][nj][4 * g] * rinv * w.x; v.y = acc[mi][nj][4 * g + 1] * rinv * w.y;
            v.z = acc[mi][nj][4 * g + 2] * rinv * w.z; v.w = acc[mi][nj][4 * g + 3] * rinv * w.w;
            if (!isq && tok < TP) *(float4*)(p.out + (size_t)TT * 1024 + (size_t)tok * 512 + hc + d) = v;
            uint2 o; o.x = pack2(v.x * qs, v.y * qs); o.y = pack2(v.z * qs, v.w * qs);
            *(uint2*)(dst + d) = o;
          }
      } else {
        const int hc = fb - 2560;
#pragma unroll
        for (int mi = 0; mi < 2; ++mi)
#pragma unroll
          for (int g = 0; g < 4; ++g) {
            const int d = mi * 32 + 8 * g + 4 * hh;
            if (tok < TP) {
              float4 v; v.x = acc[mi][nj][4 * g]; v.y = acc[mi][nj][4 * g + 1]; v.z = acc[mi][nj][4 * g + 2]; v.w = acc[mi][nj][4 * g + 3];
              *(float4*)(p.out + (size_t)TT * 1024 + (size_t)TP * 512 + (size_t)tok * 512 + hc + d) = v;
            }
#pragma unroll
            for (int a = 0; a < 4; ++a) VT[(size_t)(hc + d + a) * TT + tok] = f2bf(acc[mi][nj][4 * g + a]);
          }
      }
    }
  } else if (EPI == 2 || EPI == 5) {
    const int layer = (EPI == 2) ? 0 : 1;
#pragma unroll
    for (int nj = 0; nj < 2; ++nj) {
      const int tok = tokb + nj * 32 + l31;
      const float* gate = (const float*)(p.ws + WS_MOD) + (size_t)(layer * 5 + midx(tok)) * 3072 + 2048;
      const float* xr = (EPI == 2) ? xrow(p, tok) : (p.out + (size_t)tok * 1024);
      float* yr = p.out + (size_t)tok * 1024;
#pragma unroll
      for (int mi = 0; mi < 2; ++mi)
#pragma unroll
        for (int g = 0; g < 4; ++g) {
          const int col = fb + mi * 32 + 8 * g + 4 * hh;
          const float4 xv = *(const float4*)(xr + col);
          const float4 gv = *(const float4*)(gate + col);
          float4 o;
          o.x = xv.x + gv.x * acc[mi][nj][4 * g]; o.y = xv.y + gv.y * acc[mi][nj][4 * g + 1];
          o.z = xv.z + gv.z * acc[mi][nj][4 * g + 2]; o.w = xv.w + gv.w * acc[mi][nj][4 * g + 3];
          *(float4*)(yr + col) = o;
        }
    }
  } else if (EPI == 3) {
    u16* U1 = (u16*)(p.ws + WS_R1);
    u16* SG1 = (u16*)(p.ws + WS_R2);
#pragma unroll
    for (int nj = 0; nj < 2; ++nj) {
      const int tok = tokb + nj * 32 + l31;
#pragma unroll
      for (int mi = 0; mi < 2; ++mi)
#pragma unroll
        for (int g = 0; g < 4; ++g) {
          const int col = fb + mi * 32 + 8 * g + 4 * hh;
          uint2 o;
          if (fb < 1024) {
            o.x = pack2(acc[mi][nj][4 * g], acc[mi][nj][4 * g + 1]); o.y = pack2(acc[mi][nj][4 * g + 2], acc[mi][nj][4 * g + 3]);
            *(uint2*)(U1 + (size_t)tok * 1024 + col) = o;
          } else {
            o.x = pack2(silu_f(acc[mi][nj][4 * g]), silu_f(acc[mi][nj][4 * g + 1])); o.y = pack2(silu_f(acc[mi][nj][4 * g + 2]), silu_f(acc[mi][nj][4 * g + 3]));
            *(uint2*)(SG1 + (size_t)tok * 1024 + col - 1024) = o;
          }
        }
    }
  } else {
    const u16* SG1 = (const u16*)(p.ws + WS_R2);
    u16* Z1 = (u16*)(p.ws + WS_R0);
#pragma unroll
    for (int nj = 0; nj < 2; ++nj) {
      const int tok = tokb + nj * 32 + l31;
#pragma unroll
      for (int mi = 0; mi < 2; ++mi)
#pragma unroll
        for (int g = 0; g < 4; ++g) {
          const int col = grp * 256 + fb + mi * 32 + 8 * g + 4 * hh;
          const float4 sc = *(const float4*)(p.pool_scale + col);
          const uint2 sg = *(const uint2*)(SG1 + (size_t)tok * 1024 + col);
          uint2 o;
          o.x = pack2(acc[mi][nj][4 * g] * sc.x * bflo(sg.x), acc[mi][nj][4 * g + 1] * sc.y * bfhi(sg.x));
          o.y = pack2(acc[mi][nj][4 * g + 2] * sc.z * bflo(sg.y), acc[mi][nj][4 * g + 3] * sc.w * bfhi(sg.y));
          *(uint2*)(Z1 + (size_t)tok * 1024 + col) = o;
        }
    }
  }
}

constexpr int P3_NA = 1024, P3_CTX = 512, P3_CONV = 3072, P3_ITEMS = P3_NA + P3_CTX + P3_CONV;

DI void conv_item(const P& p, int it, char* smem) {
  const int tid = threadIdx.x, lane = tid & 63, wave = tid >> 6;
  const int t0 = it * 8;
  int s0, s1;
  if (t0 < TP) { s0 = t0 & ~255; s1 = s0 + 256; } else { s0 = TP + ((t0 - TP) & ~4095); s1 = s0 + 4096; }
  const int c = 2 * tid;
  const u16* U = (const u16*)(p.ws + WS_R1);
  const u16* SGA = (const u16*)(p.ws + WS_R1 + HALF_R);
  u16* Z = (u16*)(p.ws + WS_R0);
  float y0[8], y1[8];
#pragma unroll
  for (int i = 0; i < 8; ++i) { y0[i] = 0.f; y1[i] = 0.f; }
#pragma unroll 1
  for (int hf = 0; hf < 2; ++hf) {
    float w0[16], w1[16];
    const float* wp = p.conv_w + hf * 16 * 512 + c;
#pragma unroll
    for (int jj = 0; jj < 16; ++jj) {
      float2 w = make_float2(0.f, 0.f);
      if (jj < 15 || hf == 0) w = *(const float2*)(wp + jj * 512);
      w0[jj] = w.x; w1[jj] = w.y;
    }
    const int tb = t0 - 15 + hf * 16;
#pragma unroll
    for (int r = 0; r < 23; ++r) {
      const int trow = tb + r;
      unsigned v = 0u;
      if (trow >= s0 && trow < s1) v = *(const unsigned*)(U + (size_t)trow * 512 + c);
      const float v0 = bflo(v), v1 = bfhi(v);
#pragma unroll
      for (int i = 0; i < 8; ++i) {
        const int jj = r - i;
        if (jj >= 0 && jj <= 15) { y0[i] += v0 * w0[jj]; y1[i] += v1 * w1[jj]; }
      }
    }
  }
  const float2 cb = *(const float2*)(p.conv_b + c);
  float vals[16];
#pragma unroll
  for (int i = 0; i < 8; ++i) {
    y0[i] += cb.x; y1[i] += cb.y;
    vals[i] = y0[i] + y1[i];
    vals[8 + i] = y0[i] * y0[i] + y1[i] * y1[i];
  }
#pragma unroll
  for (int half = 8, bit = 32; half >= 1; half >>= 1, bit >>= 1) {
    const bool up = (lane & bit) != 0;
#pragma unroll
    for (int k = 0; k < half; ++k) {
      const float keep = up ? vals[k + half] : vals[k];
      const float send = up ? vals[k] : vals[k + half];
      vals[k] = keep + __shfl_xor(send, bit);
    }
  }
  vals[0] += __shfl_xor(vals[0], 2);
  vals[0] += __shfl_xor(vals[0], 1);
  float* red = (float*)smem;
  float* stat = (float*)smem + 64;
  if ((lane & 3) == 0) red[wave * 16 + (lane >> 2)] = vals[0];
  __syncthreads();
  if (tid < 16) stat[tid] = red[tid] + red[16 + tid] + red[32 + tid] + red[48 + tid];
  __syncthreads();
  const float2 lg = *(const float2*)(p.ln_g + c);
  const float2 lb = *(const float2*)(p.ln_b + c);
#pragma unroll
  for (int i = 0; i < 8; ++i) {
    const float mean = stat[i] * (1.f / 512.f);
    const float var = fmaxf(stat[8 + i] * (1.f / 512.f) - mean * mean, 0.f);
    const float rstd = rsqrtf(var + EPS);
    const int tok = t0 + i;
    const unsigned ga = *(const unsigned*)(SGA + (size_t)tok * 512 + c);
    const float a0 = (y0[i] - mean) * rstd * lg.x + lb.x;
    const float a1 = (y1[i] - mean) * rstd * lg.y + lb.y;
    *(unsigned*)(Z + (size_t)tok * 1024 + c) = pack2(silu_f(a0) * bflo(ga), silu_f(a1) * bfhi(ga));
  }
}

constexpr int ACH = 64 * LROW;
constexpr int ABUF = 2 * ACH;
DI int crow(int i, int hh) { return (i & 3) + 8 * (i >> 2) + 4 * hh; }

DI void attn_item(const P& p, int it, char* smem) {
  const int tid = threadIdx.x, lane = tid & 63, wave = tid >> 6, l31 = lane & 31, hh = lane >> 5;
  const bool is_na = it < P3_NA;
  const u16* Qb = (const u16*)(p.ws + WS_R2);
  const u16* Kb = (const u16*)(p.ws + WS_R2 + HALF_R);
  const u16* VT = (const u16*)(p.ws + WS_R3);
  const u16* SGB = (const u16*)(p.ws + WS_R3 + HALF_R);
  const u16* KC = (const u16*)(p.ws + WS_KC);
  const u16* VTC = (const u16*)(p.ws + WS_VTC);
  u16* Z = (u16*)(p.ws + WS_R0);
  int b, head, qtok, nchunks, tokbase;
  int r = 0, c = 0, qcs = 0, rsw = 0, rs_lo = 0;
  if (is_na) {
    b = it >> 8; head = (it >> 5) & 7; const int r0 = 2 * (it & 31);
    r = r0 + (wave >> 1); c = (wave & 1) * 32 + l31;
    qcs = min(max(c - 8, 0), 48);
    rsw = min(max(r - 4, 0), 56);
    rs_lo = min(max(r0 - 4, 0), 56);
    const int rs_hi = min(max(r0 - 3, 0), 56);
    tokbase = TP + b * 4096;
    qtok = tokbase + r * 64 + c;
    nchunks = 8 + rs_hi + 8 - rs_lo;
  } else {
    const int j = it - P3_NA;
    b = j >> 4; head = (j >> 1) & 7;
    tokbase = b * 256;
    qtok = tokbase + (j & 1) * 128 + wave * 32 + l31;
    nchunks = 4;
  }
  float* rpb_s = (float*)(smem + 2 * ABUF);
  if (is_na) for (int i = tid; i < 465; i += 256) rpb_s[i] = p.rpb[head * 465 + i];

  bf16x8 qf[4];
#pragma unroll
  for (int ks = 0; ks < 4; ++ks) qf[ks] = *(const bf16x8*)(Qb + (size_t)qtok * 512 + head * 64 + ks * 16 + hh * 8);

  f32x16 o0, o1;
#pragma unroll
  for (int i = 0; i < 16; ++i) { o0[i] = 0.f; o1[i] = 0.f; }
  float m_run = -INFINITY, l_run = 0.f;

  const int prow = tid >> 3, ppart = tid & 7;
  const int vpos0 = (16 * (ppart >> 1) + 4 * (ppart & 1)) * 2, vpos1 = vpos0 + 16;
  uint4 kreg[2], vreg[2];
  auto load_chunk = [&](int ci) {
    const u16 *kp, *vp; size_t ks, vs;
    if (is_na && ci < 8) {
      kp = KC + ((size_t)(b * 8 + head) * 512 + ci * 64) * 64; ks = 64;
      vp = VTC + (size_t)(b * 8 + head) * 64 * 512 + ci * 64; vs = 512;
    } else {
      const int kt0 = is_na ? (tokbase + (rs_lo + ci - 8) * 64) : (tokbase + ci * 64);
      kp = Kb + (size_t)kt0 * 512 + head * 64; ks = 512;
      vp = VT + (size_t)(head * 64) * TT + kt0; vs = TT;
    }
#pragma unroll
    for (int i = 0; i < 2; ++i) {
      kreg[i] = *(const uint4*)(kp + (size_t)(prow + 32 * i) * ks + ppart * 8);
      vreg[i] = *(const uint4*)(vp + (size_t)(prow + 32 * i) * vs + ppart * 8);
    }
  };
  auto store_chunk = [&](char* buf) {
#pragma unroll
    for (int i = 0; i < 2; ++i) {
      *(uint4*)(buf + (prow + 32 * i) * LROW + ppart * 16) = kreg[i];
      char* vrow = buf + ACH + (prow + 32 * i) * LROW;
      *(uint2*)(vrow + vpos0) = make_uint2(vreg[i].x, vreg[i].y);
      *(uint2*)(vrow + vpos1) = make_uint2(vreg[i].z, vreg[i].w);
    }
  };
  load_chunk(0);
  store_chunk(smem);
  __syncthreads();
  for (int ci = 0; ci < nchunks; ++ci) {
    const char* cur = smem + (ci & 1) * ABUF;
    const bool more = ci + 1 < nchunks;
    if (more) load_chunk(ci + 1);
    bool act = true, window = false; int rowidx = 0;
    if (is_na && ci >= 8) { const int kr = rs_lo + ci - 8; act = (kr >= rsw) && (kr < rsw + 8); window = true; rowidx = kr - r + 7; }
    if (act) {
#pragma unroll 1
      for (int kt = 0; kt < 2; ++kt) {
        f32x16 s;
#pragma unroll
        for (int i = 0; i < 16; ++i) s[i] = 0.f;
#pragma unroll
        for (int ks = 0; ks < 4; ++ks) {
          const bf16x8 a = *(const bf16x8*)(cur + (kt * 32 + l31) * LROW + ks * 32 + hh * 16);
          s = MFMA(a, qf[ks], s);
        }
        if (window) {
#pragma unroll
          for (int i = 0; i < 16; ++i) {
            const int kc = kt * 32 + crow(i, hh);
            const bool valid = (kc >= qcs) && (kc < qcs + 16);
            const int bi = min(max(kc - c + 15, 0), 30);
            const float bias = rpb_s[rowidx * 31 + bi];
            s[i] = valid ? (s[i] + bias) : -INFINITY;
          }
        }
        float mx = s[0];
#pragma unroll
        for (int i = 1; i < 16; ++i) mx = fmaxf(mx, s[i]);
        mx = fmaxf(mx, __shfl_xor(mx, 32));
        const float m_new = fmaxf(m_run, mx);
        const float alpha = __expf(m_run - m_new);
        m_run = m_new;
        float ps = 0.f;
#pragma unroll
        for (int i = 0; i < 16; ++i) { s[i] = __expf(s[i] - m_new); ps += s[i]; }
        l_run = l_run * alpha + ps;
#pragma unroll
        for (int i = 0; i < 16; ++i) { o0[i] *= alpha; o1[i] *= alpha; }
#pragma unroll
        for (int sidx = 0; sidx < 2; ++sidx) {
          union { unsigned u[4]; bf16x8 v; } pb;
#pragma unroll
          for (int q2 = 0; q2 < 4; ++q2) pb.u[q2] = pack2(s[8 * sidx + 2 * q2], s[8 * sidx + 2 * q2 + 1]);
          const bf16x8 a0 = *(const bf16x8*)(cur + ACH + l31 * LROW + (kt * 32 + 16 * sidx + 8 * hh) * 2);
          const bf16x8 a1 = *(const bf16x8*)(cur + ACH + (32 + l31) * LROW + (kt * 32 + 16 * sidx + 8 * hh) * 2);
          o0 = MFMA(a0, pb.v, o0);
          o1 = MFMA(a1, pb.v, o1);
        }
      }
    }
    if (more) store_chunk(smem + ((ci + 1) & 1) * ABUF);
    __syncthreads();
  }
  const float lt = l_run + __shfl_xor(l_run, 32);
  const float inv = 1.f / lt;
#pragma unroll
  for (int dt = 0; dt < 2; ++dt)
#pragma unroll
    for (int g = 0; g < 4; ++g) {
      const int d = dt * 32 + 8 * g + 4 * hh;
      const uint2 sg = *(const uint2*)(SGB + (size_t)qtok * 512 + head * 64 + d);
      const f32x16& o = dt ? o1 : o0;
      uint2 ov;
      ov.x = pack2(o[4 * g] * inv * bflo(sg.x), o[4 * g + 1] * inv * bfhi(sg.x));
      ov.y = pack2(o[4 * g + 2] * inv * bflo(sg.y), o[4 * g + 3] * inv * bfhi(sg.y));
      *(uint2*)(Z + (size_t)qtok * 1024 + 512 + head * 64 + d) = ov;
    }
}

DI void pool_item(const P& p, int it) {
  const int tid = threadIdx.x, wave = tid >> 6;
  const int t0 = it * 32;
  int s0, s1;
  if (t0 < TP) { s0 = t0 & ~255; s1 = s0 + 256; } else { s0 = TP + ((t0 - TP) & ~4095); s1 = s0 + 4096; }
  const int w = 2 << wave, hw = w >> 1;
  const int c = 4 * tid;
  const u16* U1 = (const u16*)(p.ws + WS_R1);
  u16* Dd = (u16*)(p.ws + WS_R3);
  float sx = 0.f, sy = 0.f, sz = 0.f, sw = 0.f;
  int lo = max(t0 - hw, s0), hi = min(t0 + w - hw, s1);
  for (int t = lo; t < hi; ++t) {
    const uint2 v = *(const uint2*)(U1 + (size_t)t * 1024 + c);
    sx += bflo(v.x); sy += bfhi(v.x); sz += bflo(v.y); sw += bfhi(v.y);
  }
  for (int t = t0; t < t0 + 32; ++t) {
    const int nlo = max(t - hw, s0), nhi = min(t + w - hw, s1);
    if (nhi > hi) { const uint2 v = *(const uint2*)(U1 + (size_t)(nhi - 1) * 1024 + c); sx += bflo(v.x); sy += bfhi(v.x); sz += bflo(v.y); sw += bfhi(v.y); }
    if (nlo > lo) { const uint2 v = *(const uint2*)(U1 + (size_t)lo * 1024 + c); sx -= bflo(v.x); sy -= bfhi(v.x); sz -= bflo(v.y); sw -= bfhi(v.y); }
    lo = nlo; hi = nhi;
    const float rc = 1.f / (float)(hi - lo);
    const uint2 cv = *(const uint2*)(U1 + (size_t)t * 1024 + c);
    uint2 o;
    o.x = pack2(sx * rc - bflo(cv.x), sy * rc - bfhi(cv.x));
    o.y = pack2(sz * rc - bflo(cv.y), sw * rc - bfhi(cv.y));
    *(uint2*)(Dd + (size_t)t * 1024 + c) = o;
  }
}

constexpr int N_PHASES = 10;
#define PHASE_NS(k, n, call) \
  if (p.ph_lo <= (k) && (k) < p.ph_hi) { \
    for (int it = blockIdx.x; it < (n); it += gridDim.x) { __syncthreads(); call; } \
  }
#define PHASE(k, n, call) \
  PHASE_NS(k, n, call) \
  if (p.ph_lo <= (k) && (k) + 1 < p.ph_hi) grid.sync();

__global__ void __launch_bounds__(256, 2) mega(P p) {
  __shared__ __attribute__((aligned(16))) char smem[SMEM_BYTES];
  cg::grid_group grid = cg::this_grid();
  PHASE(0, P0_ITEMS, p0_item(p, it, smem))
  PHASE(1, 768, modnorm_item(p, it, 0))
  PHASE(2, 28 * 192, gemm_item<1>(p, it, smem))
  PHASE_NS(3, P3_NA + P3_CTX, attn_item(p, it, smem))
  PHASE(3, P3_CONV, conv_item(p, (it + 1024) % P3_CONV, smem))
  PHASE(4, 8 * 192, gemm_item<2>(p, it, smem))
  PHASE(5, 768, modnorm_item(p, it, 1))
  PHASE(6, 16 * 192, gemm_item<3>(p, it, smem))
  PHASE(7, 768, pool_item(p, it))
  PHASE(8, 8 * 192, gemm_item<4>(p, it, smem))
  PHASE(9, 8 * 192, gemm_item<5>(p, it, smem))
}

extern "C" void kernel_launch(void* const* d_in, const int* in_sizes, int n_in, void* d_out, int out_size, void* d_ws, size_t ws_size, hipStream_t stream) {
  static int grid_blocks = 0;
  if (!grid_blocks) {
    int dev = 0, cus = 0, per_cu = 0;
    hipGetDevice(&dev);
    hipDeviceGetAttribute(&cus, hipDeviceAttributeMultiprocessorCount, dev);
    hipOccupancyMaxActiveBlocksPerMultiprocessor(&per_cu, mega, 256, 0);
    if (per_cu < 1) per_cu = 1;
    if (per_cu > 2) per_cu = 2;
    grid_blocks = cus * per_cu;
    if (ws_size < WS_END) fprintf(stderr, "kernel_launch: workspace too small: %zu < %zu\n", ws_size, (size_t)WS_END);
  }
  P p{};
  const float** f = (const float**)&p;
  for (int i = 0; i < 25; ++i) f[i] = (const float*)d_in[i];
  p.out = (float*)d_out;
  p.ws = (char*)d_ws;
#if MK_MULTI
  for (int ph = 0; ph < N_PHASES; ++ph) {
    p.ph_lo = ph; p.ph_hi = ph + 1;
    hipLaunchKernelGGL(mega, dim3(grid_blocks), dim3(256), 0, stream, p);
  }
#else
  p.ph_lo = 0; p.ph_hi = N_PHASES;
  void* args[] = {&p};
  hipError_t e = hipLaunchCooperativeKernel((void*)mega, dim3(grid_blocks), dim3(256), args, 0, stream);
  if (e != hipSuccess) fprintf(stderr, "cooperative launch failed: %s (grid %d)\n", hipGetErrorString(e), grid_blocks);
#endif
}
```

```cpp
#include <hip/hip_runtime.h>
#include <hip/hip_cooperative_groups.h>
#include <cstdio>
namespace cg = cooperative_groups;

#ifndef MK_MULTI
#define MK_MULTI 0
#endif

typedef unsigned short u16;
using bf16x8 = __attribute__((ext_vector_type(8))) short;
using f32x16 = __attribute__((ext_vector_type(16))) float;
#define DI __device__ __forceinline__
#define MFMA(a, b, c) __builtin_amdgcn_mfma_f32_32x32x16_bf16((a), (b), (c), 0, 0, 0)

constexpr int TP = 8192;
constexpr int TT = 24576;
constexpr float EPS = 1e-6f;

constexpr size_t WS_MOD   = 0;
constexpr size_t WS_WIN0  = 131072;
constexpr size_t WS_WOUT0 = WS_WIN0 + (size_t)3584 * 1024 * 2;
constexpr size_t WS_WIN1  = WS_WOUT0 + (size_t)1024 * 1024 * 2;
constexpr size_t WS_WPOOL = WS_WIN1 + (size_t)2048 * 1024 * 2;
constexpr size_t WS_WOUT1 = WS_WPOOL + (size_t)4 * 256 * 256 * 2;
constexpr size_t WS_KC    = WS_WOUT1 + (size_t)1024 * 1024 * 2;
constexpr size_t WS_VTC   = WS_KC + (size_t)4 * 8 * 512 * 64 * 2;
constexpr size_t WS_R0    = WS_VTC + (size_t)4 * 8 * 512 * 64 * 2;
constexpr size_t RSZ      = (size_t)TT * 1024 * 2;
constexpr size_t WS_R1    = WS_R0 + RSZ;
constexpr size_t WS_R2    = WS_R1 + RSZ;
constexpr size_t WS_R3    = WS_R2 + RSZ;
constexpr size_t WS_BAR   = WS_R3 + RSZ;
constexpr size_t WS_END   = WS_BAR + 16384;
constexpr size_t HALF_R   = RSZ / 2;

struct P {
  const float *x_prompt, *x_sample, *cache_k, *cache_v, *c, *c_ctx;
  const float *norm_g0, *w_ada0, *b_ada0, *w_in0, *conv_w, *conv_b, *ln_g, *ln_b, *q_norm, *k_norm, *rpb, *w_out0;
  const float *norm_g1, *w_ada1, *b_ada1, *w_in1, *pool_w, *pool_scale, *w_out1;
  float* out;
  char* ws;
  int ph_lo, ph_hi;
};

DI u16 f2bf(float x) { unsigned u = __float_as_uint(x); u += 0x7fffu + ((u >> 16) & 1u); return (u16)(u >> 16); }
DI float bf2f(u16 v) { return __uint_as_float(((unsigned)v) << 16); }
DI unsigned pack2(float a, float b) { return (unsigned)f2bf(a) | ((unsigned)f2bf(b) << 16); }
DI float bflo(unsigned v) { return __uint_as_float(v << 16); }
DI float bfhi(unsigned v) { return __uint_as_float(v & 0xffff0000u); }
DI float silu_f(float x) { return x / (1.f + __expf(-x)); }
DI float sigm_f(float x) { return 1.f / (1.f + __expf(-x)); }
DI const float* xrow(const P& p, int t) { return t < TP ? p.x_prompt + (size_t)t * 1024 : p.x_sample + (size_t)(t - TP) * 1024; }
DI int midx(int t) { return t < TP ? 0 : 1 + ((t - TP) >> 12); }

constexpr int P0_ADA = 192, P0_TR = 2240, P0_KC = 256, P0_ITEMS = P0_ADA + P0_TR + P0_KC;

DI void p0_item(const P& p, int it, char* smem) {
  const int tid = threadIdx.x;
  if (it < P0_ADA) {
    const int layer = it / 96, n0 = (it % 96) * 32;
    float* sc = (float*)smem;
    float* red = (float*)(smem + 20480);
    for (int e = tid; e < 5120; e += 256) {
      const int j = e >> 10, k = e & 1023;
      const float v = (j == 0) ? p.c_ctx[k] : p.c[(j - 1) * 1024 + k];
      sc[e] = silu_f(v);
    }
    __syncthreads();
    const float* W = layer ? p.w_ada1 : p.w_ada0;
    const float* bias = layer ? p.b_ada1 : p.b_ada0;
    const int cq = tid & 7, kl = tid >> 3;
    float acc[5][4];
#pragma unroll
    for (int j = 0; j < 5; ++j) { acc[j][0] = acc[j][1] = acc[j][2] = acc[j][3] = 0.f; }
#pragma unroll 4
    for (int i = 0; i < 32; ++i) {
      const int k = kl + 32 * i;
      const float4 w = *(const float4*)(W + (size_t)k * 3072 + n0 + 4 * cq);
#pragma unroll
      for (int j = 0; j < 5; ++j) {
        const float s = sc[j * 1024 + k];
        acc[j][0] += s * w.x; acc[j][1] += s * w.y; acc[j][2] += s * w.z; acc[j][3] += s * w.w;
      }
    }
#pragma unroll
    for (int j = 0; j < 5; ++j)
#pragma unroll
      for (int a = 0; a < 4; ++a) red[((kl * 8 + cq) * 5 + j) * 4 + a] = acc[j][a];
    __syncthreads();
    if (tid < 160) {
      const int j = tid >> 5, col = tid & 31;
      float s = bias[n0 + col];
      for (int k2 = 0; k2 < 32; ++k2) s += red[((k2 * 8 + (col >> 2)) * 5 + j) * 4 + (col & 3)];
      ((float*)(p.ws + WS_MOD))[(layer * 5 + j) * 3072 + n0 + col] = s;
    }
  } else if (it < P0_ADA + P0_TR) {
    int j = it - P0_ADA;
    const float* src; u16* dst; int sstride, dstride, r0, n0; bool perm = false;
    if (j < 896) { src = p.w_in0; sstride = 3584; r0 = (j / 56) * 64; n0 = (j % 56) * 64; dst = (u16*)(p.ws + WS_WIN0); dstride = 1024; perm = true; }
    else if (j < 1152) { j -= 896; src = p.w_out0; sstride = 1024; r0 = (j / 16) * 64; n0 = (j % 16) * 64; dst = (u16*)(p.ws + WS_WOUT0); dstride = 1024; }
    else if (j < 1664) { j -= 1152; src = p.w_in1; sstride = 2048; r0 = (j / 32) * 64; n0 = (j % 32) * 64; dst = (u16*)(p.ws + WS_WIN1); dstride = 1024; }
    else if (j < 1728) { j -= 1664; const int g = j >> 4; src = p.pool_w + g * 65536; sstride = 256; r0 = ((j & 15) >> 2) * 64; n0 = (j & 3) * 64; dst = (u16*)(p.ws + WS_WPOOL) + g * 65536; dstride = 256; }
    else if (j < 1984) { j -= 1728; src = p.w_out1; sstride = 1024; r0 = (j / 16) * 64; n0 = (j % 16) * 64; dst = (u16*)(p.ws + WS_WOUT1); dstride = 1024; }
    else { j -= 1984; const int bh = j >> 3, mt = j & 7; src = p.cache_v + (size_t)(bh >> 3) * 512 * 512 + (bh & 7) * 64; sstride = 512; r0 = mt * 64; n0 = 0; dst = (u16*)(p.ws + WS_VTC) + (size_t)bh * 64 * 512; dstride = 512; }
    float* tile = (float*)smem;
    {
      int nn = n0 + (tid & 63);
      if (perm && nn < 1024) { const int w = nn >> 6, r = nn & 63; nn = (r < 32) ? (32 * w + r) : (512 + 32 * w + r - 32); }
#pragma unroll 4
      for (int i = 0; i < 16; ++i) {
        const int r = i * 4 + (tid >> 6);
        tile[r * 65 + (tid & 63)] = src[(size_t)(r0 + r) * sstride + nn];
      }
    }
    __syncthreads();
#pragma unroll 4
    for (int i = 0; i < 16; ++i) {
      const int n = i * 4 + (tid >> 6), k = tid & 63;
      dst[(size_t)(n0 + n) * dstride + r0 + k] = f2bf(tile[k * 65 + n]);
    }
  } else {
    const int it2 = it - P0_ADA - P0_TR;
    u16* kc = (u16*)(p.ws + WS_KC);
#pragma unroll 4
    for (int e = 0; e < 16; ++e) {
      const int o = it2 * 4096 + e * 256 + tid;
      const int d = o & 63, m = (o >> 6) & 511, bh = o >> 15;
      kc[o] = f2bf(p.cache_k[(((size_t)(bh >> 3) * 512 + m) * 8 + (bh & 7)) * 64 + d]);
    }
  }
}

DI void modnorm_item(const P& p, int it, int layer) {
  const int tid = threadIdx.x, lane = tid & 63, wave = tid >> 6;
  const int row0 = it * 32 + wave * 8;
  const float* g = layer ? p.norm_g1 : p.norm_g0;
  const float* mod = (const float*)(p.ws + WS_MOD) + (size_t)(layer * 5 + midx(row0)) * 3072;
  u16* H = (u16*)(p.ws + WS_R0);
  float4 a[4], b[4];
#pragma unroll
  for (int j = 0; j < 4; ++j) {
    const int col = j * 256 + lane * 4;
    const float4 gv = *(const float4*)(g + col);
    const float4 sh = *(const float4*)(mod + col);
    const float4 sv = *(const float4*)(mod + 1024 + col);
    a[j] = make_float4(gv.x * (1.f + sv.x), gv.y * (1.f + sv.y), gv.z * (1.f + sv.z), gv.w * (1.f + sv.w));
    b[j] = sh;
  }
#pragma unroll 2
  for (int r = 0; r < 8; ++r) {
    const int row = row0 + r;
    const float* xr = layer ? (p.out + (size_t)row * 1024) : xrow(p, row);
    float4 v[4];
    float ss = 0.f;
#pragma unroll
    for (int j = 0; j < 4; ++j) {
      v[j] = *(const float4*)(xr + j * 256 + lane * 4);
      ss += v[j].x * v[j].x + v[j].y * v[j].y + v[j].z * v[j].z + v[j].w * v[j].w;
    }
#pragma unroll
    for (int o = 32; o >= 1; o >>= 1) ss += __shfl_xor(ss, o);
    const float rinv = rsqrtf(ss * (1.f / 1024.f) + EPS);
#pragma unroll
    for (int j = 0; j < 4; ++j) {
      uint2 o2;
      o2.x = pack2(v[j].x * rinv * a[j].x + b[j].x, v[j].y * rinv * a[j].y + b[j].y);
      o2.y = pack2(v[j].z * rinv * a[j].z + b[j].z, v[j].w * rinv * a[j].w + b[j].w);
      *(uint2*)(H + (size_t)row * 1024 + j * 256 + lane * 4) = o2;
    }
  }
}

constexpr int LROW = 144;
constexpr int GSTAGE = 256 * LROW;
constexpr int SMEM_BYTES = 2 * GSTAGE;

DI void gemm_mainloop(const u16* __restrict__ Ag, int lda, const u16* __restrict__ Bg, int ldb, int K, char* smem, f32x16 (&acc)[2][2]) {
  const int tid = threadIdx.x, lane = tid & 63, wave = tid >> 6;
  const int wm = wave >> 1, wn = wave & 1;
  const int srow = tid >> 3, scol = tid & 7;
  const u16* ag = Ag + (size_t)srow * lda + scol * 8;
  const u16* bg = Bg + (size_t)srow * ldb + scol * 8;
  uint4 ra[4], rb[4];
#pragma unroll
  for (int i = 0; i < 4; ++i) { ra[i] = *(const uint4*)(ag + (size_t)(32 * i) * lda); rb[i] = *(const uint4*)(bg + (size_t)(32 * i) * ldb); }
  const int wofs = srow * LROW + scol * 16;
#pragma unroll
  for (int i = 0; i < 4; ++i) { *(uint4*)(smem + wofs + 32 * i * LROW) = ra[i]; *(uint4*)(smem + 128 * LROW + wofs + 32 * i * LROW) = rb[i]; }
  __syncthreads();
  const int aofs = (wm * 64 + (lane & 31)) * LROW + (lane >> 5) * 16;
  const int bofs = 128 * LROW + (wn * 64 + (lane & 31)) * LROW + (lane >> 5) * 16;
  const int nk = K >> 6;
  for (int kt = 0; kt < nk; ++kt) {
    const char* cur = smem + (kt & 1) * GSTAGE;
    char* nxt = smem + ((kt + 1) & 1) * GSTAGE;
    const bool more = (kt + 1 < nk);
    if (more) {
      const int ko = (kt + 1) * 64;
#pragma unroll
      for (int i = 0; i < 4; ++i) { ra[i] = *(const uint4*)(ag + (size_t)(32 * i) * lda + ko); rb[i] = *(const uint4*)(bg + (size_t)(32 * i) * ldb + ko); }
    }
#pragma unroll
    for (int ks = 0; ks < 4; ++ks) {
      bf16x8 af[2], bfr[2];
      af[0] = *(const bf16x8*)(cur + aofs + ks * 32);
      af[1] = *(const bf16x8*)(cur + aofs + 32 * LROW + ks * 32);
      bfr[0] = *(const bf16x8*)(cur + bofs + ks * 32);
      bfr[1] = *(const bf16x8*)(cur + bofs + 32 * LROW + ks * 32);
      acc[0][0] = MFMA(af[0], bfr[0], acc[0][0]);
      acc[0][1] = MFMA(af[0], bfr[1], acc[0][1]);
      acc[1][0] = MFMA(af[1], bfr[0], acc[1][0]);
      acc[1][1] = MFMA(af[1], bfr[1], acc[1][1]);
    }
    if (more) {
#pragma unroll
      for (int i = 0; i < 4; ++i) { *(uint4*)(nxt + wofs + 32 * i * LROW) = ra[i]; *(uint4*)(nxt + 128 * LROW + wofs + 32 * i * LROW) = rb[i]; }
    }
    __syncthreads();
  }
}

template <int EPI>
DI void gemm_item(const P& p, int item, char* smem) {
  const int tid = threadIdx.x, lane = tid & 63, wave = tid >> 6, l31 = lane & 31, hh = lane >> 5;
  const int wm = wave >> 1, wn = wave & 1;
  const u16 *A, *B; int lda, ldb, K, f0, t0, grp = 0;
  if (EPI == 1) { const int ft = item % 28, tt = item / 28; f0 = ft * 128; t0 = tt * 128; A = (const u16*)(p.ws + WS_WIN0) + (size_t)f0 * 1024; lda = 1024; B = (const u16*)(p.ws + WS_R0) + (size_t)t0 * 1024; ldb = 1024; K = 1024; }
  else if (EPI == 2) { const int ft = item % 8, tt = item / 8; f0 = ft * 128; t0 = tt * 128; A = (const u16*)(p.ws + WS_WOUT0) + (size_t)f0 * 1024; lda = 1024; B = (const u16*)(p.ws + WS_R0) + (size_t)t0 * 1024; ldb = 1024; K = 1024; }
  else if (EPI == 3) { const int ft = item % 16, tt = item / 16; f0 = ft * 128; t0 = tt * 128; A = (const u16*)(p.ws + WS_WIN1) + (size_t)f0 * 1024; lda = 1024; B = (const u16*)(p.ws + WS_R0) + (size_t)t0 * 1024; ldb = 1024; K = 1024; }
  else if (EPI == 4) { const int ft = item & 1, tt = item >> 3; grp = (item >> 1) & 3; f0 = ft * 128; t0 = tt * 128; A = (const u16*)(p.ws + WS_WPOOL) + grp * 65536 + (size_t)f0 * 256; lda = 256; B = (const u16*)(p.ws + WS_R3) + (size_t)t0 * 1024 + grp * 256; ldb = 1024; K = 256; }
  else { const int ft = item % 8, tt = item / 8; f0 = ft * 128; t0 = tt * 128; A = (const u16*)(p.ws + WS_WOUT1) + (size_t)f0 * 1024; lda = 1024; B = (const u16*)(p.ws + WS_R0) + (size_t)t0 * 1024; ldb = 1024; K = 1024; }

  f32x16 acc[2][2];
#pragma unroll
  for (int a = 0; a < 2; ++a)
#pragma unroll
    for (int b = 0; b < 2; ++b)
#pragma unroll
      for (int i = 0; i < 16; ++i) acc[a][b][i] = 0.f;
  gemm_mainloop(A, lda, B, ldb, K, smem, acc);

  const int fb = f0 + wm * 64;
  const int tokb = t0 + wn * 64;
  if (EPI == 1) {
    u16* U = (u16*)(p.ws + WS_R1);
    u16* SGA = (u16*)(p.ws + WS_R1 + HALF_R);
    u16* Q = (u16*)(p.ws + WS_R2);
    u16* Kb = (u16*)(p.ws + WS_R2 + HALF_R);
    u16* VT = (u16*)(p.ws + WS_R3);
    u16* SGB = (u16*)(p.ws + WS_R3 + HALF_R);
#pragma unroll
    for (int nj = 0; nj < 2; ++nj) {
      const int tok = tokb + nj * 32 + l31;
      if (fb < 1024) {
        const int cb = (fb >> 6) * 32;
#pragma unroll
        for (int g = 0; g < 4; ++g) {
          float u[4];
#pragma unroll
          for (int a = 0; a < 4; ++a) u[a] = acc[0][nj][4 * g + a] * sigm_f(acc[1][nj][4 * g + a]);
          uint2 o; o.x = pack2(u[0], u[1]); o.y = pack2(u[2], u[3]);
          *(uint2*)(U + (size_t)tok * 512 + cb + 8 * g + 4 * hh) = o;
        }
      } else if (fb < 1536 || fb >= 3072) {
        u16* dst = (fb < 1536) ? (SGA + (size_t)tok * 512 + (fb - 1024)) : (SGB + (size_t)tok * 512 + (fb - 3072));
#pragma unroll
        for (int mi = 0; mi < 2; ++mi)
#pragma unroll
          for (int g = 0; g < 4; ++g) {
            uint2 o;
            o.x = pack2(silu_f(acc[mi][nj][4 * g]), silu_f(acc[mi][nj][4 * g + 1]));
            o.y = pack2(silu_f(acc[mi][nj][4 * g + 2]), silu_f(acc[mi][nj][4 * g + 3]));
            *(uint2*)(dst + mi * 32 + 8 * g + 4 * hh) = o;
          }
      } else if (fb < 2560) {
        const bool isq = fb < 2048;
        const int hc = isq ? (fb - 1536) : (fb - 2048);
        float ss = 0.f;
#pragma unroll
        for (int mi = 0; mi < 2; ++mi)
#pragma unroll
          for (int i = 0; i < 16; ++i) ss += acc[mi][nj][i] * acc[mi][nj][i];
        ss += __shfl_xor(ss, 32);
        float rinv = rsqrtf(ss * (1.f / 64.f) + EPS);
        const float* nw = isq ? p.q_norm : p.k_norm;
        const float qs = isq ? 0.125f : 1.f;
        u16* dst = (isq ? Q : Kb) + (size_t)tok * 512 + hc;
#pragma unroll
        for (int mi = 0; mi < 2; ++mi)
#pragma unroll
          for (int g = 0; g < 4; ++g) {
            const int d = mi * 32 + 8 * g + 4 * hh;
            const float4 w = *(const float4*)(nw + d);
            float4 v;
            v.x = acc[mi][nj][4 * g] * rinv * w.x; v.y = acc[mi][nj][4 * g + 1] * rinv * w.y;
            v.z = acc[mi][nj][4 * g + 2] * rinv * w.z; v.w = acc[mi][nj][4 * g + 3] * rinv * w.w;
            if (!isq && tok < TP) *(float4*)(p.out + (size_t)TT * 1024 + (size_t)tok * 512 + hc + d) = v;
            uint2 o; o.x = pack2(v.x * qs, v.y * qs); o.y = pack2(v.z * qs, v.w * qs);
            *(uint2*)(dst + d) = o;
          }
      } else {
        const int hc = fb - 2560;
#pragma unroll
        for (int mi = 0; mi < 2; ++mi)
#pragma unroll
          for (int g = 0; g < 4; ++g) {
            const int d = mi * 32 + 8 * g + 4 * hh;
            if (tok < TP) {
              float4 v; v.x = acc[mi][nj][4 * g]; v.y = acc[mi][nj][4 * g + 1]; v.z = acc[mi][nj][4 * g + 2]; v.w = acc[mi][nj][4 * g + 3];
              *(float4*)(p.out + (size_t)TT * 1024 + (size_t)TP * 512 + (size_t)tok * 512 + hc + d) = v;
            }
#pragma unroll
            for (int a = 0; a < 4; ++a) VT[(size_t)(hc + d + a) * TT + tok] = f2bf(acc[mi][nj][4 * g + a]);
          }
      }
    }
  } else if (EPI == 2 || EPI == 5) {
    const int layer = (EPI == 2) ? 0 : 1;
#pragma unroll
    for (int nj = 0; nj < 2; ++nj) {
      const int tok = tokb + nj * 32 + l31;
      const float* gate = (const float*)(p.ws + WS_MOD) + (size_t)(layer * 5 + midx(tok)) * 3072 + 2048;
      const float* xr = (EPI == 2) ? xrow(p, tok) : (p.out + (size_t)tok * 1024);
      float* yr = p.out + (size_t)tok * 1024;
#pragma unroll
      for (int mi = 0; mi < 2; ++mi)
#pragma unroll
        for (int g = 0; g < 4; ++g) {
          const int col = fb + mi * 32 + 8 * g + 4 * hh;
          const float4 xv = *(const float4*)(xr + col);
          const float4 gv = *(const float4*)(gate + col);
          float4 o;
          o.x = xv.x + gv.x * acc[mi][nj][4 * g]; o.y = xv.y + gv.y * acc[mi][nj][4 * g + 1];
          o.z = xv.z + gv.z * acc[mi][nj][4 * g + 2]; o.w = xv.w + gv.w * acc[mi][nj][4 * g + 3];
          *(float4*)(yr + col) = o;
        }
    }
  } else if (EPI == 3) {
    u16* U1 = (u16*)(p.ws + WS_R1);
    u16* SG1 = (u16*)(p.ws + WS_R2);
#pragma unroll
    for (int nj = 0; nj < 2; ++nj) {
      const int tok = tokb + nj * 32 + l31;
#pragma unroll
      for (int mi = 0; mi < 2; ++mi)
#pragma unroll
        for (int g = 0; g < 4; ++g) {
          const int col = fb + mi * 32 + 8 * g + 4 * hh;
          uint2 o;
          if (fb < 1024) {
            o.x = pack2(acc[mi][nj][4 * g], acc[mi][nj][4 * g + 1]); o.y = pack2(acc[mi][nj][4 * g + 2], acc[mi][nj][4 * g + 3]);
            *(uint2*)(U1 + (size_t)tok * 1024 + col) = o;
          } else {
            o.x = pack2(silu_f(acc[mi][nj][4 * g]), silu_f(acc[mi][nj][4 * g + 1])); o.y = pack2(silu_f(acc[mi][nj][4 * g + 2]), silu_f(acc[mi][nj][4 * g + 3]));
            *(uint2*)(SG1 + (size_t)tok * 1024 + col - 1024) = o;
          }
        }
    }
  } else {
    const u16* SG1 = (const u16*)(p.ws + WS_R2);
    u16* Z1 = (u16*)(p.ws + WS_R0);
#pragma unroll
    for (int nj = 0; nj < 2; ++nj) {
      const int tok = tokb + nj * 32 + l31;
#pragma unroll
      for (int mi = 0; mi < 2; ++mi)
#pragma unroll
        for (int g = 0; g < 4; ++g) {
          const int col = grp * 256 + fb + mi * 32 + 8 * g + 4 * hh;
          const float4 sc = *(const float4*)(p.pool_scale + col);
          const uint2 sg = *(const uint2*)(SG1 + (size_t)tok * 1024 + col);
          uint2 o;
          o.x = pack2(acc[mi][nj][4 * g] * sc.x * bflo(sg.x), acc[mi][nj][4 * g + 1] * sc.y * bfhi(sg.x));
          o.y = pack2(acc[mi][nj][4 * g + 2] * sc.z * bflo(sg.y), acc[mi][nj][4 * g + 3] * sc.w * bfhi(sg.y));
          *(uint2*)(Z1 + (size_t)tok * 1024 + col) = o;
        }
    }
  }
}

constexpr int P3_NA = 1024, P3_CTX = 512, P3_CONV = 3072, P3_ITEMS = P3_NA + P3_CTX + P3_CONV;

DI void conv_item(const P& p, int it, char* smem) {
  const int tid = threadIdx.x, lane = tid & 63, wave = tid >> 6;
  const int t0 = it * 8;
  int s0, s1;
  if (t0 < TP) { s0 = t0 & ~255; s1 = s0 + 256; } else { s0 = TP + ((t0 - TP) & ~4095); s1 = s0 + 4096; }
  const int c = 2 * tid;
  const u16* U = (const u16*)(p.ws + WS_R1);
  const u16* SGA = (const u16*)(p.ws + WS_R1 + HALF_R);
  u16* Z = (u16*)(p.ws + WS_R0);
  float y0[8], y1[8];
#pragma unroll
  for (int i = 0; i < 8; ++i) { y0[i] = 0.f; y1[i] = 0.f; }
#pragma unroll 1
  for (int hf = 0; hf < 2; ++hf) {
    float w0[16], w1[16];
    const float* wp = p.conv_w + hf * 16 * 512 + c;
#pragma unroll
    for (int jj = 0; jj < 16; ++jj) {
      float2 w = make_float2(0.f, 0.f);
      if (jj < 15 || hf == 0) w = *(const float2*)(wp + jj * 512);
      w0[jj] = w.x; w1[jj] = w.y;
    }
    const int tb = t0 - 15 + hf * 16;
#pragma unroll
    for (int r = 0; r < 23; ++r) {
      const int trow = tb + r;
      unsigned v = 0u;
      if (trow >= s0 && trow < s1) v = *(const unsigned*)(U + (size_t)trow * 512 + c);
      const float v0 = bflo(v), v1 = bfhi(v);
#pragma unroll
      for (int i = 0; i < 8; ++i) {
        const int jj = r - i;
        if (jj >= 0 && jj <= 15) { y0[i] += v0 * w0[jj]; y1[i] += v1 * w1[jj]; }
      }
    }
  }
  const float2 cb = *(const float2*)(p.conv_b + c);
  float vals[16];
#pragma unroll
  for (int i = 0; i < 8; ++i) {
    y0[i] += cb.x; y1[i] += cb.y;
    vals[i] = y0[i] + y1[i];
    vals[8 + i] = y0[i] * y0[i] + y1[i] * y1[i];
  }
#pragma unroll
  for (int half = 8, bit = 32; half >= 1; half >>= 1, bit >>= 1) {
    const bool up = (lane & bit) != 0;
#pragma unroll
    for (int k = 0; k < half; ++k) {
      const float keep = up ? vals[k + half] : vals[k];
      const float send = up ? vals[k] : vals[k + half];
      vals[k] = keep + __shfl_xor(send, bit);
    }
  }
  vals[0] += __shfl_xor(vals[0], 2);
  vals[0] += __shfl_xor(vals[0], 1);
  float* red = (float*)smem;
  float* stat = (float*)smem + 64;
  if ((lane & 3) == 0) red[wave * 16 + (lane >> 2)] = vals[0];
  __syncthreads();
  if (tid < 16) stat[tid] = red[tid] + red[16 + tid] + red[32 + tid] + red[48 + tid];
  __syncthreads();
  const float2 lg = *(const float2*)(p.ln_g + c);
  const float2 lb = *(const float2*)(p.ln_b + c);
#pragma unroll
  for (int i = 0; i < 8; ++i) {
    const float mean = stat[i] * (1.f / 512.f);
    const float var = fmaxf(stat[8 + i] * (1.f / 512.f) - mean * mean, 0.f);
    const float rstd = rsqrtf(var + EPS);
    const int tok = t0 + i;
    const unsigned ga = *(const unsigned*)(SGA + (size_t)tok * 512 + c);
    const float a0 = (y0[i] - mean) * rstd * lg.x + lb.x;
    const float a1 = (y1[i] - mean) * rstd * lg.y + lb.y;
    *(unsigned*)(Z + (size_t)tok * 1024 + c) = pack2(silu_f(a0) * bflo(ga), silu_f(a1) * bfhi(ga));
  }
}

constexpr int ACH = 64 * LROW;
constexpr int ABUF = 2 * ACH;
DI int crow(int i, int hh) { return (i & 3) + 8 * (i >> 2) + 4 * hh; }

DI void attn_item(const P& p, int it, char* smem) {
  const int tid = threadIdx.x, lane = tid & 63, wave = tid >> 6, l31 = lane & 31, hh = lane >> 5;
  const bool is_na = it < P3_NA;
  const u16* Qb = (const u16*)(p.ws + WS_R2);
  const u16* Kb = (const u16*)(p.ws + WS_R2 + HALF_R);
  const u16* VT = (const u16*)(p.ws + WS_R3);
  const u16* SGB = (const u16*)(p.ws + WS_R3 + HALF_R);
  const u16* KC = (const u16*)(p.ws + WS_KC);
  const u16* VTC = (const u16*)(p.ws + WS_VTC);
  u16* Z = (u16*)(p.ws + WS_R0);
  int b, head, qtok, nchunks, tokbase;
  int r = 0, c = 0, qcs = 0, rsw = 0, rs_lo = 0;
  if (is_na) {
    b = it >> 8; head = (it >> 5) & 7; const int r0 = 2 * (it & 31);
    r = r0 + (wave >> 1); c = (wave & 1) * 32 + l31;
    qcs = min(max(c - 8, 0), 48);
    rsw = min(max(r - 4, 0), 56);
    rs_lo = min(max(r0 - 4, 0), 56);
    const int rs_hi = min(max(r0 - 3, 0), 56);
    tokbase = TP + b * 4096;
    qtok = tokbase + r * 64 + c;
    nchunks = 8 + rs_hi + 8 - rs_lo;
  } else {
    const int j = it - P3_NA;
    b = j >> 4; head = (j >> 1) & 7;
    tokbase = b * 256;
    qtok = tokbase + (j & 1) * 128 + wave * 32 + l31;
    nchunks = 4;
  }
  float* rpb_s = (float*)(smem + 2 * ABUF);
  if (is_na) for (int i = tid; i < 465; i += 256) rpb_s[i] = p.rpb[head * 465 + i];

  bf16x8 qf[4];
#pragma unroll
  for (int ks = 0; ks < 4; ++ks) qf[ks] = *(const bf16x8*)(Qb + (size_t)qtok * 512 + head * 64 + ks * 16 + hh * 8);

  f32x16 o0, o1;
#pragma unroll
  for (int i = 0; i < 16; ++i) { o0[i] = 0.f; o1[i] = 0.f; }
  float m_run = -INFINITY, l_run = 0.f;

  const int prow = tid >> 3, ppart = tid & 7;
  const int vpos0 = (16 * (ppart >> 1) + 4 * (ppart & 1)) * 2, vpos1 = vpos0 + 16;
  uint4 kreg0, kreg1, vreg0, vreg1;
#define LOAD_CHUNK(ci_) do { \
    const int ci__ = (ci_); const u16 *kp, *vp; size_t ks_, vs_; \
    if (is_na && ci__ < 8) { \
      kp = KC + ((size_t)(b * 8 + head) * 512 + ci__ * 64) * 64; ks_ = 64; \
      vp = VTC + (size_t)(b * 8 + head) * 64 * 512 + ci__ * 64; vs_ = 512; \
    } else { \
      const int kt0 = is_na ? (tokbase + (rs_lo + ci__ - 8) * 64) : (tokbase + ci__ * 64); \
      kp = Kb + (size_t)kt0 * 512 + head * 64; ks_ = 512; \
      vp = VT + (size_t)(head * 64) * TT + kt0; vs_ = TT; \
    } \
    kreg0 = *(const uint4*)(kp + (size_t)prow * ks_ + ppart * 8); \
    kreg1 = *(const uint4*)(kp + (size_t)(prow + 32) * ks_ + ppart * 8); \
    vreg0 = *(const uint4*)(vp + (size_t)prow * vs_ + ppart * 8); \
    vreg1 = *(const uint4*)(vp + (size_t)(prow + 32) * vs_ + ppart * 8); \
  } while (0)
#define STORE_CHUNK(buf_) do { \
    char* bb_ = (buf_); \
    *(uint4*)(bb_ + prow * LROW + ppart * 16) = kreg0; \
    *(uint4*)(bb_ + (prow + 32) * LROW + ppart * 16) = kreg1; \
    char* vr0 = bb_ + ACH + prow * LROW; char* vr1 = bb_ + ACH + (prow + 32) * LROW; \
    *(uint2*)(vr0 + vpos0) = make_uint2(vreg0.x, vreg0.y); *(uint2*)(vr0 + vpos1) = make_uint2(vreg0.z, vreg0.w); \
    *(uint2*)(vr1 + vpos0) = make_uint2(vreg1.x, vreg1.y); *(uint2*)(vr1 + vpos1) = make_uint2(vreg1.z, vreg1.w); \
  } while (0)
  LOAD_CHUNK(0);
  STORE_CHUNK(smem);
  __syncthreads();
  for (int ci = 0; ci < nchunks; ++ci) {
    const char* cur = smem + (ci & 1) * ABUF;
    const bool more = ci + 1 < nchunks;
    if (more) LOAD_CHUNK(ci + 1);
    bool act = true, window = false; int rowidx = 0;
    if (is_na && ci >= 8) { const int kr = rs_lo + ci - 8; act = (kr >= rsw) && (kr < rsw + 8); window = true; rowidx = kr - r + 7; }
    if (act) {
#pragma unroll 1
      for (int kt = 0; kt < 2; ++kt) {
        f32x16 s;
#pragma unroll
        for (int i = 0; i < 16; ++i) s[i] = 0.f;
#pragma unroll
        for (int ks = 0; ks < 4; ++ks) {
          const bf16x8 a = *(const bf16x8*)(cur + (kt * 32 + l31) * LROW + ks * 32 + hh * 16);
          s = MFMA(a, qf[ks], s);
        }
        if (window) {
#pragma unroll
          for (int i = 0; i < 16; ++i) {
            const int kc = kt * 32 + crow(i, hh);
            const bool valid = (kc >= qcs) && (kc < qcs + 16);
            const int bi = min(max(kc - c + 15, 0), 30);
            const float bias = rpb_s[rowidx * 31 + bi];
            s[i] = valid ? (s[i] + bias) : -INFINITY;
          }
        }
        float mx = s[0];
#pragma unroll
        for (int i = 1; i < 16; ++i) mx = fmaxf(mx, s[i]);
        mx = fmaxf(mx, __shfl_xor(mx, 32));
        const float m_new = fmaxf(m_run, mx);
        const float alpha = __expf(m_run - m_new);
        m_run = m_new;
        float ps = 0.f;
#pragma unroll
        for (int i = 0; i < 16; ++i) { s[i] = __expf(s[i] - m_new); ps += s[i]; }
        l_run = l_run * alpha + ps;
#pragma unroll
        for (int i = 0; i < 16; ++i) { o0[i] *= alpha; o1[i] *= alpha; }
#pragma unroll
        for (int sidx = 0; sidx < 2; ++sidx) {
          union { unsigned u[4]; bf16x8 v; } pb;
#pragma unroll
          for (int q2 = 0; q2 < 4; ++q2) pb.u[q2] = pack2(s[8 * sidx + 2 * q2], s[8 * sidx + 2 * q2 + 1]);
          const bf16x8 a0 = *(const bf16x8*)(cur + ACH + l31 * LROW + (kt * 32 + 16 * sidx + 8 * hh) * 2);
          const bf16x8 a1 = *(const bf16x8*)(cur + ACH + (32 + l31) * LROW + (kt * 32 + 16 * sidx + 8 * hh) * 2);
          o0 = MFMA(a0, pb.v, o0);
          o1 = MFMA(a1, pb.v, o1);
        }
      }
    }
    if (more) STORE_CHUNK(smem + ((ci + 1) & 1) * ABUF);
    __syncthreads();
  }
  const float lt = l_run + __shfl_xor(l_run, 32);
  const float inv = 1.f / lt;
#pragma unroll
  for (int dt = 0; dt < 2; ++dt)
#pragma unroll
    for (int g = 0; g < 4; ++g) {
      const int d = dt * 32 + 8 * g + 4 * hh;
      const uint2 sg = *(const uint2*)(SGB + (size_t)qtok * 512 + head * 64 + d);
      const f32x16& o = dt ? o1 : o0;
      uint2 ov;
      ov.x = pack2(o[4 * g] * inv * bflo(sg.x), o[4 * g + 1] * inv * bfhi(sg.x));
      ov.y = pack2(o[4 * g + 2] * inv * bflo(sg.y), o[4 * g + 3] * inv * bfhi(sg.y));
      *(uint2*)(Z + (size_t)qtok * 1024 + 512 + head * 64 + d) = ov;
    }
}

DI void pool_item(const P& p, int it) {
  const int tid = threadIdx.x, wave = tid >> 6;
  const int t0 = it * 32;
  int s0, s1;
  if (t0 < TP) { s0 = t0 & ~255; s1 = s0 + 256; } else { s0 = TP + ((t0 - TP) & ~4095); s1 = s0 + 4096; }
  const int w = 2 << wave, hw = w >> 1;
  const int c = 4 * tid;
  const u16* U1 = (const u16*)(p.ws + WS_R1);
  u16* Dd = (u16*)(p.ws + WS_R3);
  float sx = 0.f, sy = 0.f, sz = 0.f, sw = 0.f;
  int lo = max(t0 - hw, s0), hi = min(t0 + w - hw, s1);
  for (int t = lo; t < hi; ++t) {
    const uint2 v = *(const uint2*)(U1 + (size_t)t * 1024 + c);
    sx += bflo(v.x); sy += bfhi(v.x); sz += bflo(v.y); sw += bfhi(v.y);
  }
  for (int t = t0; t < t0 + 32; ++t) {
    const int nlo = max(t - hw, s0), nhi = min(t + w - hw, s1);
    if (nhi > hi) { const uint2 v = *(const uint2*)(U1 + (size_t)(nhi - 1) * 1024 + c); sx += bflo(v.x); sy += bfhi(v.x); sz += bflo(v.y); sw += bfhi(v.y); }
    if (nlo > lo) { const uint2 v = *(const uint2*)(U1 + (size_t)lo * 1024 + c); sx -= bflo(v.x); sy -= bfhi(v.x); sz -= bflo(v.y); sw -= bfhi(v.y); }
    lo = nlo; hi = nhi;
    const float rc = 1.f / (float)(hi - lo);
    const uint2 cv = *(const uint2*)(U1 + (size_t)t * 1024 + c);
    uint2 o;
    o.x = pack2(sx * rc - bflo(cv.x), sy * rc - bfhi(cv.x));
    o.y = pack2(sz * rc - bflo(cv.y), sw * rc - bfhi(cv.y));
    *(uint2*)(Dd + (size_t)t * 1024 + c) = o;
  }
}


#define XB_TMO      128
#define XB_XCNT(j)  (256  + 64 * (j))
#define XB_XSUB(j)  (1280 + 64 * (j))
#define XB_XGEN(j)  (2304 + 64 * (j))
#define XB_TOP      3328
#define XB_TOPGEN   3392
#define XCD_BAR_WORDS 3456
#define XB_SPIN_CAP (1u << 22)
#define LAS __attribute__((address_space(3)))
DI unsigned xb_ld(unsigned* p)              { return __hip_atomic_load(p, __ATOMIC_RELAXED, __HIP_MEMORY_SCOPE_AGENT); }
DI unsigned xb_add(unsigned* p, unsigned v) { return __hip_atomic_fetch_add(p, v, __ATOMIC_RELAXED, __HIP_MEMORY_SCOPE_AGENT); }
DI unsigned xb_xcc_id() { return (unsigned)__builtin_amdgcn_s_getreg((3 << 11) | 20) & 0xFu; }
#define XB_SPIN(cond, bar) do { unsigned _sp = 0; while (cond) { __builtin_amdgcn_s_sleep(1); \
    if ((++_sp & 255u) == 0u) { if (xb_ld(&(bar)[XB_TMO])) break; if (_sp > XB_SPIN_CAP) { atomicAdd(&(bar)[XB_TMO], 1u); break; } } } } while (0)
struct XcdBarrier { unsigned* bar; unsigned x; volatile LAS unsigned* st; };
DI XcdBarrier xcd_barrier_post(unsigned* bar, volatile LAS unsigned* st) {
  XcdBarrier b; b.bar = bar; b.x = xb_xcc_id(); b.st = st;
  if (threadIdx.x == 0) (void)xb_add(&bar[XB_XCNT(b.x)], 1u);
  return b;
}
DI void xcd_barrier_complete(unsigned* bar, unsigned x, unsigned& nloc, unsigned& nx) {
  const unsigned G = gridDim.x * gridDim.y * gridDim.z;
  unsigned sum, cnt, mine, sp = 0u;
  for (;;) {
    sum = 0u; cnt = 0u; mine = 0u;
#pragma unroll
    for (unsigned j = 0; j < 16; ++j) { const unsigned c = xb_ld(&bar[XB_XCNT(j)]); sum += c; cnt += (c > 0u) ? 1u : 0u; mine = (j == x) ? c : mine; }
    if (sum == G) break;
    __builtin_amdgcn_s_sleep(1);
    if ((++sp & 255u) == 0u) { if (xb_ld(&bar[XB_TMO])) break; if (sp > XB_SPIN_CAP) { atomicAdd(&bar[XB_TMO], 1u); break; } }
  }
  nloc = mine > 0u ? mine : 1u; nx = cnt > 0u ? cnt : 1u;
}
DI void xcd_barrier(const XcdBarrier& b) {
  asm volatile("s_waitcnt vmcnt(0)" ::: "memory");
  __syncthreads();
  if (threadIdx.x == 0) {
    unsigned* bar = b.bar;
    __builtin_amdgcn_s_waitcnt(0);
    unsigned nloc = b.st[0], nx = b.st[1];
    if (nloc == 0u) { xcd_barrier_complete(bar, b.x, nloc, nx); b.st[0] = nloc; b.st[1] = nx; }
    const unsigned old = xb_add(&bar[XB_XSUB(b.x)], 1u);
    const unsigned gen = old / nloc;
    if (old + 1u == (gen + 1u) * nloc) {
      __builtin_amdgcn_fence(__ATOMIC_RELEASE, "agent");
      asm volatile("s_waitcnt vmcnt(0)" ::: "memory");
      const unsigned og = xb_add(&bar[XB_TOP], 1u);
      const unsigned tg = og / nx;
      if (og + 1u == (tg + 1u) * nx) xb_add(&bar[XB_TOPGEN], 1u);
      else XB_SPIN(xb_ld(&bar[XB_TOPGEN]) == tg, bar);
      __builtin_amdgcn_fence(__ATOMIC_ACQUIRE, "agent");
      xb_add(&bar[XB_XGEN(b.x)], 1u);
      asm volatile("s_waitcnt vmcnt(0)" ::: "memory");
    } else {
      XB_SPIN(xb_ld(&bar[XB_XGEN(b.x)]) == gen, bar);
      __builtin_amdgcn_fence(__ATOMIC_ACQUIRE, "agent");
      asm volatile("s_waitcnt vmcnt(0)" ::: "memory");
    }
  }
  __syncthreads();
}

constexpr int N_PHASES = 10;
#define PHASE_NS(k, n, call) \
  if (p.ph_lo <= (k) && (k) < p.ph_hi) { \
    for (int it = blockIdx.x; it < (n); it += gridDim.x) { __syncthreads(); call; } \
  }
#define PHASE(k, n, call) \
  PHASE_NS(k, n, call) \
  if (p.ph_lo <= (k) && (k) + 1 < p.ph_hi) { if ((k) == 0) grid.sync(); else xcd_barrier(xb); }

__global__ void __launch_bounds__(256, 2) mega(P p) {
  __shared__ __attribute__((aligned(16))) char smem[SMEM_BYTES + 16];
  cg::grid_group grid = cg::this_grid();
  volatile LAS unsigned* xst = (volatile LAS unsigned*)(smem + SMEM_BYTES);
  if (threadIdx.x == 0) { xst[0] = 0u; xst[1] = 0u; }
  __syncthreads();
  XcdBarrier xb = xcd_barrier_post((unsigned*)(p.ws + WS_BAR), xst);
  PHASE(0, P0_ITEMS, p0_item(p, it, smem))
  PHASE(1, 768, modnorm_item(p, it, 0))
  PHASE(2, 28 * 192, gemm_item<1>(p, it, smem))
  PHASE_NS(3, P3_NA + P3_CTX, attn_item(p, it, smem))
  PHASE(3, P3_CONV, conv_item(p, (it + 1024) % P3_CONV, smem))
  PHASE(4, 8 * 192, gemm_item<2>(p, it, smem))
  PHASE(5, 768, modnorm_item(p, it, 1))
  PHASE(6, 16 * 192, gemm_item<3>(p, it, smem))
  PHASE(7, 768, pool_item(p, it))
  PHASE(8, 8 * 192, gemm_item<4>(p, it, smem))
  PHASE(9, 8 * 192, gemm_item<5>(p, it, smem))
}

extern "C" void kernel_launch(void* const* d_in, const int* in_sizes, int n_in, void* d_out, int out_size, void* d_ws, size_t ws_size, hipStream_t stream) {
  static int grid_blocks = 0;
  if (!grid_blocks) {
    int dev = 0, cus = 0, per_cu = 0;
    hipGetDevice(&dev);
    hipDeviceGetAttribute(&cus, hipDeviceAttributeMultiprocessorCount, dev);
    hipOccupancyMaxActiveBlocksPerMultiprocessor(&per_cu, mega, 256, 0);
    if (per_cu < 1) per_cu = 1;
    if (per_cu > 2) per_cu = 2;
    grid_blocks = cus * per_cu;
    if (ws_size < WS_END) fprintf(stderr, "kernel_launch: workspace too small: %zu < %zu\n", ws_size, (size_t)WS_END);
  }
  P p{};
  const float** f = (const float**)&p;
  for (int i = 0; i < 25; ++i) f[i] = (const float*)d_in[i];
  p.out = (float*)d_out;
  p.ws = (char*)d_ws;
#if MK_MULTI
  for (int ph = 0; ph < N_PHASES; ++ph) {
    p.ph_lo = ph; p.ph_hi = ph + 1;
    hipLaunchKernelGGL(mega, dim3(grid_blocks), dim3(256), 0, stream, p);
  }
#else
  p.ph_lo = 0; p.ph_hi = N_PHASES;
  hipMemsetAsync((char*)d_ws + WS_BAR, 0, XCD_BAR_WORDS * 4, stream);
  void* args[] = {&p};
  hipError_t e = hipLaunchCooperativeKernel((void*)mega, dim3(grid_blocks), dim3(256), args, 0, stream);
  if (e != hipSuccess) fprintf(stderr, "cooperative launch failed: %s (grid %d)\n", hipGetErrorString(e), grid_blocks);
#endif
}
```

```cpp
#include <hip/hip_runtime.h>
#include <hip/hip_cooperative_groups.h>
#include <cstdio>
namespace cg = cooperative_groups;

#ifndef GD
#define GD 3
#endif
#ifndef MK_MULTI
#define MK_MULTI 0
#endif

typedef unsigned short u16;
using bf16x8 = __attribute__((ext_vector_type(8))) short;
using f32x16 = __attribute__((ext_vector_type(16))) float;
#define DI __device__ __forceinline__
#define MFMA(a, b, c) __builtin_amdgcn_mfma_f32_32x32x16_bf16((a), (b), (c), 0, 0, 0)

constexpr int TP = 8192;
constexpr int TT = 24576;
constexpr float EPS = 1e-6f;

constexpr size_t WS_MOD   = 0;
constexpr size_t WS_WIN0  = 131072;
constexpr size_t WS_WOUT0 = WS_WIN0 + (size_t)3584 * 1024 * 2;
constexpr size_t WS_WIN1  = WS_WOUT0 + (size_t)1024 * 1024 * 2;
constexpr size_t WS_WPOOL = WS_WIN1 + (size_t)2048 * 1024 * 2;
constexpr size_t WS_WOUT1 = WS_WPOOL + (size_t)4 * 256 * 256 * 2;
constexpr size_t WS_KC    = WS_WOUT1 + (size_t)1024 * 1024 * 2;
constexpr size_t WS_VTC   = WS_KC + (size_t)4 * 8 * 512 * 64 * 2;
constexpr size_t WS_R0    = WS_VTC + (size_t)4 * 8 * 512 * 64 * 2;
constexpr size_t RSZ      = (size_t)TT * 1024 * 2;
constexpr size_t WS_R1    = WS_R0 + RSZ;
constexpr size_t WS_R2    = WS_R1 + RSZ;
constexpr size_t WS_R3    = WS_R2 + RSZ;
constexpr size_t WS_BAR   = WS_R3 + RSZ;
constexpr size_t WS_UP    = WS_BAR + 16384;
constexpr size_t WS_SS    = WS_UP + (size_t)(24576 + 36 * 32) * 1024;
constexpr size_t WS_SW    = WS_SS + (size_t)TT * 4;
constexpr size_t WS_END   = WS_SW + 5 * 2048 * 4;
constexpr size_t HALF_R   = RSZ / 2;

struct P {
  const float *x_prompt, *x_sample, *cache_k, *cache_v, *c, *c_ctx;
  const float *norm_g0, *w_ada0, *b_ada0, *w_in0, *conv_w, *conv_b, *ln_g, *ln_b, *q_norm, *k_norm, *rpb, *w_out0;
  const float *norm_g1, *w_ada1, *b_ada1, *w_in1, *pool_w, *pool_scale, *w_out1;
  float* out;
  char* ws;
  int ph_lo, ph_hi, flags, pad;
};

typedef __bf16 hbf16x2 __attribute__((ext_vector_type(2)));
typedef float hf32x2 __attribute__((ext_vector_type(2)));
DI unsigned pack2(float a, float b) { hf32x2 v = {a, b}; hbf16x2 r = __builtin_convertvector(v, hbf16x2); return __builtin_bit_cast(unsigned, r); }
DI u16 f2bf(float x) { return (u16)(pack2(x, 0.f) & 0xffffu); }
DI float bf2f(u16 v) { return __uint_as_float(((unsigned)v) << 16); }
DI void swap32v(f32x16& x, f32x16& y) {
#pragma unroll
  for (int i = 0; i < 16; ++i) {
    auto r = __builtin_amdgcn_permlane32_swap(__float_as_uint(x[i]), __float_as_uint(y[i]), false, false);
    x[i] = __uint_as_float(r[0]); y[i] = __uint_as_float(r[1]);
  }
}
DI void swap32(float& x, float& y) {
  auto r = __builtin_amdgcn_permlane32_swap(__float_as_uint(x), __float_as_uint(y), false, false);
  x = __uint_as_float(r[0]); y = __uint_as_float(r[1]);
}
DI float bflo(unsigned v) { return __uint_as_float(v << 16); }
DI float bfhi(unsigned v) { return __uint_as_float(v & 0xffff0000u); }
DI float silu_f(float x) { return x / (1.f + __expf(-x)); }
DI float sigm_f(float x) { return 1.f / (1.f + __expf(-x)); }
DI const float* xrow(const P& p, int t) { return t < TP ? p.x_prompt + (size_t)t * 1024 : p.x_sample + (size_t)(t - TP) * 1024; }
DI int midx(int t) { return t < TP ? 0 : 1 + ((t - TP) >> 12); }
DI int prow(int t) { const int seq = t < TP ? (t >> 8) : 32 + ((t - TP) >> 12); return t + 32 * seq + 16; }

constexpr int P0_ADA = 384, P0_TR = 2240, P0_KC = 256, P0_PAD = 36, P0_SS = 6, P0_ITEMS = P0_ADA + P0_TR + P0_KC + P0_PAD + P0_SS;

DI void p0_item(const P& p, int it, char* smem, int mode = 0) {
  const int tid = (threadIdx.x & 255);
  if (mode == 1 || it < P0_ADA) {
    const int NC = mode ? 8 : 16;
    const int QN = NC >> 2, KL = 256 / QN, NIT = 1024 / KL;
    const int layer = mode ? 0 : it / 192, n0 = mode ? it * 8 : (it % 192) * 16;
    const int ldw = mode ? 2048 : 3072;
    float* sc = (float*)smem;
    float* red = (float*)(smem + 20480);
    for (int e = tid; e < 5120; e += 256) {
      const int j = e >> 10, k = e & 1023;
      if (mode) sc[e] = ((const float*)(p.ws + WS_MOD))[(5 + j) * 3072 + k];
      else { const float v = (j == 0) ? p.c_ctx[k] : p.c[(j - 1) * 1024 + k]; sc[e] = silu_f(v); }
    }
    __syncthreads();
    const float* W = mode ? p.w_in1 : (layer ? p.w_ada1 : p.w_ada0);
    const float* bias = layer ? p.b_ada1 : p.b_ada0;
    const int cq = tid % QN, kl = tid / QN;
    float acc[5][4];
#pragma unroll
    for (int j = 0; j < 5; ++j) { acc[j][0] = acc[j][1] = acc[j][2] = acc[j][3] = 0.f; }
#pragma unroll 8
    for (int i = 0; i < NIT; ++i) {
      const int k = kl + KL * i;
      const float4 w = *(const float4*)(W + (size_t)k * ldw + n0 + 4 * cq);
#pragma unroll
      for (int j = 0; j < 5; ++j) {
        const float s = sc[j * 1024 + k];
        acc[j][0] += s * w.x; acc[j][1] += s * w.y; acc[j][2] += s * w.z; acc[j][3] += s * w.w;
      }
    }
#pragma unroll
    for (int j = 0; j < 5; ++j)
#pragma unroll
      for (int a = 0; a < 4; ++a) red[((kl * QN + cq) * 5 + j) * 4 + a] = acc[j][a];
    __syncthreads();
    if (tid < 5 * NC) {
      const int j = tid / NC, col = tid % NC;
      float s = mode ? 0.f : bias[n0 + col];
      for (int k2 = 0; k2 < KL; ++k2) s += red[((k2 * QN + (col >> 2)) * 5 + j) * 4 + (col & 3)];
      if (mode) ((float*)(p.ws + WS_SW))[j * 2048 + n0 + col] = s;
      else ((float*)(p.ws + WS_MOD))[(layer * 5 + j) * 3072 + n0 + col] = s;
    }
  } else if (it < P0_ADA + P0_TR) {
    int j = it - P0_ADA;
    const float* src; u16* dst; int sstride, dstride, r0, n0, dk0 = -1; bool perm = false;
    if (j < 896) { src = p.w_in0; sstride = 3584; r0 = (j / 56) * 64; n0 = (j % 56) * 64; dst = (u16*)(p.ws + WS_WIN0); dstride = 1024; perm = true; }
    else if (j < 1152) { j -= 896; src = p.w_out0; sstride = 1024; r0 = (j / 16) * 64; n0 = (j % 16) * 64; dst = (u16*)(p.ws + WS_WOUT0); dstride = 1024; }
    else if (j < 1664) { j -= 1152; src = p.w_in1; sstride = 2048; r0 = (j / 32) * 64; n0 = (j % 32) * 64; dst = (u16*)(p.ws + WS_WIN1); dstride = 1024; }
    else if (j < 1728) { j -= 1664; const int g = j >> 4; src = p.pool_w + g * 65536; sstride = 256; r0 = ((j & 15) >> 2) * 64; n0 = (j & 3) * 64; dst = (u16*)(p.ws + WS_WPOOL) + g * 65536; dstride = 256; }
    else if (j < 1984) { j -= 1728; src = p.w_out1; sstride = 1024; r0 = (j / 16) * 64; n0 = (j % 16) * 64; dst = (u16*)(p.ws + WS_WOUT1); dstride = 1024; }
    else { j -= 1984; const int bh = j >> 3, mt = j & 7; src = p.cache_v + (size_t)(bh >> 3) * 512 * 512 + (bh & 7) * 64; sstride = 512; r0 = mt * 64; n0 = 0; dst = (u16*)(p.ws + WS_VTC) + ((size_t)bh * 8 + mt) * 4096; dstride = 64; dk0 = 0; }
    float* tile = (float*)smem;
    {
      const int r = tid >> 4, c4 = (tid & 15) * 4;
      int nn = n0 + c4;
      if (perm && nn < 1024) { const int w = nn >> 6, rr = nn & 63; nn = (rr < 32) ? (32 * w + rr) : (512 + 32 * w + rr - 32); }
#pragma unroll
      for (int i = 0; i < 4; ++i) {
        const float4 v = *(const float4*)(src + (size_t)(r0 + r + 16 * i) * sstride + nn);
        *(float4*)(tile + (r + 16 * i) * 68 + c4) = v;
      }
    }
    __syncthreads();
    {
      const int n = tid >> 2, kseg = (tid & 3) * 16;
      unsigned pk[8];
#pragma unroll
      for (int j = 0; j < 8; ++j) pk[j] = pack2(tile[(kseg + 2 * j) * 68 + n], tile[(kseg + 2 * j + 1) * 68 + n]);
      u16* d = dst + (size_t)(n0 + n) * dstride + (dk0 < 0 ? r0 : dk0) + kseg;
      *(uint4*)d = make_uint4(pk[0], pk[1], pk[2], pk[3]);
      *(uint4*)(d + 8) = make_uint4(pk[4], pk[5], pk[6], pk[7]);
    }
  } else if (it >= P0_ADA + P0_TR + P0_KC + P0_PAD) {
    float* ss = (float*)(p.ws + WS_SS) + (it - P0_ADA - P0_TR - P0_KC - P0_PAD) * 4096;
#pragma unroll
    for (int i = 0; i < 4; ++i) *(float4*)(ss + (i * 256 + tid) * 4) = make_float4(0.f, 0.f, 0.f, 0.f);
  } else if (it >= P0_ADA + P0_TR + P0_KC) {
    const int sq = it - P0_ADA - P0_TR - P0_KC;
    const int st = sq < 32 ? sq * 256 : TP + (sq - 32) * 4096, en = st + (sq < 32 ? 256 : 4096);
    char* up = p.ws + WS_UP;
    const uint4 z = make_uint4(0u, 0u, 0u, 0u);
#pragma unroll
    for (int i = 0; i < 4; ++i) {
      *(uint4*)(up + (size_t)(st + 32 * sq) * 1024 + (i * 256 + tid) * 16) = z;
      *(uint4*)(up + (size_t)(en + 32 * sq + 16) * 1024 + (i * 256 + tid) * 16) = z;
    }
  } else {
    const int it2 = it - P0_ADA - P0_TR;
    u16* kc = (u16*)(p.ws + WS_KC);
#pragma unroll
    for (int e = 0; e < 16; ++e) {
      const int o = it2 * 4096 + e * 256 + tid;
      const int d = o & 63, m = (o >> 6) & 511, bh = o >> 15;
      kc[o] = f2bf(p.cache_k[(((size_t)(bh >> 3) * 512 + m) * 8 + (bh & 7)) * 64 + d]);
    }
  }
}

DI void modnorm_item(const P& p, int it, int layer) {
  const int tid = (threadIdx.x & 255), lane = tid & 63, wave = tid >> 6;
  const int row0 = it * 16 + wave * 4;
  const float* g = layer ? p.norm_g1 : p.norm_g0;
  const float* mod = (const float*)(p.ws + WS_MOD) + (size_t)(layer * 5 + midx(row0)) * 3072;
  u16* H = (u16*)(p.ws + WS_R0);
  float4 a[4], b[4];
#pragma unroll
  for (int j = 0; j < 4; ++j) {
    const int col = j * 256 + lane * 4;
    const float4 gv = *(const float4*)(g + col);
    const float4 sh = *(const float4*)(mod + col);
    const float4 sv = *(const float4*)(mod + 1024 + col);
    a[j] = make_float4(gv.x * (1.f + sv.x), gv.y * (1.f + sv.y), gv.z * (1.f + sv.z), gv.w * (1.f + sv.w));
    b[j] = sh;
  }
#pragma unroll
  for (int r = 0; r < 4; ++r) {
    const int row = row0 + r;
    const float* xr = layer ? (p.out + (size_t)row * 1024) : xrow(p, row);
    float4 v[4];
    float ss = 0.f;
#pragma unroll
    for (int j = 0; j < 4; ++j) {
      v[j] = *(const float4*)(xr + j * 256 + lane * 4);
      ss += v[j].x * v[j].x + v[j].y * v[j].y + v[j].z * v[j].z + v[j].w * v[j].w;
    }
#pragma unroll
    for (int o = 32; o >= 1; o >>= 1) ss += __shfl_xor(ss, o);
    const float rinv = rsqrtf(ss * (1.f / 1024.f) + EPS);
#pragma unroll
    for (int j = 0; j < 4; ++j) {
      uint2 o2;
      o2.x = pack2(v[j].x * rinv * a[j].x + b[j].x, v[j].y * rinv * a[j].y + b[j].y);
      o2.y = pack2(v[j].z * rinv * a[j].z + b[j].z, v[j].w * rinv * a[j].w + b[j].w);
      *(uint2*)(H + (size_t)row * 1024 + j * 256 + lane * 4) = o2;
    }
  }
}

DI int crow(int i, int hh) { return (i & 3) + 8 * (i >> 2) + 4 * hh; }

constexpr int LROW = 144;
constexpr int GSTAGE = 512 * LROW;
constexpr int SMEM_BYTES = 2 * GSTAGE;
constexpr int HALF_SMEM = GSTAGE;

template <int NK, int CFG>
DI void gemm_mainloop(const u16* Ag, int lda, const u16* Bg, int ldb, char* smem, f32x16 (&acc)[CFG == 0 ? 4 : 2][CFG == 2 ? 3 : 2]) {
  constexpr int MI = CFG == 0 ? 4 : 2;
  constexpr int NJ = CFG == 2 ? 3 : 2;
  const int tid = threadIdx.x, lane = tid & 63, wave = tid >> 6;
  const int wm = CFG == 0 ? (wave >> 2) : (wave >> 1);
  const int wn = CFG == 0 ? (wave & 3) : (wave & 1);
  const int srow = tid >> 3, scol = tid & 7;
  const u16* ag = Ag + (size_t)srow * lda + scol * 8;
  const u16* bg = Bg + (size_t)srow * ldb + scol * 8;
  uint4 r0a0, r0a1, r0a2, r0a3, r0b0, r0b1, r0b2, r0b3, r1a0, r1a1, r1a2, r1a3, r1b0, r1b1, r1b2, r1b3;
#define G_LOAD(R, ko_) do { \
    R##a0 = *(const uint4*)(ag + (ko_)); R##a1 = *(const uint4*)(ag + (size_t)64 * lda + (ko_)); \
    R##a2 = *(const uint4*)(ag + (size_t)128 * lda + (ko_)); R##a3 = *(const uint4*)(ag + (size_t)192 * lda + (ko_)); \
    R##b0 = *(const uint4*)(bg + (ko_)); R##b1 = *(const uint4*)(bg + (size_t)64 * ldb + (ko_)); \
    if (CFG != 1) R##b2 = *(const uint4*)(bg + (size_t)128 * ldb + (ko_)); \
    if (CFG == 0) R##b3 = *(const uint4*)(bg + (size_t)192 * ldb + (ko_)); } while (0)
#define G_STORE(R, base_) do { char* b_ = (base_) + wofs; \
    *(uint4*)(b_) = R##a0; *(uint4*)(b_ + 64 * LROW) = R##a1; *(uint4*)(b_ + 128 * LROW) = R##a2; *(uint4*)(b_ + 192 * LROW) = R##a3; \
    *(uint4*)(b_ + 256 * LROW) = R##b0; *(uint4*)(b_ + 320 * LROW) = R##b1; \
    if (CFG != 1) *(uint4*)(b_ + 384 * LROW) = R##b2; \
    if (CFG == 0) *(uint4*)(b_ + 448 * LROW) = R##b3; } while (0)
  const int wofs = srow * LROW + scol * 16;
  const int aofs = (wm * (MI * 32) + (lane & 31)) * LROW + (lane >> 5) * 16;
  const int bofs = 256 * LROW + (wn * (NJ * 32) + (lane & 31)) * LROW + (lane >> 5) * 16;
  constexpr int FBUF = (CFG == 2) ? 4 : 2;
  bf16x8 fa[FBUF][MI], fb[FBUF][NJ];
#define LOADF(buf_, ks_) do { \
    _Pragma("unroll") \
    for (int nj_ = 0; nj_ < NJ; ++nj_) fb[buf_][nj_] = *(const bf16x8*)(cur + bofs + nj_ * 32 * LROW + (ks_) * 32); \
    _Pragma("unroll") \
    for (int mi_ = 0; mi_ < MI; ++mi_) fa[buf_][mi_] = *(const bf16x8*)(cur + aofs + mi_ * 32 * LROW + (ks_) * 32); } while (0)
#define G_STEP(R, kt_, AH_) do { \
    constexpr int kt__ = (kt_); \
    if (kt__ < NK) { \
      const char* cur = smem + (kt__ & 1) * GSTAGE; \
      __syncthreads(); \
      if (kt__ + 1 < NK) G_STORE(R, smem + ((kt__ + 1) & 1) * GSTAGE); \
      if (kt__ + (AH_) < NK) G_LOAD(R, (kt__ + (AH_)) * 64); \
      __builtin_amdgcn_sched_barrier(0); \
      if (FBUF == 4) { LOADF(0, 0); LOADF(1, 1); LOADF(2, 2); LOADF(3, 3); } else LOADF(0, 0); \
      _Pragma("unroll") \
      for (int ks = 0; ks < 4; ++ks) { \
        if (FBUF == 2 && ks < 3) LOADF((ks + 1) & 1, ks + 1); \
        _Pragma("unroll") \
        for (int mi = 0; mi < MI; ++mi) { \
          _Pragma("unroll") \
          for (int nj = 0; nj < NJ; ++nj) acc[mi][nj] = MFMA(fa[ks & (FBUF - 1)][mi], fb[ks & (FBUF - 1)][nj], acc[mi][nj]); \
        } \
      } \
      __builtin_amdgcn_sched_barrier(0); \
    } \
  } while (0)
  static_assert(NK >= 4 && NK <= 16, "K tiles");
  G_LOAD(r0, 0);
  G_STORE(r0, smem);
  G_LOAD(r0, 64);
  if (CFG != 1) {
    G_STEP(r0, 0, 2);  G_STEP(r0, 1, 2);  G_STEP(r0, 2, 2);  G_STEP(r0, 3, 2);
    G_STEP(r0, 4, 2);  G_STEP(r0, 5, 2);  G_STEP(r0, 6, 2);  G_STEP(r0, 7, 2);
    G_STEP(r0, 8, 2);  G_STEP(r0, 9, 2);  G_STEP(r0, 10, 2); G_STEP(r0, 11, 2);
    G_STEP(r0, 12, 2); G_STEP(r0, 13, 2); G_STEP(r0, 14, 2); G_STEP(r0, 15, 2);
  } else {
    G_LOAD(r1, 128);
    G_STEP(r0, 0, 3);  G_STEP(r1, 1, 3);  G_STEP(r0, 2, 3);  G_STEP(r1, 3, 3);
    G_STEP(r0, 4, 3);  G_STEP(r1, 5, 3);  G_STEP(r0, 6, 3);  G_STEP(r1, 7, 3);
    G_STEP(r0, 8, 3);  G_STEP(r1, 9, 3);  G_STEP(r0, 10, 3); G_STEP(r1, 11, 3);
    G_STEP(r0, 12, 3); G_STEP(r1, 13, 3); G_STEP(r0, 14, 3); G_STEP(r1, 15, 3);
  }
}

DI void tile_remap(int item, int FG, int NFG, int& ft, int& tt) {
  const int G = gridDim.x;
  if (G & 7) { const int NF = FG * NFG; ft = item % NF; tt = item / NF; return; }
  const int b = item % G, k = item / G;
  const int xcd = b & 7, q = (b >> 3) + k * (G >> 3);
  const int S = FG * 8;
  const int sq = q / S, r = q - sq * S;
  const int sidx = sq * 8 + xcd;
  const int ftg = sidx % NFG, ttg = sidx / NFG;
  ft = ftg * FG + r % FG;
  tt = ttg * 8 + r / FG;
}

DI void kv_rows_out(float* wbuf, int lane, float* gbase  , int tok0) {
#pragma unroll
  for (int i = 0; i < 8; ++i) {
    const int row = 4 * i + (lane >> 4), col = (lane & 15) * 4;
    const float4 v = *(const float4*)(wbuf + row * 68 + col);
    if (tok0 + row < TP) *(float4*)(gbase + (size_t)row * 512 + col) = v;
  }
}

template <int EPI>
DI void gemm_item(const P& p, int item, char* smem) {
  constexpr int CFG = (EPI == 1) ? 2 : (EPI == 3) ? 0 : 1;
  constexpr int MI = CFG == 0 ? 4 : 2;
  constexpr int NJ = CFG == 2 ? 3 : 2;
  constexpr int TNT = CFG == 0 ? 256 : (CFG == 2 ? 192 : 128);
  const int tid = threadIdx.x, lane = tid & 63, wave = tid >> 6, l31 = lane & 31, hh = lane >> 5;
  const int wm = CFG == 0 ? (wave >> 2) : (wave >> 1);
  const int wn = CFG == 0 ? (wave & 3) : (wave & 1);
  const u16 *A, *B; int lda, ldb, f0, t0, grp = 0;
  if (EPI == 1) { int ft, tt; tile_remap(item, 7, 2, ft, tt); f0 = ft * 256; t0 = tt * TNT; A = (const u16*)(p.ws + WS_WIN0) + (size_t)f0 * 1024; lda = 1024; B = (const u16*)(p.ws + WS_R0) + (size_t)t0 * 1024; ldb = 1024; }
  else if (EPI == 2) { int ft, tt; tile_remap(item, 4, 1, ft, tt); f0 = ft * 256; t0 = tt * TNT; A = (const u16*)(p.ws + WS_WOUT0) + (size_t)f0 * 1024; lda = 1024; B = (const u16*)(p.ws + WS_R0) + (size_t)t0 * 1024; ldb = 1024; }
  else if (EPI == 3) { int ft, tt; tile_remap(item, 4, 2, ft, tt); f0 = ft * 256; t0 = tt * TNT; A = (const u16*)(p.ws + WS_WIN1) + (size_t)f0 * 1024; lda = 1024; B = (const u16*)(p.ws + WS_R1) + (size_t)t0 * 1024; ldb = 1024; }
  else if (EPI == 4) { grp = item & 3; const int tt = item >> 2; f0 = 0; t0 = tt * TNT; A = (const u16*)(p.ws + WS_WPOOL) + grp * 65536; lda = 256; B = (const u16*)(p.ws + WS_R3) + (size_t)t0 * 1024 + grp * 256; ldb = 1024; }
  else { int ft, tt; tile_remap(item, 4, 1, ft, tt); f0 = ft * 256; t0 = tt * TNT; A = (const u16*)(p.ws + WS_WOUT1) + (size_t)f0 * 1024; lda = 1024; B = (const u16*)(p.ws + WS_R0) + (size_t)t0 * 1024; ldb = 1024; }

  f32x16 acc[MI][NJ];
#pragma unroll
  for (int a = 0; a < MI; ++a)
#pragma unroll
    for (int b = 0; b < NJ; ++b)
#pragma unroll
      for (int i = 0; i < 16; ++i) acc[a][b][i] = 0.f;
  if (EPI == 4 && t0 >= TP) {
    const int w = 2 << grp, hw = w >> 1;
    const int s0 = TP + ((t0 - TP) & ~4095), s1 = s0 + 4096;
    int rfix0, nfix;
    if ((t0 & 255) == 0) { rfix0 = t0; nfix = (t0 != s0) ? hw : 0; }
    else { nfix = (t0 + 128 != s1) ? (w - hw - 1) : 0; rfix0 = t0 + 128 - nfix; }
    const int rr = tid >> 6, cc = grp * 256 + (tid & 63) * 4;
    if (rr < nfix) {
      const u16* U1 = (const u16*)(p.ws + WS_R0);
      const int t = rfix0 + rr;
      const int lo = max(t - hw, s0), hi = min(t + w - hw, s1);
      float a0 = 0.f, a1 = 0.f, a2 = 0.f, a3 = 0.f;
      for (int tt = lo; tt < hi; ++tt) {
        const uint2 v = *(const uint2*)(U1 + (size_t)tt * 1024 + cc);
        a0 += bflo(v.x); a1 += bfhi(v.x); a2 += bflo(v.y); a3 += bfhi(v.y);
      }
      const uint2 cv = *(const uint2*)(U1 + (size_t)t * 1024 + cc);
      const float rc = 1.f / (float)(hi - lo);
      uint2 o; o.x = pack2(a0 * rc - bflo(cv.x), a1 * rc - bfhi(cv.x)); o.y = pack2(a2 * rc - bflo(cv.y), a3 * rc - bfhi(cv.y));
      *(uint2*)((u16*)(p.ws + WS_R3) + (size_t)t * 1024 + cc) = o;
    }
    asm volatile("s_waitcnt vmcnt(0)" ::: "memory");
    __syncthreads();
  }
  if (EPI == 4) gemm_mainloop<4, CFG>(A, lda, B, ldb, smem, acc); else gemm_mainloop<16, CFG>(A, lda, B, ldb, smem, acc);

  if (EPI == 2 || EPI == 4 || EPI == 5) {
    constexpr int SP = 260;
    float* st = (float*)smem;
    __syncthreads();
#pragma unroll
    for (int nj = 0; nj < 2; ++nj) {
      const int tokl = wn * 64 + nj * 32 + l31;
#pragma unroll
      for (int mi = 0; mi < 2; ++mi)
#pragma unroll
        for (int g = 0; g < 4; ++g)
          *(float4*)(st + tokl * SP + wm * 64 + mi * 32 + 8 * g + 4 * hh) = make_float4(acc[mi][nj][4 * g], acc[mi][nj][4 * g + 1], acc[mi][nj][4 * g + 2], acc[mi][nj][4 * g + 3]);
    }
    __syncthreads();
    const int col = lane * 4;
    if (EPI == 4) {
      const u16* SG1 = (const u16*)(p.ws + WS_R2);
      u16* Z1 = (u16*)(p.ws + WS_R0);
      const float4 sc = *(const float4*)(p.pool_scale + grp * 256 + col);
#pragma unroll 4
      for (int r = 0; r < 16; ++r) {
        const int tokl = wave * 16 + r, tok = t0 + tokl;
        const float4 a = *(const float4*)(st + tokl * SP + col);
        const uint2 sg = *(const uint2*)(SG1 + (size_t)tok * 1024 + grp * 256 + col);
        uint2 o;
        o.x = pack2(a.x * sc.x * bflo(sg.x), a.y * sc.y * bfhi(sg.x));
        o.y = pack2(a.z * sc.z * bflo(sg.y), a.w * sc.w * bfhi(sg.y));
        *(uint2*)(Z1 + (size_t)tok * 1024 + grp * 256 + col) = o;
      }
    } else {
      const int layer = (EPI == 2) ? 0 : 1;
      const float4 gv = *(const float4*)((const float*)(p.ws + WS_MOD) + (size_t)(layer * 5 + midx(t0)) * 3072 + 2048 + f0 + col);
      float4 a1 = make_float4(0.f, 0.f, 0.f, 0.f);
      if (EPI == 2) {
        const float4 g1 = *(const float4*)(p.norm_g1 + f0 + col);
        const float4 sc1 = *(const float4*)((const float*)(p.ws + WS_MOD) + (size_t)(5 + midx(t0)) * 3072 + 1024 + f0 + col);
        a1 = make_float4(g1.x * (1.f + sc1.x), g1.y * (1.f + sc1.y), g1.z * (1.f + sc1.z), g1.w * (1.f + sc1.w));
      }
      float ssq[16];
#pragma unroll
      for (int r = 0; r < 16; ++r) {
        const int tokl = wave * 16 + r, tok = t0 + tokl;
        const float4 a = *(const float4*)(st + tokl * SP + col);
        const float* xr = ((EPI == 2) ? xrow(p, tok) : (p.out + (size_t)tok * 1024)) + f0 + col;
        const float4 xv = *(const float4*)xr;
        float4 o;
        o.x = xv.x + gv.x * a.x; o.y = xv.y + gv.y * a.y; o.z = xv.z + gv.z * a.z; o.w = xv.w + gv.w * a.w;
        *(float4*)(p.out + (size_t)tok * 1024 + f0 + col) = o;
        if (EPI == 2) {
          uint2 ya; ya.x = pack2(o.x * a1.x, o.y * a1.y); ya.y = pack2(o.z * a1.z, o.w * a1.w);
          *(uint2*)((u16*)(p.ws + WS_R1) + (size_t)tok * 1024 + f0 + col) = ya;
          ssq[r] = o.x * o.x + o.y * o.y + o.z * o.z + o.w * o.w;
        }
      }
      if (EPI == 2) {
#pragma unroll
        for (int half = 8, bit = 32; half >= 1; half >>= 1, bit >>= 1) {
          const bool up = (lane & bit) != 0;
#pragma unroll
          for (int k = 0; k < half; ++k) {
            const float keep = up ? ssq[k + half] : ssq[k];
            const float send = up ? ssq[k] : ssq[k + half];
            ssq[k] = keep + __shfl_xor(send, bit);
          }
        }
        ssq[0] += __shfl_xor(ssq[0], 2);
        ssq[0] += __shfl_xor(ssq[0], 1);
        if ((lane & 3) == 0) atomicAdd((float*)(p.ws + WS_SS) + t0 + wave * 16 + (lane >> 2), ssq[0]);
      }
    }
    return;
  }
  const int tokb = t0 + wn * (NJ * 32);
  if (EPI == 3) __syncthreads();
  if (EPI == 1 && t0 < TP && f0 >= 2048 && f0 < 3072) __syncthreads();
#pragma unroll
  for (int fblk = 0; fblk < MI / 2; ++fblk) {
  const int fb = f0 + wm * (MI * 32) + fblk * 64;
  if (EPI == 1) {
    u16* U = (u16*)(p.ws + WS_UP);
    u16* SGA = (u16*)(p.ws + WS_R1 + HALF_R);
    u16* Q = (u16*)(p.ws + WS_R2);
    u16* Kb = (u16*)(p.ws + WS_R2 + HALF_R);
    u16* VT = (u16*)(p.ws + WS_R3);
    u16* SGB = (u16*)(p.ws + WS_R3 + HALF_R);
#pragma unroll
    for (int nj = 0; nj < NJ; ++nj) {
      const int tok = tokb + nj * 32 + l31;
      const bool kvst = (tokb + nj * 32 < TP);
      float* wbuf = (float*)smem + wave * (32 * 68);
      f32x16& X = acc[2 * fblk][nj];
      f32x16& Y = acc[2 * fblk + 1][nj];
      if (fb < 1024) {
        const int cb = (fb >> 6) * 32;
        float u[16];
#pragma unroll
        for (int i = 0; i < 16; ++i) u[i] = X[i] * sigm_f(Y[i]);
#pragma unroll
        for (int i = 0; i < 8; ++i) swap32(u[i], u[i + 8]);
#pragma unroll
        for (int gg = 0; gg < 2; ++gg) {
          uint4 o;
          o.x = pack2(u[4 * gg], u[4 * gg + 1]); o.y = pack2(u[4 * gg + 2], u[4 * gg + 3]);
          o.z = pack2(u[8 + 4 * gg], u[8 + 4 * gg + 1]); o.w = pack2(u[8 + 4 * gg + 2], u[8 + 4 * gg + 3]);
          *(uint4*)(U + (size_t)prow(tok) * 512 + cb + 16 * hh + 8 * gg) = o;
        }
      } else if (fb < 1536 || fb >= 3072) {
        u16* dst = (fb < 1536) ? (SGA + (size_t)tok * 512 + (fb - 1024)) : (SGB + (size_t)tok * 512 + (fb - 3072));
#pragma unroll
        for (int i = 0; i < 16; ++i) { X[i] = silu_f(X[i]); Y[i] = silu_f(Y[i]); }
        swap32v(X, Y);
#pragma unroll
        for (int g = 0; g < 4; ++g) {
          uint4 o;
          o.x = pack2(X[4 * g], X[4 * g + 1]); o.y = pack2(X[4 * g + 2], X[4 * g + 3]);
          o.z = pack2(Y[4 * g], Y[4 * g + 1]); o.w = pack2(Y[4 * g + 2], Y[4 * g + 3]);
          *(uint4*)(dst + 32 * hh + 8 * g) = o;
        }
      } else if (fb < 2560) {
        const bool isq = fb < 2048;
        const int hc = isq ? (fb - 1536) : (fb - 2048);
        float ss = 0.f;
#pragma unroll
        for (int i = 0; i < 16; ++i) ss += X[i] * X[i] + Y[i] * Y[i];
        ss += __shfl_xor(ss, 32);
        const float rinv = rsqrtf(ss * (1.f / 64.f) + EPS);
        swap32v(X, Y);
        const float* nw = (isq ? p.q_norm : p.k_norm) + 32 * hh;
        const float qs = isq ? (0.125f * 1.4426950408889634f) : 1.f;
        u16* dst = isq ? (Q + (size_t)tok * 512 + hc + 32 * hh) : (Kb + ((size_t)(hc >> 6) * TT + tok) * 64 + 32 * hh);
        float* kout = p.out + (size_t)TT * 1024 + (size_t)tok * 512 + hc + 32 * hh;
#pragma unroll
        for (int g = 0; g < 4; ++g) {
          const float4 w0 = *(const float4*)(nw + 8 * g);
          const float4 w1 = *(const float4*)(nw + 8 * g + 4);
          float4 v0, v1;
          v0.x = X[4 * g] * rinv * w0.x; v0.y = X[4 * g + 1] * rinv * w0.y; v0.z = X[4 * g + 2] * rinv * w0.z; v0.w = X[4 * g + 3] * rinv * w0.w;
          v1.x = Y[4 * g] * rinv * w1.x; v1.y = Y[4 * g + 1] * rinv * w1.y; v1.z = Y[4 * g + 2] * rinv * w1.z; v1.w = Y[4 * g + 3] * rinv * w1.w;
          if (!isq && kvst) { *(float4*)(wbuf + l31 * 68 + 32 * hh + 8 * g) = v0; *(float4*)(wbuf + l31 * 68 + 32 * hh + 8 * g + 4) = v1; }
          uint4 o;
          o.x = pack2(v0.x * qs, v0.y * qs); o.y = pack2(v0.z * qs, v0.w * qs);
          o.z = pack2(v1.x * qs, v1.y * qs); o.w = pack2(v1.z * qs, v1.w * qs);
          *(uint4*)(dst + 8 * g) = o;
        }
        if (!isq && kvst) kv_rows_out(wbuf, lane, p.out + (size_t)TT * 1024 + (size_t)(tokb + nj * 32) * 512 + hc, tokb + nj * 32);
      } else {
        const int hc = fb - 2560;
#pragma unroll
        for (int mi = 0; mi < 2; ++mi)
#pragma unroll
          for (int i = 0; i < 16; ++i) VT[(((size_t)(hc >> 6) * (TT / 64) + (tok >> 6)) * 64 + mi * 32 + crow(i, hh)) * 64 + (tok & 63)] = f2bf(acc[2 * fblk + mi][nj][i]);
        if (kvst) {
          swap32v(X, Y);
#pragma unroll
          for (int g = 0; g < 4; ++g) {
            *(float4*)(wbuf + l31 * 68 + 32 * hh + 8 * g) = make_float4(X[4 * g], X[4 * g + 1], X[4 * g + 2], X[4 * g + 3]);
            *(float4*)(wbuf + l31 * 68 + 32 * hh + 8 * g + 4) = make_float4(Y[4 * g], Y[4 * g + 1], Y[4 * g + 2], Y[4 * g + 3]);
          }
          kv_rows_out(wbuf, lane, p.out + (size_t)TT * 1024 + (size_t)TP * 512 + (size_t)(tokb + nj * 32) * 512 + hc, tokb + nj * 32);
        }
      }
    }
  } else if (EPI == 2 || EPI == 5) {
    const int layer = (EPI == 2) ? 0 : 1;
#pragma unroll
    for (int nj = 0; nj < 2; ++nj) {
      const int tok = tokb + nj * 32 + l31;
      f32x16& X = acc[2 * fblk][nj];
      f32x16& Y = acc[2 * fblk + 1][nj];
      swap32v(X, Y);
      const int colb = fb + 32 * hh;
      const float* gate = (const float*)(p.ws + WS_MOD) + (size_t)(layer * 5 + midx(tok)) * 3072 + 2048 + colb;
      const float* xr = ((EPI == 2) ? xrow(p, tok) : (p.out + (size_t)tok * 1024)) + colb;
      float* yr = p.out + (size_t)tok * 1024 + colb;
#pragma unroll
      for (int g = 0; g < 4; ++g) {
        const float4 x0 = *(const float4*)(xr + 8 * g), x1 = *(const float4*)(xr + 8 * g + 4);
        const float4 g0 = *(const float4*)(gate + 8 * g), g1 = *(const float4*)(gate + 8 * g + 4);
        float4 o0, o1;
        o0.x = x0.x + g0.x * X[4 * g]; o0.y = x0.y + g0.y * X[4 * g + 1]; o0.z = x0.z + g0.z * X[4 * g + 2]; o0.w = x0.w + g0.w * X[4 * g + 3];
        o1.x = x1.x + g1.x * Y[4 * g]; o1.y = x1.y + g1.y * Y[4 * g + 1]; o1.z = x1.z + g1.z * Y[4 * g + 2]; o1.w = x1.w + g1.w * Y[4 * g + 3];
        *(float4*)(yr + 8 * g) = o0; *(float4*)(yr + 8 * g + 4) = o1;
      }
    }
  } else if (EPI == 3) {
    u16* U1 = (u16*)(p.ws + WS_R0);
    u16* SG1 = (u16*)(p.ws + WS_R2);
#pragma unroll
    for (int nj = 0; nj < 2; ++nj) {
      const int tok = tokb + nj * 32 + l31;
      f32x16& X = acc[2 * fblk][nj];
      f32x16& Y = acc[2 * fblk + 1][nj];
      swap32v(X, Y);
      {
        const float rinv = rsqrtf(((const float*)(p.ws + WS_SS))[tok] * (1.f / 1024.f) + EPS);
        const float* sw = (const float*)(p.ws + WS_SW) + midx(tok) * 2048 + fb + 32 * hh;
#pragma unroll
        for (int g = 0; g < 4; ++g) {
          const float4 s0 = *(const float4*)(sw + 8 * g), s1 = *(const float4*)(sw + 8 * g + 4);
          X[4 * g] = X[4 * g] * rinv + s0.x; X[4 * g + 1] = X[4 * g + 1] * rinv + s0.y; X[4 * g + 2] = X[4 * g + 2] * rinv + s0.z; X[4 * g + 3] = X[4 * g + 3] * rinv + s0.w;
          Y[4 * g] = Y[4 * g] * rinv + s1.x; Y[4 * g + 1] = Y[4 * g + 1] * rinv + s1.y; Y[4 * g + 2] = Y[4 * g + 2] * rinv + s1.z; Y[4 * g + 3] = Y[4 * g + 3] * rinv + s1.w;
        }
      }
      if (fb >= 1024) {
#pragma unroll
        for (int i = 0; i < 16; ++i) { X[i] = silu_f(X[i]); Y[i] = silu_f(Y[i]); }
      }
      char* dst = smem + (wn * 64 + nj * 32 + l31) * 528 + (fb - f0 + 32 * hh) * 2;
#pragma unroll
      for (int g = 0; g < 4; ++g) {
        uint4 o;
        o.x = pack2(X[4 * g], X[4 * g + 1]); o.y = pack2(X[4 * g + 2], X[4 * g + 3]);
        o.z = pack2(Y[4 * g], Y[4 * g + 1]); o.w = pack2(Y[4 * g + 2], Y[4 * g + 3]);
        *(uint4*)(dst + 16 * g) = o;
      }
    }
  } else {
    const u16* SG1 = (const u16*)(p.ws + WS_R2);
    u16* Z1 = (u16*)(p.ws + WS_R0);
#pragma unroll
    for (int nj = 0; nj < 2; ++nj) {
      const int tok = tokb + nj * 32 + l31;
      f32x16& X = acc[2 * fblk][nj];
      f32x16& Y = acc[2 * fblk + 1][nj];
      swap32v(X, Y);
      const int colb = grp * 256 + fb + 32 * hh;
#pragma unroll
      for (int g = 0; g < 4; ++g) {
        const float4 s0 = *(const float4*)(p.pool_scale + colb + 8 * g), s1 = *(const float4*)(p.pool_scale + colb + 8 * g + 4);
        const uint4 sg = *(const uint4*)(SG1 + (size_t)tok * 1024 + colb + 8 * g);
        uint4 o;
        o.x = pack2(X[4 * g] * s0.x * bflo(sg.x), X[4 * g + 1] * s0.y * bfhi(sg.x));
        o.y = pack2(X[4 * g + 2] * s0.z * bflo(sg.y), X[4 * g + 3] * s0.w * bfhi(sg.y));
        o.z = pack2(Y[4 * g] * s1.x * bflo(sg.z), Y[4 * g + 1] * s1.y * bfhi(sg.z));
        o.w = pack2(Y[4 * g + 2] * s1.z * bflo(sg.w), Y[4 * g + 3] * s1.w * bfhi(sg.w));
        *(uint4*)(Z1 + (size_t)tok * 1024 + colb + 8 * g) = o;
      }
    }
  }
  }
  if (EPI == 3) {
    __syncthreads();
    u16* dstg = (f0 < 1024) ? ((u16*)(p.ws + WS_R0) + f0) : ((u16*)(p.ws + WS_R2) + f0 - 1024);
#pragma unroll 4
    for (int i = 0; i < 16; ++i) {
      const int row = wave * 32 + 2 * i + (lane >> 5), ch = lane & 31;
      const uint4 v = *(const uint4*)(smem + row * 528 + ch * 16);
      *(uint4*)(dstg + (size_t)(t0 + row) * 1024 + ch * 8) = v;
    }
    if (f0 < 1024) {
      const int w = 2 << (f0 >> 8), hw = w >> 1;
      int seqlo = 0, seqhi = 256;
      if (t0 >= TP) { const int s0 = TP + ((t0 - TP) & ~4095); seqlo = s0 - t0; seqhi = s0 + 4096 - t0; }
      const int lo_ok = max(seqlo, 0), hi_ok = min(seqhi, 256);
      const int ch = lane & 31, rb = wave * 32 + (lane >> 5) * 16;
      u16* Dd = (u16*)(p.ws + WS_R3);
      float sm[8];
#pragma unroll
      for (int k = 0; k < 8; ++k) sm[k] = 0.f;
#define EP_ACC(v_, m_) do { \
      sm[0] += (m_) * bflo((v_).x); sm[1] += (m_) * bfhi((v_).x); sm[2] += (m_) * bflo((v_).y); sm[3] += (m_) * bfhi((v_).y); \
      sm[4] += (m_) * bflo((v_).z); sm[5] += (m_) * bfhi((v_).z); sm[6] += (m_) * bflo((v_).w); sm[7] += (m_) * bfhi((v_).w); } while (0)
#pragma unroll
      for (int j = 0; j < 15; ++j) {
        const int t = rb - hw + j;
        const uint4 v = *(const uint4*)(smem + min(max(t, 0), 255) * 528 + ch * 16);
        const float mk = (j < w - 1 && t >= lo_ok && t < hi_ok) ? 1.f : 0.f;
        EP_ACC(v, mk);
      }
#pragma unroll 4
      for (int i = 0; i < 16; ++i) {
        const int r = rb + i;
        const int ta = r + w - hw - 1, tr = r - hw - 1;
        const uint4 va = *(const uint4*)(smem + min(ta, 255) * 528 + ch * 16);
        const uint4 vr = *(const uint4*)(smem + max(tr, 0) * 528 + ch * 16);
        const uint4 cv = *(const uint4*)(smem + r * 528 + ch * 16);
        const float ma = (ta < hi_ok) ? 1.f : 0.f;
        const float mr = (tr >= lo_ok && i > 0) ? -1.f : 0.f;
        EP_ACC(va, ma);
        EP_ACC(vr, mr);
        const int lo = max(r - hw, seqlo), hi = min(r + w - hw, seqhi);
        if (lo >= 0 && hi <= 256) {
          const float rc = 1.f / (float)(hi - lo);
          uint4 o;
          o.x = pack2(sm[0] * rc - bflo(cv.x), sm[1] * rc - bfhi(cv.x));
          o.y = pack2(sm[2] * rc - bflo(cv.y), sm[3] * rc - bfhi(cv.y));
          o.z = pack2(sm[4] * rc - bflo(cv.z), sm[5] * rc - bfhi(cv.z));
          o.w = pack2(sm[6] * rc - bflo(cv.w), sm[7] * rc - bfhi(cv.w));
          *(uint4*)(Dd + (size_t)(t0 + r) * 1024 + f0 + ch * 8) = o;
        }
      }
    }
  }
}

constexpr int P3_NA = 1024, P3_CTX = 512, P3_CONV = 1536, P3_ITEMS = P3_NA + P3_CTX + P3_CONV;

typedef float f32x2 __attribute__((ext_vector_type(2)));
DI void conv_item(const P& p, int it, char* smem) {
  const int tid = (threadIdx.x & 255), lane = tid & 63, wave = tid >> 6;
  const int t0 = it * 16;
  const int c = 2 * tid;
  const u16* UP = (const u16*)(p.ws + WS_UP) + (size_t)(prow(t0) - 15) * 512 + c;
  const u16* SGA = (const u16*)(p.ws + WS_R1 + HALF_R);
  u16* Z = (u16*)(p.ws + WS_R0);
  float* ylds = (float*)smem;
  f32x2 w[31];
#pragma unroll
  for (int j = 0; j < 31; ++j) w[j] = *(const f32x2*)(p.conv_w + j * 512 + c);
  const f32x2 cb = *(const f32x2*)(p.conv_b + c);
  unsigned uv[46];
#pragma unroll
  for (int r = 0; r < 46; ++r) uv[r] = *(const unsigned*)(UP + r * 512);
#pragma unroll
  for (int grp = 0; grp < 2; ++grp) {
    f32x2 y[8];
#pragma unroll
    for (int i = 0; i < 8; ++i) y[i] = cb;
#pragma unroll
    for (int r = 0; r < 38; ++r) {
      const unsigned v = uv[grp * 8 + r];
      f32x2 vv; vv.x = bflo(v); vv.y = bfhi(v);
#pragma unroll
      for (int i = 0; i < 8; ++i) {
        const int j = r - i;
        if (j >= 0 && j <= 30) y[i] = __builtin_elementwise_fma(vv, w[j], y[i]);
      }
    }
#pragma unroll
    for (int i = 0; i < 8; ++i) *(f32x2*)(ylds + (grp * 8 + i) * 512 + c) = y[i];
  }
  __syncthreads();
  const int c1 = lane * 4, c2 = 256 + lane * 4;
  const float4 g1 = *(const float4*)(p.ln_g + c1), g2 = *(const float4*)(p.ln_g + c2);
  const float4 b1 = *(const float4*)(p.ln_b + c1), b2 = *(const float4*)(p.ln_b + c2);
#pragma unroll
  for (int tt = 0; tt < 4; ++tt) {
    const int tl = wave * 4 + tt, tok = t0 + tl;
    const float4 a = *(const float4*)(ylds + tl * 512 + c1), b = *(const float4*)(ylds + tl * 512 + c2);
    float s1 = a.x + a.y + a.z + a.w + b.x + b.y + b.z + b.w;
    float s2 = a.x * a.x + a.y * a.y + a.z * a.z + a.w * a.w + b.x * b.x + b.y * b.y + b.z * b.z + b.w * b.w;
#pragma unroll
    for (int o = 32; o >= 1; o >>= 1) { s1 += __shfl_xor(s1, o); s2 += __shfl_xor(s2, o); }
    const float mean = s1 * (1.f / 512.f);
    const float var = fmaxf(s2 * (1.f / 512.f) - mean * mean, 0.f);
    const float rstd = rsqrtf(var + EPS);
    const uint2 ga1 = *(const uint2*)(SGA + (size_t)tok * 512 + c1), ga2 = *(const uint2*)(SGA + (size_t)tok * 512 + c2);
    uint2 o1, o2;
    o1.x = pack2(silu_f((a.x - mean) * rstd * g1.x + b1.x) * bflo(ga1.x), silu_f((a.y - mean) * rstd * g1.y + b1.y) * bfhi(ga1.x));
    o1.y = pack2(silu_f((a.z - mean) * rstd * g1.z + b1.z) * bflo(ga1.y), silu_f((a.w - mean) * rstd * g1.w + b1.w) * bfhi(ga1.y));
    o2.x = pack2(silu_f((b.x - mean) * rstd * g2.x + b2.x) * bflo(ga2.x), silu_f((b.y - mean) * rstd * g2.y + b2.y) * bfhi(ga2.x));
    o2.y = pack2(silu_f((b.z - mean) * rstd * g2.z + b2.z) * bflo(ga2.y), silu_f((b.w - mean) * rstd * g2.w + b2.w) * bfhi(ga2.y));
    *(uint2*)(Z + (size_t)tok * 1024 + c1) = o1;
    *(uint2*)(Z + (size_t)tok * 1024 + c2) = o2;
  }
}

constexpr int ACH = 64 * LROW;
constexpr int ABUF = 2 * ACH;

DI void attn_item(const P& p, int it, char* smem) {
  const int tid = (threadIdx.x & 255), lane = tid & 63, wave = tid >> 6, l31 = lane & 31, hh = lane >> 5;
  const bool is_na = it < P3_NA;
  const u16* Qb = (const u16*)(p.ws + WS_R2);
  const u16* Kb = (const u16*)(p.ws + WS_R2 + HALF_R);
  const u16* VT = (const u16*)(p.ws + WS_R3);
  const u16* SGB = (const u16*)(p.ws + WS_R3 + HALF_R);
  const u16* KC = (const u16*)(p.ws + WS_KC);
  const u16* VTC = (const u16*)(p.ws + WS_VTC);
  u16* Z = (u16*)(p.ws + WS_R0);
  int b, head, qtok, nchunks, tokbase;
  int r = 0, c = 0, qcs = 0, rsw = 0, rs_lo = 0;
  if (is_na) {
    b = it >> 8; head = it & 7; const int r0 = 2 * ((it >> 3) & 31);
    r = r0 + (wave >> 1); c = (wave & 1) * 32 + l31;
    qcs = min(max(c - 8, 0), 48);
    rsw = min(max(r - 4, 0), 56);
    rs_lo = min(max(r0 - 4, 0), 56);
    const int rs_hi = min(max(r0 - 3, 0), 56);
    tokbase = TP + b * 4096;
    qtok = tokbase + r * 64 + c;
    nchunks = 8 + rs_hi + 8 - rs_lo;
  } else {
    const int j = it - P3_NA;
    b = j >> 4; head = (j >> 1) & 7;
    tokbase = b * 256;
    qtok = tokbase + (j & 1) * 128 + wave * 32 + l31;
    nchunks = 4;
  }
  float* rpb_s = (float*)(smem + 2 * ABUF);
  if (is_na) for (int i = tid; i < 465; i += 256) rpb_s[i] = p.rpb[head * 465 + i] * 1.4426950408889634f;

  bf16x8 qf[4];
#pragma unroll
  for (int ks = 0; ks < 4; ++ks) qf[ks] = *(const bf16x8*)(Qb + (size_t)qtok * 512 + head * 64 + ks * 16 + hh * 8);

  f32x16 o0, o1;
#pragma unroll
  for (int i = 0; i < 16; ++i) { o0[i] = 0.f; o1[i] = 0.f; }
  float m_run = -INFINITY, l_run = 0.f;

  const int prow = tid >> 3, ppart = tid & 7;
  const int vpos0 = (16 * (ppart >> 1) + 4 * (ppart & 1)) * 2, vpos1 = vpos0 + 16;
  uint4 kreg0, kreg1, vreg0, vreg1;
#define LOAD_CHUNK(ci_) do { \
    const int ci__ = (ci_); const u16 *kp, *vp; size_t ks_, vs_; \
    if (is_na && ci__ < 8) { \
      kp = KC + ((size_t)(b * 8 + head) * 512 + ci__ * 64) * 64; ks_ = 64; \
      vp = VTC + ((size_t)(b * 8 + head) * 8 + ci__) * 4096; vs_ = 64; \
    } else { \
      const int kt0 = is_na ? (tokbase + (rs_lo + ci__ - 8) * 64) : (tokbase + ci__ * 64); \
      kp = Kb + ((size_t)head * TT + kt0) * 64; ks_ = 64; \
      vp = VT + ((size_t)head * (TT / 64) + (kt0 >> 6)) * 4096; vs_ = 64; \
    } \
    kreg0 = *(const uint4*)(kp + (size_t)prow * ks_ + ppart * 8); \
    kreg1 = *(const uint4*)(kp + (size_t)(prow + 32) * ks_ + ppart * 8); \
    vreg0 = *(const uint4*)(vp + (size_t)prow * vs_ + ppart * 8); \
    vreg1 = *(const uint4*)(vp + (size_t)(prow + 32) * vs_ + ppart * 8); \
  } while (0)
#define STORE_CHUNK(buf_) do { \
    char* bb_ = (buf_); \
    *(uint4*)(bb_ + prow * LROW + ppart * 16) = kreg0; \
    *(uint4*)(bb_ + (prow + 32) * LROW + ppart * 16) = kreg1; \
    char* vr0 = bb_ + ACH + prow * LROW; char* vr1 = bb_ + ACH + (prow + 32) * LROW; \
    *(uint2*)(vr0 + vpos0) = make_uint2(vreg0.x, vreg0.y); *(uint2*)(vr0 + vpos1) = make_uint2(vreg0.z, vreg0.w); \
    *(uint2*)(vr1 + vpos0) = make_uint2(vreg1.x, vreg1.y); *(uint2*)(vr1 + vpos1) = make_uint2(vreg1.z, vreg1.w); \
  } while (0)
  LOAD_CHUNK(0);
  STORE_CHUNK(smem);
  LOAD_CHUNK(1);
  for (int ci = 0; ci < nchunks; ++ci) {
    const char* cur = smem + (ci & 1) * ABUF;
    __syncthreads();
    STORE_CHUNK(smem + ((ci + 1) & 1) * ABUF);
    LOAD_CHUNK(min(ci + 2, nchunks - 1));
    __builtin_amdgcn_sched_barrier(0);
    bool act = true, window = false; int rowidx = 0;
    if (is_na && ci >= 8) { const int kr = rs_lo + ci - 8; act = (kr >= rsw) && (kr < rsw + 8); window = true; rowidx = kr - r + 7; }
    if (act) {
      f32x16 sa, sb;
#pragma unroll
      for (int i = 0; i < 16; ++i) { sa[i] = 0.f; sb[i] = 0.f; }
#pragma unroll
      for (int ks = 0; ks < 4; ++ks) {
        const bf16x8 ka = *(const bf16x8*)(cur + l31 * LROW + ks * 32 + hh * 16);
        const bf16x8 kb2 = *(const bf16x8*)(cur + (32 + l31) * LROW + ks * 32 + hh * 16);
        sa = MFMA(ka, qf[ks], sa);
        sb = MFMA(kb2, qf[ks], sb);
      }
      if (window) {
        const int kb = 4 * hh;
        const float* rp = rpb_s + rowidx * 31 + (kb - c + 15);
        const int kq = kb - qcs;
#pragma unroll
        for (int i = 0; i < 16; ++i) {
          const int co = (i & 3) + 8 * (i >> 2);
          sa[i] = ((unsigned)(kq + co) < 16u) ? (sa[i] + rp[co]) : -INFINITY;
          sb[i] = ((unsigned)(kq + 32 + co) < 16u) ? (sb[i] + rp[32 + co]) : -INFINITY;
        }
      }
      float mx = fmaxf(sa[0], sb[0]);
#pragma unroll
      for (int i = 1; i < 16; ++i) mx = fmaxf(mx, fmaxf(sa[i], sb[i]));
      mx = fmaxf(mx, __shfl_xor(mx, 32));
      if (__any(mx > m_run + 8.f)) {
        const float m_new = fmaxf(m_run, mx);
        const float alpha = __builtin_amdgcn_exp2f(m_run - m_new);
        m_run = m_new;
        l_run *= alpha;
#pragma unroll
        for (int i = 0; i < 16; ++i) { o0[i] *= alpha; o1[i] *= alpha; }
      }
      float ps = 0.f;
#pragma unroll
      for (int i = 0; i < 16; ++i) { sa[i] = __builtin_amdgcn_exp2f(sa[i] - m_run); sb[i] = __builtin_amdgcn_exp2f(sb[i] - m_run); ps += sa[i] + sb[i]; }
      l_run += ps;
#pragma unroll
      for (int kt = 0; kt < 2; ++kt)
#pragma unroll
        for (int sidx = 0; sidx < 2; ++sidx) {
          union { unsigned u[4]; bf16x8 v; } pb;
#pragma unroll
          for (int q2 = 0; q2 < 4; ++q2) pb.u[q2] = kt ? pack2(sb[8 * sidx + 2 * q2], sb[8 * sidx + 2 * q2 + 1]) : pack2(sa[8 * sidx + 2 * q2], sa[8 * sidx + 2 * q2 + 1]);
          const bf16x8 a0 = *(const bf16x8*)(cur + ACH + l31 * LROW + (kt * 32 + 16 * sidx + 8 * hh) * 2);
          const bf16x8 a1 = *(const bf16x8*)(cur + ACH + (32 + l31) * LROW + (kt * 32 + 16 * sidx + 8 * hh) * 2);
          o0 = MFMA(a0, pb.v, o0);
          o1 = MFMA(a1, pb.v, o1);
        }
    }
    __builtin_amdgcn_sched_barrier(0);
  }
  const float lt = l_run + __shfl_xor(l_run, 32);
  const float inv = 1.f / lt;
  swap32v(o0, o1);
  {
    const u16* sgp = SGB + (size_t)qtok * 512 + head * 64 + 32 * hh;
    u16* zp = Z + (size_t)qtok * 1024 + 512 + head * 64 + 32 * hh;
#pragma unroll
    for (int g = 0; g < 4; ++g) {
      const uint4 sg = *(const uint4*)(sgp + 8 * g);
      uint4 ov;
      ov.x = pack2(o0[4 * g] * inv * bflo(sg.x), o0[4 * g + 1] * inv * bfhi(sg.x));
      ov.y = pack2(o0[4 * g + 2] * inv * bflo(sg.y), o0[4 * g + 3] * inv * bfhi(sg.y));
      ov.z = pack2(o1[4 * g] * inv * bflo(sg.z), o1[4 * g + 1] * inv * bfhi(sg.z));
      ov.w = pack2(o1[4 * g + 2] * inv * bflo(sg.w), o1[4 * g + 3] * inv * bfhi(sg.w));
      *(uint4*)(zp + 8 * g) = ov;
    }
  }
}

DI void pool_item(const P& p, int it) {
  const int tid = (threadIdx.x & 255);
  const int t0 = it * 32 + (tid >> 7) * 16;
  int s0, s1;
  if (t0 < TP) { s0 = t0 & ~255; s1 = s0 + 256; } else { s0 = TP + ((t0 - TP) & ~4095); s1 = s0 + 4096; }
  const int c = (tid & 127) * 8;
  const int w = 2 << (c >> 8), hw = w >> 1;
  const u16* U1 = (const u16*)(p.ws + WS_R0);
  u16* Dd = (u16*)(p.ws + WS_R3);
  float sm[8];
#pragma unroll
  for (int k = 0; k < 8; ++k) sm[k] = 0.f;
#define POOL_ACC(v_, m_) do { \
    sm[0] += (m_) * bflo((v_).x); sm[1] += (m_) * bfhi((v_).x); sm[2] += (m_) * bflo((v_).y); sm[3] += (m_) * bfhi((v_).y); \
    sm[4] += (m_) * bflo((v_).z); sm[5] += (m_) * bfhi((v_).z); sm[6] += (m_) * bflo((v_).w); sm[7] += (m_) * bfhi((v_).w); } while (0)
#pragma unroll
  for (int j = 0; j < 15; ++j) {
    const int t = t0 - hw + j;
    const uint4 v = *(const uint4*)(U1 + (size_t)min(max(t, s0), s1 - 1) * 1024 + c);
    const float mk = (j < w - 1 && t >= s0 && t < s1) ? 1.f : 0.f;
    POOL_ACC(v, mk);
  }
#pragma unroll 8
  for (int i = 0; i < 16; ++i) {
    const int t = t0 + i;
    const int ta = t + w - hw - 1, tr = t - hw - 1;
    const uint4 va = *(const uint4*)(U1 + (size_t)min(max(ta, s0), s1 - 1) * 1024 + c);
    const uint4 vr = *(const uint4*)(U1 + (size_t)min(max(tr, s0), s1 - 1) * 1024 + c);
    const uint4 cv = *(const uint4*)(U1 + (size_t)t * 1024 + c);
    const float ma = (ta < s1) ? 1.f : 0.f;
    const float mr = (tr >= s0 && i > 0) ? -1.f : 0.f;
    POOL_ACC(va, ma);
    POOL_ACC(vr, mr);
    const int lo = max(t - hw, s0), hi = min(t + w - hw, s1);
    const float rc = 1.f / (float)(hi - lo);
    uint4 o;
    o.x = pack2(sm[0] * rc - bflo(cv.x), sm[1] * rc - bfhi(cv.x));
    o.y = pack2(sm[2] * rc - bflo(cv.y), sm[3] * rc - bfhi(cv.y));
    o.z = pack2(sm[4] * rc - bflo(cv.z), sm[5] * rc - bfhi(cv.z));
    o.w = pack2(sm[6] * rc - bflo(cv.w), sm[7] * rc - bfhi(cv.w));
    *(uint4*)(Dd + (size_t)t * 1024 + c) = o;
  }
}

#define XB_TMO      128
#define XB_XCNT(j)  (256  + 64 * (j))
#define XB_XSUB(j)  (1280 + 64 * (j))
#define XB_XGEN(j)  (2304 + 64 * (j))
#define XB_TOP      3328
#define XB_TOPGEN   3392
#define XCD_BAR_WORDS 3456
#define XB_SPIN_CAP (1u << 22)
#define LAS __attribute__((address_space(3)))
DI unsigned xb_ld(unsigned* p)              { return __hip_atomic_load(p, __ATOMIC_RELAXED, __HIP_MEMORY_SCOPE_AGENT); }
DI unsigned xb_add(unsigned* p, unsigned v) { return __hip_atomic_fetch_add(p, v, __ATOMIC_RELAXED, __HIP_MEMORY_SCOPE_AGENT); }
DI unsigned xb_xcc_id() { return (unsigned)__builtin_amdgcn_s_getreg((3 << 11) | 20) & 0xFu; }
#define XB_SPIN(cond, bar) do { unsigned _sp = 0; while (cond) { __builtin_amdgcn_s_sleep(1); \
    if ((++_sp & 255u) == 0u) { if (xb_ld(&(bar)[XB_TMO])) break; if (_sp > XB_SPIN_CAP) { atomicAdd(&(bar)[XB_TMO], 1u); break; } } } } while (0)
struct XcdBarrier { unsigned* bar; unsigned x; volatile LAS unsigned* st; };
DI XcdBarrier xcd_barrier_post(unsigned* bar, volatile LAS unsigned* st) {
  XcdBarrier b; b.bar = bar; b.x = xb_xcc_id(); b.st = st;
  if (threadIdx.x == 0) (void)xb_add(&bar[XB_XCNT(b.x)], 1u);
  return b;
}
DI void xcd_barrier_complete(unsigned* bar, unsigned x, unsigned& nloc, unsigned& nx) {
  const unsigned G = gridDim.x * gridDim.y * gridDim.z;
  unsigned sum, cnt, mine, sp = 0u;
  for (;;) {
    sum = 0u; cnt = 0u; mine = 0u;
#pragma unroll
    for (unsigned j = 0; j < 16; ++j) { const unsigned c = xb_ld(&bar[XB_XCNT(j)]); sum += c; cnt += (c > 0u) ? 1u : 0u; mine = (j == x) ? c : mine; }
    if (sum == G) break;
    __builtin_amdgcn_s_sleep(1);
    if ((++sp & 255u) == 0u) { if (xb_ld(&bar[XB_TMO])) break; if (sp > XB_SPIN_CAP) { atomicAdd(&bar[XB_TMO], 1u); break; } }
  }
  nloc = mine > 0u ? mine : 1u; nx = cnt > 0u ? cnt : 1u;
}
DI void xcd_barrier(const XcdBarrier& b) {
  asm volatile("s_waitcnt vmcnt(0)" ::: "memory");
  __syncthreads();
  if (threadIdx.x == 0) {
    unsigned* bar = b.bar;
    __builtin_amdgcn_s_waitcnt(0);
    unsigned nloc = b.st[0], nx = b.st[1];
    if (nloc == 0u) { xcd_barrier_complete(bar, b.x, nloc, nx); b.st[0] = nloc; b.st[1] = nx; }
    const unsigned old = xb_add(&bar[XB_XSUB(b.x)], 1u);
    const unsigned gen = old / nloc;
    if (old + 1u == (gen + 1u) * nloc) {
      __builtin_amdgcn_fence(__ATOMIC_RELEASE, "agent");
      asm volatile("s_waitcnt vmcnt(0)" ::: "memory");
      const unsigned og = xb_add(&bar[XB_TOP], 1u);
      const unsigned tg = og / nx;
      if (og + 1u == (tg + 1u) * nx) xb_add(&bar[XB_TOPGEN], 1u);
      else XB_SPIN(xb_ld(&bar[XB_TOPGEN]) == tg, bar);
      __builtin_amdgcn_fence(__ATOMIC_ACQUIRE, "agent");
      xb_add(&bar[XB_XGEN(b.x)], 1u);
      asm volatile("s_waitcnt vmcnt(0)" ::: "memory");
    } else {
      XB_SPIN(xb_ld(&bar[XB_XGEN(b.x)]) == gen, bar);
      __builtin_amdgcn_fence(__ATOMIC_ACQUIRE, "agent");
      asm volatile("s_waitcnt vmcnt(0)" ::: "memory");
    }
  }
  __syncthreads();
}

constexpr int N_PHASES = 10;
#define PHASE_G(k, n, call) \
  if (p.ph_lo <= (k) && (k) < p.ph_hi) { \
    for (int it = blockIdx.x; it < (n); it += gridDim.x) { __syncthreads(); call; } \
  }
#define PHASE_H(k, n, call) \
  if (p.ph_lo <= (k) && (k) < p.ph_hi) { \
    for (int it = 2 * blockIdx.x + half; it < (n); it += 2 * gridDim.x) { __syncthreads(); call; } \
  }
#define SEAM(k) \
  if (p.ph_lo <= (k) && (k) + 1 < p.ph_hi) { if (p.ph_hi > 1000) grid.sync(); xcd_barrier(xb); }

__global__ void __launch_bounds__(512, 2) mega(P p) {
  __shared__ __attribute__((aligned(16))) char smem[SMEM_BYTES + 16];
  cg::grid_group grid = cg::this_grid();
  volatile LAS unsigned* xst = (volatile LAS unsigned*)(smem + SMEM_BYTES);
  if (threadIdx.x == 0) { xst[0] = 0u; xst[1] = 0u; }
  __syncthreads();
  XcdBarrier xb = xcd_barrier_post((unsigned*)(p.ws + WS_BAR), xst);
  const int half = threadIdx.x >> 8;
  char* hsm = smem + half * HALF_SMEM;
  PHASE_H(0, P0_ITEMS, p0_item(p, it, hsm))
  SEAM(0)
  PHASE_H(1, 256, p0_item(p, it, hsm, 1))
  PHASE_H(1, 1536, modnorm_item(p, it, 0))
  SEAM(1)
  PHASE_G(2, 14 * 128, gemm_item<1>(p, it, smem))
  SEAM(2)
  if (!(p.flags & 1)) { PHASE_H(3, P3_NA + P3_CTX, attn_item(p, it, hsm)) }
  if (!(p.flags & 2)) { PHASE_H(3, P3_CONV, conv_item(p, it, hsm)) }
  SEAM(3)
  PHASE_G(4, 4 * 192, gemm_item<2>(p, it, smem))
  if (p.ph_lo <= 4 && 6 < p.ph_hi) { if (p.ph_hi > 1000) grid.sync(); xcd_barrier(xb); }
  PHASE_G(6, 8 * 96, gemm_item<3>(p, it, smem))
  if (p.ph_lo <= 6 && 8 < p.ph_hi) { if (p.ph_hi > 1000) grid.sync(); xcd_barrier(xb); }
  PHASE_G(8, 4 * 192, gemm_item<4>(p, it, smem))
  SEAM(8)
  PHASE_G(9, 4 * 192, gemm_item<5>(p, it, smem))
}

extern "C" void kernel_launch(void* const* d_in, const int* in_sizes, int n_in, void* d_out, int out_size, void* d_ws, size_t ws_size, hipStream_t stream) {
  static int grid_blocks = 0;
  if (!grid_blocks) {
    int dev = 0, cus = 0, per_cu = 0;
    hipGetDevice(&dev);
    hipDeviceGetAttribute(&cus, hipDeviceAttributeMultiprocessorCount, dev);
    hipOccupancyMaxActiveBlocksPerMultiprocessor(&per_cu, mega, 512, 0);
    per_cu = 1;
    grid_blocks = cus * per_cu;
    if (ws_size < WS_END) fprintf(stderr, "kernel_launch: workspace too small: %zu < %zu\n", ws_size, (size_t)WS_END);
  }
  P p{};
  const float** f = (const float**)&p;
  for (int i = 0; i < 25; ++i) f[i] = (const float*)d_in[i];
  p.out = (float*)d_out;
  p.ws = (char*)d_ws;
#if MK_MULTI
  for (int ph = 0; ph < N_PHASES; ++ph) {
    p.ph_lo = ph; p.ph_hi = ph + 1;
#ifdef PROBE_PH
    if (ph == PROBE_PH) { p.flags = PROBE_FLAGS; for (int rr = 0; rr < PROBE_N; ++rr) hipLaunchKernelGGL(mega, dim3(grid_blocks), dim3(512), 0, stream, p); p.flags = 0; }
#endif
    hipLaunchKernelGGL(mega, dim3(grid_blocks), dim3(512), 0, stream, p);
  }
#else
  p.ph_lo = 0; p.ph_hi = N_PHASES;
  hipMemsetAsync((char*)d_ws + WS_BAR, 0, XCD_BAR_WORDS * 4, stream);
  void* args[] = {&p};
  hipError_t e = hipLaunchCooperativeKernel((void*)mega, dim3(grid_blocks), dim3(512), args, 0, stream);
  if (e != hipSuccess) fprintf(stderr, "cooperative launch failed: %s (grid %d)\n", hipGetErrorString(e), grid_blocks);
#endif
}
```

```cpp
#include <hip/hip_runtime.h>
#include <hip/hip_cooperative_groups.h>
#include <cstdio>
namespace cg = cooperative_groups;

#ifndef GD
#define GD 3
#endif
#ifndef MK_MULTI
#define MK_MULTI 0
#endif

typedef unsigned short u16;
using bf16x8 = __attribute__((ext_vector_type(8))) short;
using f32x16 = __attribute__((ext_vector_type(16))) float;
#define DI __device__ __forceinline__
#define MFMA(a, b, c) __builtin_amdgcn_mfma_f32_32x32x16_bf16((a), (b), (c), 0, 0, 0)

constexpr int TP = 8192;
constexpr int TT = 24576;
constexpr float EPS = 1e-6f;

constexpr size_t WS_MOD   = 0;
constexpr size_t WS_WIN0  = 131072;
constexpr size_t WS_WOUT0 = WS_WIN0 + (size_t)3584 * 1024 * 2;
constexpr size_t WS_WIN1  = WS_WOUT0 + (size_t)1024 * 1024 * 2;
constexpr size_t WS_WPOOL = WS_WIN1 + (size_t)2048 * 1024 * 2;
constexpr size_t WS_WOUT1 = WS_WPOOL + (size_t)4 * 256 * 256 * 2;
constexpr size_t WS_KC    = WS_WOUT1 + (size_t)1024 * 1024 * 2;
constexpr size_t WS_VTC   = WS_KC + (size_t)4 * 8 * 512 * 64 * 2;
constexpr size_t WS_R0    = WS_VTC + (size_t)4 * 8 * 512 * 64 * 2;
constexpr size_t RSZ      = (size_t)TT * 1024 * 2;
constexpr size_t WS_R1    = WS_R0 + RSZ;
constexpr size_t WS_R2    = WS_R1 + RSZ;
constexpr size_t WS_R3    = WS_R2 + RSZ;
constexpr size_t WS_BAR   = WS_R3 + RSZ;
constexpr size_t WS_UP    = WS_BAR + 16384;
constexpr size_t WS_SS    = WS_UP + (size_t)(24576 + 36 * 32) * 1024;
constexpr size_t WS_SW    = WS_SS + (size_t)TT * 4;
constexpr size_t WS_END   = WS_SW + 5 * 2048 * 4;
constexpr size_t HALF_R   = RSZ / 2;

struct P {
  const float *x_prompt, *x_sample, *cache_k, *cache_v, *c, *c_ctx;
  const float *norm_g0, *w_ada0, *b_ada0, *w_in0, *conv_w, *conv_b, *ln_g, *ln_b, *q_norm, *k_norm, *rpb, *w_out0;
  const float *norm_g1, *w_ada1, *b_ada1, *w_in1, *pool_w, *pool_scale, *w_out1;
  float* out;
  char* ws;
  int ph_lo, ph_hi, flags, pad;
};

typedef __bf16 hbf16x2 __attribute__((ext_vector_type(2)));
typedef float hf32x2 __attribute__((ext_vector_type(2)));
DI unsigned pack2(float a, float b) { hf32x2 v = {a, b}; hbf16x2 r = __builtin_convertvector(v, hbf16x2); return __builtin_bit_cast(unsigned, r); }
DI u16 f2bf(float x) { return (u16)(pack2(x, 0.f) & 0xffffu); }
DI float bf2f(u16 v) { return __uint_as_float(((unsigned)v) << 16); }
DI void swap32v(f32x16& x, f32x16& y) {
#pragma unroll
  for (int i = 0; i < 16; ++i) {
    auto r = __builtin_amdgcn_permlane32_swap(__float_as_uint(x[i]), __float_as_uint(y[i]), false, false);
    x[i] = __uint_as_float(r[0]); y[i] = __uint_as_float(r[1]);
  }
}
DI void swap32(float& x, float& y) {
  auto r = __builtin_amdgcn_permlane32_swap(__float_as_uint(x), __float_as_uint(y), false, false);
  x = __uint_as_float(r[0]); y = __uint_as_float(r[1]);
}
DI float bflo(unsigned v) { return __uint_as_float(v << 16); }
DI float bfhi(unsigned v) { return __uint_as_float(v & 0xffff0000u); }
DI float silu_f(float x) { return x / (1.f + __expf(-x)); }
DI float sigm_f(float x) { return 1.f / (1.f + __expf(-x)); }
DI const float* xrow(const P& p, int t) { return t < TP ? p.x_prompt + (size_t)t * 1024 : p.x_sample + (size_t)(t - TP) * 1024; }
DI int midx(int t) { return t < TP ? 0 : 1 + ((t - TP) >> 12); }
DI int prow(int t) { const int seq = t < TP ? (t >> 8) : 32 + ((t - TP) >> 12); return t + 32 * seq + 16; }

constexpr int P0_ADA = 384, P0_TR = 2240, P0_KC = 256, P0_PAD = 36, P0_SS = 6, P0_ITEMS = P0_ADA + P0_TR + P0_KC + P0_PAD + P0_SS;

DI void p0_item(const P& p, int it, char* smem, int mode = 0) {
  const int tid = (threadIdx.x & 255);
  if (mode == 1 || it < P0_ADA) {
    const int NC = mode ? 8 : 16;
    const int QN = NC >> 2, KL = 256 / QN, NIT = 1024 / KL;
    const int layer = mode ? 0 : it / 192, n0 = mode ? it * 8 : (it % 192) * 16;
    const int ldw = mode ? 2048 : 3072;
    float* sc = (float*)smem;
    float* red = (float*)(smem + 20480);
    for (int e = tid; e < 5120; e += 256) {
      const int j = e >> 10, k = e & 1023;
      if (mode) sc[e] = ((const float*)(p.ws + WS_MOD))[(5 + j) * 3072 + k];
      else { const float v = (j == 0) ? p.c_ctx[k] : p.c[(j - 1) * 1024 + k]; sc[e] = silu_f(v); }
    }
    __syncthreads();
    const float* W = mode ? p.w_in1 : (layer ? p.w_ada1 : p.w_ada0);
    const float* bias = layer ? p.b_ada1 : p.b_ada0;
    const int cq = tid % QN, kl = tid / QN;
    float acc[5][4];
#pragma unroll
    for (int j = 0; j < 5; ++j) { acc[j][0] = acc[j][1] = acc[j][2] = acc[j][3] = 0.f; }
#pragma unroll 8
    for (int i = 0; i < NIT; ++i) {
      const int k = kl + KL * i;
      const float4 w = *(const float4*)(W + (size_t)k * ldw + n0 + 4 * cq);
#pragma unroll
      for (int j = 0; j < 5; ++j) {
        const float s = sc[j * 1024 + k];
        acc[j][0] += s * w.x; acc[j][1] += s * w.y; acc[j][2] += s * w.z; acc[j][3] += s * w.w;
      }
    }
#pragma unroll
    for (int j = 0; j < 5; ++j)
#pragma unroll
      for (int a = 0; a < 4; ++a) red[((kl * QN + cq) * 5 + j) * 4 + a] = acc[j][a];
    __syncthreads();
    if (tid < 5 * NC) {
      const int j = tid / NC, col = tid % NC;
      float s = mode ? 0.f : bias[n0 + col];
      for (int k2 = 0; k2 < KL; ++k2) s += red[((k2 * QN + (col >> 2)) * 5 + j) * 4 + (col & 3)];
      if (mode) ((float*)(p.ws + WS_SW))[j * 2048 + n0 + col] = s;
      else ((float*)(p.ws + WS_MOD))[(layer * 5 + j) * 3072 + n0 + col] = s;
    }
  } else if (it < P0_ADA + P0_TR) {
    int j = it - P0_ADA;
    const float* src; u16* dst; int sstride, dstride, r0, n0, dk0 = -1; bool perm = false;
    if (j < 896) { src = p.w_in0; sstride = 3584; r0 = (j / 56) * 64; n0 = (j % 56) * 64; dst = (u16*)(p.ws + WS_WIN0); dstride = 1024; perm = true; }
    else if (j < 1152) { j -= 896; src = p.w_out0; sstride = 1024; r0 = (j / 16) * 64; n0 = (j % 16) * 64; dst = (u16*)(p.ws + WS_WOUT0); dstride = 1024; }
    else if (j < 1664) { j -= 1152; src = p.w_in1; sstride = 2048; r0 = (j / 32) * 64; n0 = (j % 32) * 64; dst = (u16*)(p.ws + WS_WIN1); dstride = 1024; }
    else if (j < 1728) { j -= 1664; const int g = j >> 4; src = p.pool_w + g * 65536; sstride = 256; r0 = ((j & 15) >> 2) * 64; n0 = (j & 3) * 64; dst = (u16*)(p.ws + WS_WPOOL) + g * 65536; dstride = 256; }
    else if (j < 1984) { j -= 1728; src = p.w_out1; sstride = 1024; r0 = (j / 16) * 64; n0 = (j % 16) * 64; dst = (u16*)(p.ws + WS_WOUT1); dstride = 1024; }
    else { j -= 1984; const int bh = j >> 3, mt = j & 7; src = p.cache_v + (size_t)(bh >> 3) * 512 * 512 + (bh & 7) * 64; sstride = 512; r0 = mt * 64; n0 = 0; dst = (u16*)(p.ws + WS_VTC) + ((size_t)bh * 8 + mt) * 4096; dstride = 64; dk0 = 0; }
    float* tile = (float*)smem;
    {
      const int r = tid >> 4, c4 = (tid & 15) * 4;
      int nn = n0 + c4;
      if (perm && nn < 1024) { const int w = nn >> 6, rr = nn & 63; nn = (rr < 32) ? (32 * w + rr) : (512 + 32 * w + rr - 32); }
#pragma unroll
      for (int i = 0; i < 4; ++i) {
        const float4 v = *(const float4*)(src + (size_t)(r0 + r + 16 * i) * sstride + nn);
        *(float4*)(tile + (r + 16 * i) * 68 + c4) = v;
      }
    }
    __syncthreads();
    {
      const int n = tid >> 2, kseg = (tid & 3) * 16;
      unsigned pk[8];
#pragma unroll
      for (int j = 0; j < 8; ++j) pk[j] = pack2(tile[(kseg + 2 * j) * 68 + n], tile[(kseg + 2 * j + 1) * 68 + n]);
      u16* d = dst + (size_t)(n0 + n) * dstride + (dk0 < 0 ? r0 : dk0) + kseg;
      *(uint4*)d = make_uint4(pk[0], pk[1], pk[2], pk[3]);
      *(uint4*)(d + 8) = make_uint4(pk[4], pk[5], pk[6], pk[7]);
    }
  } else if (it >= P0_ADA + P0_TR + P0_KC + P0_PAD) {
    float* ss = (float*)(p.ws + WS_SS) + (it - P0_ADA - P0_TR - P0_KC - P0_PAD) * 4096;
#pragma unroll
    for (int i = 0; i < 4; ++i) *(float4*)(ss + (i * 256 + tid) * 4) = make_float4(0.f, 0.f, 0.f, 0.f);
  } else if (it >= P0_ADA + P0_TR + P0_KC) {
    const int sq = it - P0_ADA - P0_TR - P0_KC;
    const int st = sq < 32 ? sq * 256 : TP + (sq - 32) * 4096, en = st + (sq < 32 ? 256 : 4096);
    char* up = p.ws + WS_UP;
    const uint4 z = make_uint4(0u, 0u, 0u, 0u);
#pragma unroll
    for (int i = 0; i < 4; ++i) {
      *(uint4*)(up + (size_t)(st + 32 * sq) * 1024 + (i * 256 + tid) * 16) = z;
      *(uint4*)(up + (size_t)(en + 32 * sq + 16) * 1024 + (i * 256 + tid) * 16) = z;
    }
  } else {
    const int it2 = it - P0_ADA - P0_TR;
    u16* kc = (u16*)(p.ws + WS_KC);
#pragma unroll
    for (int e = 0; e < 16; ++e) {
      const int o = it2 * 4096 + e * 256 + tid;
      const int d = o & 63, m = (o >> 6) & 511, bh = o >> 15;
      kc[o] = f2bf(p.cache_k[(((size_t)(bh >> 3) * 512 + m) * 8 + (bh & 7)) * 64 + d]);
    }
  }
}

DI void modnorm_item(const P& p, int it, int layer) {
  const int tid = (threadIdx.x & 255), lane = tid & 63, wave = tid >> 6;
  const int row0 = it * 16 + wave * 4;
  const float* g = layer ? p.norm_g1 : p.norm_g0;
  const float* mod = (const float*)(p.ws + WS_MOD) + (size_t)(layer * 5 + midx(row0)) * 3072;
  u16* H = (u16*)(p.ws + WS_R0);
  float4 a[4], b[4];
#pragma unroll
  for (int j = 0; j < 4; ++j) {
    const int col = j * 256 + lane * 4;
    const float4 gv = *(const float4*)(g + col);
    const float4 sh = *(const float4*)(mod + col);
    const float4 sv = *(const float4*)(mod + 1024 + col);
    a[j] = make_float4(gv.x * (1.f + sv.x), gv.y * (1.f + sv.y), gv.z * (1.f + sv.z), gv.w * (1.f + sv.w));
    b[j] = sh;
  }
#pragma unroll
  for (int r = 0; r < 4; ++r) {
    const int row = row0 + r;
    const float* xr = layer ? (p.out + (size_t)row * 1024) : xrow(p, row);
    float4 v[4];
    float ss = 0.f;
#pragma unroll
    for (int j = 0; j < 4; ++j) {
      v[j] = *(const float4*)(xr + j * 256 + lane * 4);
      ss += v[j].x * v[j].x + v[j].y * v[j].y + v[j].z * v[j].z + v[j].w * v[j].w;
    }
#pragma unroll
    for (int o = 32; o >= 1; o >>= 1) ss += __shfl_xor(ss, o);
    const float rinv = rsqrtf(ss * (1.f / 1024.f) + EPS);
#pragma unroll
    for (int j = 0; j < 4; ++j) {
      uint2 o2;
      o2.x = pack2(v[j].x * rinv * a[j].x + b[j].x, v[j].y * rinv * a[j].y + b[j].y);
      o2.y = pack2(v[j].z * rinv * a[j].z + b[j].z, v[j].w * rinv * a[j].w + b[j].w);
      *(uint2*)(H + (size_t)row * 1024 + j * 256 + lane * 4) = o2;
    }
  }
}

DI int crow(int i, int hh) { return (i & 3) + 8 * (i >> 2) + 4 * hh; }

constexpr int LROW = 144;
constexpr int GSTAGE = 512 * LROW;
constexpr int SMEM_BYTES = 2 * GSTAGE;
constexpr int HALF_SMEM = GSTAGE;

template <int NK, int CFG>
DI void gemm_mainloop(const u16* Ag, int lda, const u16* Bg, int ldb, char* smem, f32x16 (&acc)[CFG == 0 ? 4 : 2][CFG == 2 ? 3 : 2]) {
  constexpr int MI = CFG == 0 ? 4 : 2;
  constexpr int NJ = CFG == 2 ? 3 : 2;
  int tid = threadIdx.x;
  asm volatile("" : "+v"(tid));
  const int lane = tid & 63, wave = tid >> 6;
  const int wm = CFG == 0 ? (wave >> 2) : (wave >> 1);
  const int wn = CFG == 0 ? (wave & 3) : (wave & 1);
  const int srow = tid >> 3, scol = tid & 7;
  const u16* ag = Ag + (size_t)srow * lda + scol * 8;
  const u16* bg = Bg + (size_t)srow * ldb + scol * 8;
  uint4 r0a0, r0a1, r0a2, r0a3, r0b0, r0b1, r0b2, r0b3, r1a0, r1a1, r1a2, r1a3, r1b0, r1b1, r1b2, r1b3;
#define G_LOAD(R, ko_) do { \
    R##a0 = *(const uint4*)(ag + (ko_)); R##a1 = *(const uint4*)(ag + (size_t)64 * lda + (ko_)); \
    R##a2 = *(const uint4*)(ag + (size_t)128 * lda + (ko_)); R##a3 = *(const uint4*)(ag + (size_t)192 * lda + (ko_)); \
    R##b0 = *(const uint4*)(bg + (ko_)); R##b1 = *(const uint4*)(bg + (size_t)64 * ldb + (ko_)); \
    if (CFG != 1) R##b2 = *(const uint4*)(bg + (size_t)128 * ldb + (ko_)); \
    if (CFG == 0) R##b3 = *(const uint4*)(bg + (size_t)192 * ldb + (ko_)); } while (0)
#define G_STORE(R, base_) do { char* b_ = (base_) + wofs; \
    *(uint4*)(b_) = R##a0; *(uint4*)(b_ + 64 * LROW) = R##a1; *(uint4*)(b_ + 128 * LROW) = R##a2; *(uint4*)(b_ + 192 * LROW) = R##a3; \
    *(uint4*)(b_ + 256 * LROW) = R##b0; *(uint4*)(b_ + 320 * LROW) = R##b1; \
    if (CFG != 1) *(uint4*)(b_ + 384 * LROW) = R##b2; \
    if (CFG == 0) *(uint4*)(b_ + 448 * LROW) = R##b3; } while (0)
  const int wofs = srow * LROW + scol * 16;
  const int aofs = (wm * (MI * 32) + (lane & 31)) * LROW + (lane >> 5) * 16;
  const int bofs = 256 * LROW + (wn * (NJ * 32) + (lane & 31)) * LROW + (lane >> 5) * 16;
  bf16x8 fa[2][MI], fb[2][NJ];
#define LOADF(buf_, ks_) do { \
    _Pragma("unroll") \
    for (int nj_ = 0; nj_ < NJ; ++nj_) fb[buf_][nj_] = *(const bf16x8*)(cur + bofs + nj_ * 32 * LROW + (ks_) * 32); \
    _Pragma("unroll") \
    for (int mi_ = 0; mi_ < MI; ++mi_) fa[buf_][mi_] = *(const bf16x8*)(cur + aofs + mi_ * 32 * LROW + (ks_) * 32); } while (0)
#define G_STEP(R, kt_, AH_) do { \
    constexpr int kt__ = (kt_); \
    if (kt__ < NK) { \
      const char* cur = smem + (kt__ & 1) * GSTAGE; \
      __syncthreads(); \
      if (kt__ + 1 < NK) G_STORE(R, smem + ((kt__ + 1) & 1) * GSTAGE); \
      if (kt__ + (AH_) < NK) G_LOAD(R, (kt__ + (AH_)) * 64); \
      __builtin_amdgcn_sched_barrier(0); \
      LOADF(0, 0); \
      _Pragma("unroll") \
      for (int ks = 0; ks < 4; ++ks) { \
        if (ks < 3) LOADF((ks + 1) & 1, ks + 1); \
        __builtin_amdgcn_s_setprio(1); \
        _Pragma("unroll") \
        for (int mi = 0; mi < MI; ++mi) { \
          _Pragma("unroll") \
          for (int nj = 0; nj < NJ; ++nj) acc[mi][nj] = MFMA(fa[ks & 1][mi], fb[ks & 1][nj], acc[mi][nj]); \
        } \
        __builtin_amdgcn_s_setprio(0); \
      } \
      __builtin_amdgcn_sched_barrier(0); \
    } \
  } while (0)
  static_assert(NK >= 4 && NK <= 16, "K tiles");
  G_LOAD(r0, 0);
  G_STORE(r0, smem);
  G_LOAD(r0, 64);
  if (CFG != 1) {
    G_STEP(r0, 0, 2);  G_STEP(r0, 1, 2);  G_STEP(r0, 2, 2);  G_STEP(r0, 3, 2);
    G_STEP(r0, 4, 2);  G_STEP(r0, 5, 2);  G_STEP(r0, 6, 2);  G_STEP(r0, 7, 2);
    G_STEP(r0, 8, 2);  G_STEP(r0, 9, 2);  G_STEP(r0, 10, 2); G_STEP(r0, 11, 2);
    G_STEP(r0, 12, 2); G_STEP(r0, 13, 2); G_STEP(r0, 14, 2); G_STEP(r0, 15, 2);
  } else {
    G_LOAD(r1, 128);
    G_STEP(r0, 0, 3);  G_STEP(r1, 1, 3);  G_STEP(r0, 2, 3);  G_STEP(r1, 3, 3);
    G_STEP(r0, 4, 3);  G_STEP(r1, 5, 3);  G_STEP(r0, 6, 3);  G_STEP(r1, 7, 3);
    G_STEP(r0, 8, 3);  G_STEP(r1, 9, 3);  G_STEP(r0, 10, 3); G_STEP(r1, 11, 3);
    G_STEP(r0, 12, 3); G_STEP(r1, 13, 3); G_STEP(r0, 14, 3); G_STEP(r1, 15, 3);
  }
}

DI void tile_remap(int item, int FG, int NFG, int& ft, int& tt) {
  const int G = gridDim.x;
  if (G & 7) { const int NF = FG * NFG; ft = item % NF; tt = item / NF; return; }
  const int b = item % G, k = item / G;
  const int xcd = b & 7, q = (b >> 3) + k * (G >> 3);
  const int S = FG * 8;
  const int sq = q / S, r = q - sq * S;
  const int sidx = sq * 8 + xcd;
  const int ftg = sidx % NFG, ttg = sidx / NFG;
  ft = ftg * FG + r % FG;
  tt = ttg * 8 + r / FG;
}

DI void kv_rows_out(float* wbuf, int lane, float* gbase  , int tok0) {
#pragma unroll
  for (int i = 0; i < 8; ++i) {
    const int row = 4 * i + (lane >> 4), col = (lane & 15) * 4;
    const float4 v = *(const float4*)(wbuf + row * 68 + col);
    if (tok0 + row < TP) *(float4*)(gbase + (size_t)row * 512 + col) = v;
  }
}

template <int EPI>
DI void gemm_item(const P& p, int item, char* smem) {
  constexpr int CFG = (EPI == 1) ? 2 : (EPI == 3) ? 0 : 1;
  constexpr int MI = CFG == 0 ? 4 : 2;
  constexpr int NJ = CFG == 2 ? 3 : 2;
  constexpr int TNT = CFG == 0 ? 256 : (CFG == 2 ? 192 : 128);
  int tid = threadIdx.x;
  asm volatile("" : "+v"(tid));
  const int lane = tid & 63, wave = tid >> 6, l31 = lane & 31, hh = lane >> 5;
  const int wm = CFG == 0 ? (wave >> 2) : (wave >> 1);
  const int wn = CFG == 0 ? (wave & 3) : (wave & 1);
  const u16 *A, *B; int lda, ldb, f0, t0, grp = 0;
  if (EPI == 1) { int ft, tt; tile_remap(item, 7, 2, ft, tt); f0 = ft * 256; t0 = tt * TNT; A = (const u16*)(p.ws + WS_WIN0) + (size_t)f0 * 1024; lda = 1024; B = (const u16*)(p.ws + WS_R0) + (size_t)t0 * 1024; ldb = 1024; }
  else if (EPI == 2) { int ft, tt; tile_remap(item, 4, 1, ft, tt); f0 = ft * 256; t0 = tt * TNT; A = (const u16*)(p.ws + WS_WOUT0) + (size_t)f0 * 1024; lda = 1024; B = (const u16*)(p.ws + WS_R0) + (size_t)t0 * 1024; ldb = 1024; }
  else if (EPI == 3) { int ft, tt; tile_remap(item, 4, 2, ft, tt); f0 = ft * 256; t0 = tt * TNT; A = (const u16*)(p.ws + WS_WIN1) + (size_t)f0 * 1024; lda = 1024; B = (const u16*)(p.ws + WS_R1) + (size_t)t0 * 1024; ldb = 1024; }
  else if (EPI == 4) { grp = item & 3; const int tt = item >> 2; f0 = 0; t0 = tt * TNT; A = (const u16*)(p.ws + WS_WPOOL) + grp * 65536; lda = 256; B = (const u16*)(p.ws + WS_R3) + (size_t)t0 * 1024 + grp * 256; ldb = 1024; }
  else { int ft, tt; tile_remap(item, 4, 1, ft, tt); f0 = ft * 256; t0 = tt * TNT; A = (const u16*)(p.ws + WS_WOUT1) + (size_t)f0 * 1024; lda = 1024; B = (const u16*)(p.ws + WS_R0) + (size_t)t0 * 1024; ldb = 1024; }

  f32x16 acc[MI][NJ];
#pragma unroll
  for (int a = 0; a < MI; ++a)
#pragma unroll
    for (int b = 0; b < NJ; ++b)
#pragma unroll
      for (int i = 0; i < 16; ++i) acc[a][b][i] = 0.f;
  if (EPI == 4 && t0 >= TP) {
    const int w = 2 << grp, hw = w >> 1;
    const int s0 = TP + ((t0 - TP) & ~4095), s1 = s0 + 4096;
    int rfix0, nfix;
    if ((t0 & 255) == 0) { rfix0 = t0; nfix = (t0 != s0) ? hw : 0; }
    else { nfix = (t0 + 128 != s1) ? (w - hw - 1) : 0; rfix0 = t0 + 128 - nfix; }
    const int rr = tid >> 6, cc = grp * 256 + (tid & 63) * 4;
    if (rr < nfix) {
      const u16* U1 = (const u16*)(p.ws + WS_R0);
      const int t = rfix0 + rr;
      const int lo = max(t - hw, s0), hi = min(t + w - hw, s1);
      float a0 = 0.f, a1 = 0.f, a2 = 0.f, a3 = 0.f;
      for (int tt = lo; tt < hi; ++tt) {
        const uint2 v = *(const uint2*)(U1 + (size_t)tt * 1024 + cc);
        a0 += bflo(v.x); a1 += bfhi(v.x); a2 += bflo(v.y); a3 += bfhi(v.y);
      }
      const uint2 cv = *(const uint2*)(U1 + (size_t)t * 1024 + cc);
      const float rc = 1.f / (float)(hi - lo);
      uint2 o; o.x = pack2(a0 * rc - bflo(cv.x), a1 * rc - bfhi(cv.x)); o.y = pack2(a2 * rc - bflo(cv.y), a3 * rc - bfhi(cv.y));
      *(uint2*)((u16*)(p.ws + WS_R3) + (size_t)t * 1024 + cc) = o;
    }
    asm volatile("s_waitcnt vmcnt(0)" ::: "memory");
    __syncthreads();
  }
  if (EPI == 4) gemm_mainloop<4, CFG>(A, lda, B, ldb, smem, acc); else gemm_mainloop<16, CFG>(A, lda, B, ldb, smem, acc);

  if (EPI == 2 || EPI == 4 || EPI == 5) {
    constexpr int SP = 260;
    float* st = (float*)smem;
    __syncthreads();
#pragma unroll
    for (int nj = 0; nj < 2; ++nj) {
      const int tokl = wn * 64 + nj * 32 + l31;
#pragma unroll
      for (int mi = 0; mi < 2; ++mi)
#pragma unroll
        for (int g = 0; g < 4; ++g)
          *(float4*)(st + tokl * SP + wm * 64 + mi * 32 + 8 * g + 4 * hh) = make_float4(acc[mi][nj][4 * g], acc[mi][nj][4 * g + 1], acc[mi][nj][4 * g + 2], acc[mi][nj][4 * g + 3]);
    }
    __syncthreads();
    const int col = lane * 4;
    if (EPI == 4) {
      const u16* SG1 = (const u16*)(p.ws + WS_R2);
      u16* Z1 = (u16*)(p.ws + WS_R0);
      const float4 sc = *(const float4*)(p.pool_scale + grp * 256 + col);
#pragma unroll 4
      for (int r = 0; r < 16; ++r) {
        const int tokl = wave * 16 + r, tok = t0 + tokl;
        const float4 a = *(const float4*)(st + tokl * SP + col);
        const uint2 sg = *(const uint2*)(SG1 + (size_t)tok * 1024 + grp * 256 + col);
        uint2 o;
        o.x = pack2(a.x * sc.x * bflo(sg.x), a.y * sc.y * bfhi(sg.x));
        o.y = pack2(a.z * sc.z * bflo(sg.y), a.w * sc.w * bfhi(sg.y));
        *(uint2*)(Z1 + (size_t)tok * 1024 + grp * 256 + col) = o;
      }
    } else {
      const int layer = (EPI == 2) ? 0 : 1;
      const float4 gv = *(const float4*)((const float*)(p.ws + WS_MOD) + (size_t)(layer * 5 + midx(t0)) * 3072 + 2048 + f0 + col);
      float4 a1 = make_float4(0.f, 0.f, 0.f, 0.f);
      if (EPI == 2) {
        const float4 g1 = *(const float4*)(p.norm_g1 + f0 + col);
        const float4 sc1 = *(const float4*)((const float*)(p.ws + WS_MOD) + (size_t)(5 + midx(t0)) * 3072 + 1024 + f0 + col);
        a1 = make_float4(g1.x * (1.f + sc1.x), g1.y * (1.f + sc1.y), g1.z * (1.f + sc1.z), g1.w * (1.f + sc1.w));
      }
      float ssq[16];
#pragma unroll
      for (int r = 0; r < 16; ++r) {
        const int tokl = wave * 16 + r, tok = t0 + tokl;
        const float4 a = *(const float4*)(st + tokl * SP + col);
        const float* xr = ((EPI == 2) ? xrow(p, tok) : (p.out + (size_t)tok * 1024)) + f0 + col;
        const float4 xv = *(const float4*)xr;
        float4 o;
        o.x = xv.x + gv.x * a.x; o.y = xv.y + gv.y * a.y; o.z = xv.z + gv.z * a.z; o.w = xv.w + gv.w * a.w;
        *(float4*)(p.out + (size_t)tok * 1024 + f0 + col) = o;
        if (EPI == 2) {
          uint2 ya; ya.x = pack2(o.x * a1.x, o.y * a1.y); ya.y = pack2(o.z * a1.z, o.w * a1.w);
          *(uint2*)((u16*)(p.ws + WS_R1) + (size_t)tok * 1024 + f0 + col) = ya;
          ssq[r] = o.x * o.x + o.y * o.y + o.z * o.z + o.w * o.w;
        }
      }
      if (EPI == 2) {
#pragma unroll
        for (int half = 8, bit = 32; half >= 1; half >>= 1, bit >>= 1) {
          const bool up = (lane & bit) != 0;
#pragma unroll
          for (int k = 0; k < half; ++k) {
            const float keep = up ? ssq[k + half] : ssq[k];
            const float send = up ? ssq[k] : ssq[k + half];
            ssq[k] = keep + __shfl_xor(send, bit);
          }
        }
        ssq[0] += __shfl_xor(ssq[0], 2);
        ssq[0] += __shfl_xor(ssq[0], 1);
        if ((lane & 3) == 0) atomicAdd((float*)(p.ws + WS_SS) + t0 + wave * 16 + (lane >> 2), ssq[0]);
      }
    }
    return;
  }
  const int tokb = t0 + wn * (NJ * 32);
  if (EPI == 3) __syncthreads();
  if (EPI == 1 && t0 < TP && f0 >= 2048 && f0 < 3072) __syncthreads();
#pragma unroll
  for (int fblk = 0; fblk < MI / 2; ++fblk) {
  const int fb = f0 + wm * (MI * 32) + fblk * 64;
  if (EPI == 1) {
    u16* U = (u16*)(p.ws + WS_UP);
    u16* SGA = (u16*)(p.ws + WS_R1 + HALF_R);
    u16* Q = (u16*)(p.ws + WS_R2);
    u16* Kb = (u16*)(p.ws + WS_R2 + HALF_R);
    u16* VT = (u16*)(p.ws + WS_R3);
    u16* SGB = (u16*)(p.ws + WS_R3 + HALF_R);
#pragma unroll
    for (int nj = 0; nj < NJ; ++nj) {
      const int tok = tokb + nj * 32 + l31;
      const bool kvst = (tokb + nj * 32 < TP);
      float* wbuf = (float*)smem + wave * (32 * 68);
      f32x16& X = acc[2 * fblk][nj];
      f32x16& Y = acc[2 * fblk + 1][nj];
      if (fb < 1024) {
        const int cb = (fb >> 6) * 32;
        float u[16];
#pragma unroll
        for (int i = 0; i < 16; ++i) u[i] = X[i] * sigm_f(Y[i]);
#pragma unroll
        for (int i = 0; i < 8; ++i) swap32(u[i], u[i + 8]);
#pragma unroll
        for (int gg = 0; gg < 2; ++gg) {
          uint4 o;
          o.x = pack2(u[4 * gg], u[4 * gg + 1]); o.y = pack2(u[4 * gg + 2], u[4 * gg + 3]);
          o.z = pack2(u[8 + 4 * gg], u[8 + 4 * gg + 1]); o.w = pack2(u[8 + 4 * gg + 2], u[8 + 4 * gg + 3]);
          *(uint4*)(U + (size_t)prow(tok) * 512 + cb + 16 * hh + 8 * gg) = o;
        }
      } else if (fb < 1536 || fb >= 3072) {
        u16* dst = (fb < 1536) ? (SGA + (size_t)tok * 512 + (fb - 1024)) : (SGB + (size_t)tok * 512 + (fb - 3072));
#pragma unroll
        for (int i = 0; i < 16; ++i) { X[i] = silu_f(X[i]); Y[i] = silu_f(Y[i]); }
        swap32v(X, Y);
#pragma unroll
        for (int g = 0; g < 4; ++g) {
          uint4 o;
          o.x = pack2(X[4 * g], X[4 * g + 1]); o.y = pack2(X[4 * g + 2], X[4 * g + 3]);
          o.z = pack2(Y[4 * g], Y[4 * g + 1]); o.w = pack2(Y[4 * g + 2], Y[4 * g + 3]);
          *(uint4*)(dst + 32 * hh + 8 * g) = o;
        }
      } else if (fb < 2560) {
        const bool isq = fb < 2048;
        const int hc = isq ? (fb - 1536) : (fb - 2048);
        float ss = 0.f;
#pragma unroll
        for (int i = 0; i < 16; ++i) ss += X[i] * X[i] + Y[i] * Y[i];
        ss += __shfl_xor(ss, 32);
        const float rinv = rsqrtf(ss * (1.f / 64.f) + EPS);
        swap32v(X, Y);
        const float* nw = (isq ? p.q_norm : p.k_norm) + 32 * hh;
        const float qs = isq ? (0.125f * 1.4426950408889634f) : 1.f;
        u16* dst = isq ? (Q + (size_t)tok * 512 + hc + 32 * hh) : (Kb + ((size_t)(hc >> 6) * TT + tok) * 64 + 32 * hh);
        float* kout = p.out + (size_t)TT * 1024 + (size_t)tok * 512 + hc + 32 * hh;
#pragma unroll
        for (int g = 0; g < 4; ++g) {
          const float4 w0 = *(const float4*)(nw + 8 * g);
          const float4 w1 = *(const float4*)(nw + 8 * g + 4);
          float4 v0, v1;
          v0.x = X[4 * g] * rinv * w0.x; v0.y = X[4 * g + 1] * rinv * w0.y; v0.z = X[4 * g + 2] * rinv * w0.z; v0.w = X[4 * g + 3] * rinv * w0.w;
          v1.x = Y[4 * g] * rinv * w1.x; v1.y = Y[4 * g + 1] * rinv * w1.y; v1.z = Y[4 * g + 2] * rinv * w1.z; v1.w = Y[4 * g + 3] * rinv * w1.w;
          if (!isq && kvst) { *(float4*)(wbuf + l31 * 68 + 32 * hh + 8 * g) = v0; *(float4*)(wbuf + l31 * 68 + 32 * hh + 8 * g + 4) = v1; }
          uint4 o;
          o.x = pack2(v0.x * qs, v0.y * qs); o.y = pack2(v0.z * qs, v0.w * qs);
          o.z = pack2(v1.x * qs, v1.y * qs); o.w = pack2(v1.z * qs, v1.w * qs);
          *(uint4*)(dst + 8 * g) = o;
        }
        if (!isq && kvst) kv_rows_out(wbuf, lane, p.out + (size_t)TT * 1024 + (size_t)(tokb + nj * 32) * 512 + hc, tokb + nj * 32);
      } else {
        const int hc = fb - 2560;
#pragma unroll
        for (int mi = 0; mi < 2; ++mi)
#pragma unroll
          for (int i = 0; i < 16; ++i) VT[(((size_t)(hc >> 6) * (TT / 64) + (tok >> 6)) * 64 + mi * 32 + crow(i, hh)) * 64 + (tok & 63)] = f2bf(acc[2 * fblk + mi][nj][i]);
        if (kvst) {
          swap32v(X, Y);
#pragma unroll
          for (int g = 0; g < 4; ++g) {
            *(float4*)(wbuf + l31 * 68 + 32 * hh + 8 * g) = make_float4(X[4 * g], X[4 * g + 1], X[4 * g + 2], X[4 * g + 3]);
            *(float4*)(wbuf + l31 * 68 + 32 * hh + 8 * g + 4) = make_float4(Y[4 * g], Y[4 * g + 1], Y[4 * g + 2], Y[4 * g + 3]);
          }
          kv_rows_out(wbuf, lane, p.out + (size_t)TT * 1024 + (size_t)TP * 512 + (size_t)(tokb + nj * 32) * 512 + hc, tokb + nj * 32);
        }
      }
    }
  } else if (EPI == 2 || EPI == 5) {
    const int layer = (EPI == 2) ? 0 : 1;
#pragma unroll
    for (int nj = 0; nj < 2; ++nj) {
      const int tok = tokb + nj * 32 + l31;
      f32x16& X = acc[2 * fblk][nj];
      f32x16& Y = acc[2 * fblk + 1][nj];
      swap32v(X, Y);
      const int colb = fb + 32 * hh;
      const float* gate = (const float*)(p.ws + WS_MOD) + (size_t)(layer * 5 + midx(tok)) * 3072 + 2048 + colb;
      const float* xr = ((EPI == 2) ? xrow(p, tok) : (p.out + (size_t)tok * 1024)) + colb;
      float* yr = p.out + (size_t)tok * 1024 + colb;
#pragma unroll
      for (int g = 0; g < 4; ++g) {
        const float4 x0 = *(const float4*)(xr + 8 * g), x1 = *(const float4*)(xr + 8 * g + 4);
        const float4 g0 = *(const float4*)(gate + 8 * g), g1 = *(const float4*)(gate + 8 * g + 4);
        float4 o0, o1;
        o0.x = x0.x + g0.x * X[4 * g]; o0.y = x0.y + g0.y * X[4 * g + 1]; o0.z = x0.z + g0.z * X[4 * g + 2]; o0.w = x0.w + g0.w * X[4 * g + 3];
        o1.x = x1.x + g1.x * Y[4 * g]; o1.y = x1.y + g1.y * Y[4 * g + 1]; o1.z = x1.z + g1.z * Y[4 * g + 2]; o1.w = x1.w + g1.w * Y[4 * g + 3];
        *(float4*)(yr + 8 * g) = o0; *(float4*)(yr + 8 * g + 4) = o1;
      }
    }
  } else if (EPI == 3) {
    u16* U1 = (u16*)(p.ws + WS_R0);
    u16* SG1 = (u16*)(p.ws + WS_R2);
#pragma unroll
    for (int nj = 0; nj < 2; ++nj) {
      const int tok = tokb + nj * 32 + l31;
      f32x16& X = acc[2 * fblk][nj];
      f32x16& Y = acc[2 * fblk + 1][nj];
      swap32v(X, Y);
      {
        const float rinv = rsqrtf(((const float*)(p.ws + WS_SS))[tok] * (1.f / 1024.f) + EPS);
        const float* sw = (const float*)(p.ws + WS_SW) + midx(tok) * 2048 + fb + 32 * hh;
#pragma unroll
        for (int g = 0; g < 4; ++g) {
          const float4 s0 = *(const float4*)(sw + 8 * g), s1 = *(const float4*)(sw + 8 * g + 4);
          X[4 * g] = X[4 * g] * rinv + s0.x; X[4 * g + 1] = X[4 * g + 1] * rinv + s0.y; X[4 * g + 2] = X[4 * g + 2] * rinv + s0.z; X[4 * g + 3] = X[4 * g + 3] * rinv + s0.w;
          Y[4 * g] = Y[4 * g] * rinv + s1.x; Y[4 * g + 1] = Y[4 * g + 1] * rinv + s1.y; Y[4 * g + 2] = Y[4 * g + 2] * rinv + s1.z; Y[4 * g + 3] = Y[4 * g + 3] * rinv + s1.w;
        }
      }
      if (fb >= 1024) {
#pragma unroll
        for (int i = 0; i < 16; ++i) { X[i] = silu_f(X[i]); Y[i] = silu_f(Y[i]); }
      }
      char* dst = smem + (wn * 64 + nj * 32 + l31) * 528 + (fb - f0 + 32 * hh) * 2;
#pragma unroll
      for (int g = 0; g < 4; ++g) {
        uint4 o;
        o.x = pack2(X[4 * g], X[4 * g + 1]); o.y = pack2(X[4 * g + 2], X[4 * g + 3]);
        o.z = pack2(Y[4 * g], Y[4 * g + 1]); o.w = pack2(Y[4 * g + 2], Y[4 * g + 3]);
        *(uint4*)(dst + 16 * g) = o;
      }
    }
  } else {
    const u16* SG1 = (const u16*)(p.ws + WS_R2);
    u16* Z1 = (u16*)(p.ws + WS_R0);
#pragma unroll
    for (int nj = 0; nj < 2; ++nj) {
      const int tok = tokb + nj * 32 + l31;
      f32x16& X = acc[2 * fblk][nj];
      f32x16& Y = acc[2 * fblk + 1][nj];
      swap32v(X, Y);
      const int colb = grp * 256 + fb + 32 * hh;
#pragma unroll
      for (int g = 0; g < 4; ++g) {
        const float4 s0 = *(const float4*)(p.pool_scale + colb + 8 * g), s1 = *(const float4*)(p.pool_scale + colb + 8 * g + 4);
        const uint4 sg = *(const uint4*)(SG1 + (size_t)tok * 1024 + colb + 8 * g);
        uint4 o;
        o.x = pack2(X[4 * g] * s0.x * bflo(sg.x), X[4 * g + 1] * s0.y * bfhi(sg.x));
        o.y = pack2(X[4 * g + 2] * s0.z * bflo(sg.y), X[4 * g + 3] * s0.w * bfhi(sg.y));
        o.z = pack2(Y[4 * g] * s1.x * bflo(sg.z), Y[4 * g + 1] * s1.y * bfhi(sg.z));
        o.w = pack2(Y[4 * g + 2] * s1.z * bflo(sg.w), Y[4 * g + 3] * s1.w * bfhi(sg.w));
        *(uint4*)(Z1 + (size_t)tok * 1024 + colb + 8 * g) = o;
      }
    }
  }
  }
  if (EPI == 3) {
    __syncthreads();
    u16* dstg = (f0 < 1024) ? ((u16*)(p.ws + WS_R0) + f0) : ((u16*)(p.ws + WS_R2) + f0 - 1024);
#pragma unroll 4
    for (int i = 0; i < 16; ++i) {
      const int row = wave * 32 + 2 * i + (lane >> 5), ch = lane & 31;
      const uint4 v = *(const uint4*)(smem + row * 528 + ch * 16);
      *(uint4*)(dstg + (size_t)(t0 + row) * 1024 + ch * 8) = v;
    }
    if (f0 < 1024) {
      const int w = 2 << (f0 >> 8), hw = w >> 1;
      int seqlo = 0, seqhi = 256;
      if (t0 >= TP) { const int s0 = TP + ((t0 - TP) & ~4095); seqlo = s0 - t0; seqhi = s0 + 4096 - t0; }
      const int lo_ok = max(seqlo, 0), hi_ok = min(seqhi, 256);
      const int ch = lane & 31, rb = wave * 32 + (lane >> 5) * 16;
      u16* Dd = (u16*)(p.ws + WS_R3);
      float sm[8];
#pragma unroll
      for (int k = 0; k < 8; ++k) sm[k] = 0.f;
#define EP_ACC(v_, m_) do { \
      sm[0] += (m_) * bflo((v_).x); sm[1] += (m_) * bfhi((v_).x); sm[2] += (m_) * bflo((v_).y); sm[3] += (m_) * bfhi((v_).y); \
      sm[4] += (m_) * bflo((v_).z); sm[5] += (m_) * bfhi((v_).z); sm[6] += (m_) * bflo((v_).w); sm[7] += (m_) * bfhi((v_).w); } while (0)
#pragma unroll
      for (int j = 0; j < 15; ++j) {
        const int t = rb - hw + j;
        const uint4 v = *(const uint4*)(smem + min(max(t, 0), 255) * 528 + ch * 16);
        const float mk = (j < w - 1 && t >= lo_ok && t < hi_ok) ? 1.f : 0.f;
        EP_ACC(v, mk);
      }
#pragma unroll 4
      for (int i = 0; i < 16; ++i) {
        const int r = rb + i;
        const int ta = r + w - hw - 1, tr = r - hw - 1;
        const uint4 va = *(const uint4*)(smem + min(ta, 255) * 528 + ch * 16);
        const uint4 vr = *(const uint4*)(smem + max(tr, 0) * 528 + ch * 16);
        const uint4 cv = *(const uint4*)(smem + r * 528 + ch * 16);
        const float ma = (ta < hi_ok) ? 1.f : 0.f;
        const float mr = (tr >= lo_ok && i > 0) ? -1.f : 0.f;
        EP_ACC(va, ma);
        EP_ACC(vr, mr);
        const int lo = max(r - hw, seqlo), hi = min(r + w - hw, seqhi);
        if (lo >= 0 && hi <= 256) {
          const float rc = 1.f / (float)(hi - lo);
          uint4 o;
          o.x = pack2(sm[0] * rc - bflo(cv.x), sm[1] * rc - bfhi(cv.x));
          o.y = pack2(sm[2] * rc - bflo(cv.y), sm[3] * rc - bfhi(cv.y));
          o.z = pack2(sm[4] * rc - bflo(cv.z), sm[5] * rc - bfhi(cv.z));
          o.w = pack2(sm[6] * rc - bflo(cv.w), sm[7] * rc - bfhi(cv.w));
          *(uint4*)(Dd + (size_t)(t0 + r) * 1024 + f0 + ch * 8) = o;
        }
      }
    }
  }
}

constexpr int P3_NA = 1024, P3_CTX = 512, P3_CONV = 1536, P3_ITEMS = P3_NA + P3_CTX + P3_CONV;

typedef float f32x2 __attribute__((ext_vector_type(2)));
DI void conv_item(const P& p, int it, char* smem) {
  const int tid = (threadIdx.x & 255), lane = tid & 63, wave = tid >> 6;
  const int t0 = it * 16;
  const int c = 2 * tid;
  const u16* UP = (const u16*)(p.ws + WS_UP) + (size_t)(prow(t0) - 15) * 512 + c;
  const u16* SGA = (const u16*)(p.ws + WS_R1 + HALF_R);
  u16* Z = (u16*)(p.ws + WS_R0);
  float* ylds = (float*)smem;
  f32x2 w[31];
#pragma unroll
  for (int j = 0; j < 31; ++j) w[j] = *(const f32x2*)(p.conv_w + j * 512 + c);
  const f32x2 cb = *(const f32x2*)(p.conv_b + c);
  unsigned uv[46];
#pragma unroll
  for (int r = 0; r < 46; ++r) uv[r] = *(const unsigned*)(UP + r * 512);
#pragma unroll
  for (int grp = 0; grp < 2; ++grp) {
    f32x2 y[8];
#pragma unroll
    for (int i = 0; i < 8; ++i) y[i] = cb;
#pragma unroll
    for (int r = 0; r < 38; ++r) {
      const unsigned v = uv[grp * 8 + r];
      f32x2 vv; vv.x = bflo(v); vv.y = bfhi(v);
#pragma unroll
      for (int i = 0; i < 8; ++i) {
        const int j = r - i;
        if (j >= 0 && j <= 30) y[i] = __builtin_elementwise_fma(vv, w[j], y[i]);
      }
    }
#pragma unroll
    for (int i = 0; i < 8; ++i) *(f32x2*)(ylds + (grp * 8 + i) * 512 + c) = y[i];
  }
  __syncthreads();
  const int c1 = lane * 4, c2 = 256 + lane * 4;
  const float4 g1 = *(const float4*)(p.ln_g + c1), g2 = *(const float4*)(p.ln_g + c2);
  const float4 b1 = *(const float4*)(p.ln_b + c1), b2 = *(const float4*)(p.ln_b + c2);
#pragma unroll
  for (int tt = 0; tt < 4; ++tt) {
    const int tl = wave * 4 + tt, tok = t0 + tl;
    const float4 a = *(const float4*)(ylds + tl * 512 + c1), b = *(const float4*)(ylds + tl * 512 + c2);
    float s1 = a.x + a.y + a.z + a.w + b.x + b.y + b.z + b.w;
    float s2 = a.x * a.x + a.y * a.y + a.z * a.z + a.w * a.w + b.x * b.x + b.y * b.y + b.z * b.z + b.w * b.w;
#pragma unroll
    for (int o = 32; o >= 1; o >>= 1) { s1 += __shfl_xor(s1, o); s2 += __shfl_xor(s2, o); }
    const float mean = s1 * (1.f / 512.f);
    const float var = fmaxf(s2 * (1.f / 512.f) - mean * mean, 0.f);
    const float rstd = rsqrtf(var + EPS);
    const uint2 ga1 = *(const uint2*)(SGA + (size_t)tok * 512 + c1), ga2 = *(const uint2*)(SGA + (size_t)tok * 512 + c2);
    uint2 o1, o2;
    o1.x = pack2(silu_f((a.x - mean) * rstd * g1.x + b1.x) * bflo(ga1.x), silu_f((a.y - mean) * rstd * g1.y + b1.y) * bfhi(ga1.x));
    o1.y = pack2(silu_f((a.z - mean) * rstd * g1.z + b1.z) * bflo(ga1.y), silu_f((a.w - mean) * rstd * g1.w + b1.w) * bfhi(ga1.y));
    o2.x = pack2(silu_f((b.x - mean) * rstd * g2.x + b2.x) * bflo(ga2.x), silu_f((b.y - mean) * rstd * g2.y + b2.y) * bfhi(ga2.x));
    o2.y = pack2(silu_f((b.z - mean) * rstd * g2.z + b2.z) * bflo(ga2.y), silu_f((b.w - mean) * rstd * g2.w + b2.w) * bfhi(ga2.y));
    *(uint2*)(Z + (size_t)tok * 1024 + c1) = o1;
    *(uint2*)(Z + (size_t)tok * 1024 + c2) = o2;
  }
}

constexpr int ACH = 64 * LROW;
constexpr int ABUF = 2 * ACH;

DI void attn_item(const P& p, int it, char* smem) {
  const int tid = (threadIdx.x & 255), lane = tid & 63, wave = tid >> 6, l31 = lane & 31, hh = lane >> 5;
  const bool is_na = it < P3_NA;
  const u16* Qb = (const u16*)(p.ws + WS_R2);
  const u16* Kb = (const u16*)(p.ws + WS_R2 + HALF_R);
  const u16* VT = (const u16*)(p.ws + WS_R3);
  const u16* SGB = (const u16*)(p.ws + WS_R3 + HALF_R);
  const u16* KC = (const u16*)(p.ws + WS_KC);
  const u16* VTC = (const u16*)(p.ws + WS_VTC);
  u16* Z = (u16*)(p.ws + WS_R0);
  int b, head, qtok, nchunks, tokbase;
  int r = 0, c = 0, qcs = 0, rsw = 0, rs_lo = 0;
  if (is_na) {
    b = it >> 8; head = it & 7; const int r0 = 2 * ((it >> 3) & 31);
    r = r0 + (wave >> 1); c = (wave & 1) * 32 + l31;
    qcs = min(max(c - 8, 0), 48);
    rsw = min(max(r - 4, 0), 56);
    rs_lo = min(max(r0 - 4, 0), 56);
    const int rs_hi = min(max(r0 - 3, 0), 56);
    tokbase = TP + b * 4096;
    qtok = tokbase + r * 64 + c;
    nchunks = 8 + rs_hi + 8 - rs_lo;
  } else {
    const int j = it - P3_NA;
    b = j >> 4; head = (j >> 1) & 7;
    tokbase = b * 256;
    qtok = tokbase + (j & 1) * 128 + wave * 32 + l31;
    nchunks = 4;
  }
  float* rpb_s = (float*)(smem + 2 * ABUF);
  if (is_na) for (int i = tid; i < 465; i += 256) rpb_s[i] = p.rpb[head * 465 + i] * 1.4426950408889634f;

  bf16x8 qf[4];
#pragma unroll
  for (int ks = 0; ks < 4; ++ks) qf[ks] = *(const bf16x8*)(Qb + (size_t)qtok * 512 + head * 64 + ks * 16 + hh * 8);

  f32x16 o0, o1;
#pragma unroll
  for (int i = 0; i < 16; ++i) { o0[i] = 0.f; o1[i] = 0.f; }
  float m_run = -INFINITY, l_run = 0.f;

  const int prow = tid >> 3, ppart = tid & 7;
  const int vpos0 = (16 * (ppart >> 1) + 4 * (ppart & 1)) * 2, vpos1 = vpos0 + 16;
  uint4 kreg0, kreg1, vreg0, vreg1;
#define LOAD_CHUNK(ci_) do { \
    const int ci__ = (ci_); const u16 *kp, *vp; size_t ks_, vs_; \
    if (is_na && ci__ < 8) { \
      kp = KC + ((size_t)(b * 8 + head) * 512 + ci__ * 64) * 64; ks_ = 64; \
      vp = VTC + ((size_t)(b * 8 + head) * 8 + ci__) * 4096; vs_ = 64; \
    } else { \
      const int kt0 = is_na ? (tokbase + (rs_lo + ci__ - 8) * 64) : (tokbase + ci__ * 64); \
      kp = Kb + ((size_t)head * TT + kt0) * 64; ks_ = 64; \
      vp = VT + ((size_t)head * (TT / 64) + (kt0 >> 6)) * 4096; vs_ = 64; \
    } \
    kreg0 = *(const uint4*)(kp + (size_t)prow * ks_ + ppart * 8); \
    kreg1 = *(const uint4*)(kp + (size_t)(prow + 32) * ks_ + ppart * 8); \
    vreg0 = *(const uint4*)(vp + (size_t)prow * vs_ + ppart * 8); \
    vreg1 = *(const uint4*)(vp + (size_t)(prow + 32) * vs_ + ppart * 8); \
  } while (0)
#define STORE_CHUNK(buf_) do { \
    char* bb_ = (buf_); \
    *(uint4*)(bb_ + prow * LROW + ppart * 16) = kreg0; \
    *(uint4*)(bb_ + (prow + 32) * LROW + ppart * 16) = kreg1; \
    char* vr0 = bb_ + ACH + prow * LROW; char* vr1 = bb_ + ACH + (prow + 32) * LROW; \
    *(uint2*)(vr0 + vpos0) = make_uint2(vreg0.x, vreg0.y); *(uint2*)(vr0 + vpos1) = make_uint2(vreg0.z, vreg0.w); \
    *(uint2*)(vr1 + vpos0) = make_uint2(vreg1.x, vreg1.y); *(uint2*)(vr1 + vpos1) = make_uint2(vreg1.z, vreg1.w); \
  } while (0)
  LOAD_CHUNK(0);
  STORE_CHUNK(smem);
  LOAD_CHUNK(1);
  for (int ci = 0; ci < nchunks; ++ci) {
    const char* cur = smem + (ci & 1) * ABUF;
    __syncthreads();
    STORE_CHUNK(smem + ((ci + 1) & 1) * ABUF);
    LOAD_CHUNK(min(ci + 2, nchunks - 1));
    __builtin_amdgcn_sched_barrier(0);
    bool act = true, window = false; int rowidx = 0;
    if (is_na && ci >= 8) { const int kr = rs_lo + ci - 8; act = (kr >= rsw) && (kr < rsw + 8); window = true; rowidx = kr - r + 7; }
    if (act) {
      f32x16 sa, sb;
#pragma unroll
      for (int i = 0; i < 16; ++i) { sa[i] = 0.f; sb[i] = 0.f; }
#pragma unroll
      for (int ks = 0; ks < 4; ++ks) {
        const bf16x8 ka = *(const bf16x8*)(cur + l31 * LROW + ks * 32 + hh * 16);
        const bf16x8 kb2 = *(const bf16x8*)(cur + (32 + l31) * LROW + ks * 32 + hh * 16);
        sa = MFMA(ka, qf[ks], sa);
        sb = MFMA(kb2, qf[ks], sb);
      }
      if (window) {
        const int kb = 4 * hh;
        const float* rp = rpb_s + rowidx * 31 + (kb - c + 15);
        const int kq = kb - qcs;
#pragma unroll
        for (int i = 0; i < 16; ++i) {
          const int co = (i & 3) + 8 * (i >> 2);
          sa[i] = ((unsigned)(kq + co) < 16u) ? (sa[i] + rp[co]) : -INFINITY;
          sb[i] = ((unsigned)(kq + 32 + co) < 16u) ? (sb[i] + rp[32 + co]) : -INFINITY;
        }
      }
      float mx = fmaxf(sa[0], sb[0]);
#pragma unroll
      for (int i = 1; i < 16; ++i) mx = fmaxf(mx, fmaxf(sa[i], sb[i]));
      mx = fmaxf(mx, __shfl_xor(mx, 32));
      if (__any(mx > m_run + 8.f)) {
        const float m_new = fmaxf(m_run, mx);
        const float alpha = __builtin_amdgcn_exp2f(m_run - m_new);
        m_run = m_new;
        l_run *= alpha;
#pragma unroll
        for (int i = 0; i < 16; ++i) { o0[i] *= alpha; o1[i] *= alpha; }
      }
      float ps = 0.f;
#pragma unroll
      for (int i = 0; i < 16; ++i) { sa[i] = __builtin_amdgcn_exp2f(sa[i] - m_run); sb[i] = __builtin_amdgcn_exp2f(sb[i] - m_run); ps += sa[i] + sb[i]; }
      l_run += ps;
#pragma unroll
      for (int kt = 0; kt < 2; ++kt)
#pragma unroll
        for (int sidx = 0; sidx < 2; ++sidx) {
          union { unsigned u[4]; bf16x8 v; } pb;
#pragma unroll
          for (int q2 = 0; q2 < 4; ++q2) pb.u[q2] = kt ? pack2(sb[8 * sidx + 2 * q2], sb[8 * sidx + 2 * q2 + 1]) : pack2(sa[8 * sidx + 2 * q2], sa[8 * sidx + 2 * q2 + 1]);
          const bf16x8 a0 = *(const bf16x8*)(cur + ACH + l31 * LROW + (kt * 32 + 16 * sidx + 8 * hh) * 2);
          const bf16x8 a1 = *(const bf16x8*)(cur + ACH + (32 + l31) * LROW + (kt * 32 + 16 * sidx + 8 * hh) * 2);
          o0 = MFMA(a0, pb.v, o0);
          o1 = MFMA(a1, pb.v, o1);
        }
    }
    __builtin_amdgcn_sched_barrier(0);
  }
  const float lt = l_run + __shfl_xor(l_run, 32);
  const float inv = 1.f / lt;
  swap32v(o0, o1);
  {
    const u16* sgp = SGB + (size_t)qtok * 512 + head * 64 + 32 * hh;
    u16* zp = Z + (size_t)qtok * 1024 + 512 + head * 64 + 32 * hh;
#pragma unroll
    for (int g = 0; g < 4; ++g) {
      const uint4 sg = *(const uint4*)(sgp + 8 * g);
      uint4 ov;
      ov.x = pack2(o0[4 * g] * inv * bflo(sg.x), o0[4 * g + 1] * inv * bfhi(sg.x));
      ov.y = pack2(o0[4 * g + 2] * inv * bflo(sg.y), o0[4 * g + 3] * inv * bfhi(sg.y));
      ov.z = pack2(o1[4 * g] * inv * bflo(sg.z), o1[4 * g + 1] * inv * bfhi(sg.z));
      ov.w = pack2(o1[4 * g + 2] * inv * bflo(sg.w), o1[4 * g + 3] * inv * bfhi(sg.w));
      *(uint4*)(zp + 8 * g) = ov;
    }
  }
}

DI void pool_item(const P& p, int it) {
  const int tid = (threadIdx.x & 255);
  const int t0 = it * 32 + (tid >> 7) * 16;
  int s0, s1;
  if (t0 < TP) { s0 = t0 & ~255; s1 = s0 + 256; } else { s0 = TP + ((t0 - TP) & ~4095); s1 = s0 + 4096; }
  const int c = (tid & 127) * 8;
  const int w = 2 << (c >> 8), hw = w >> 1;
  const u16* U1 = (const u16*)(p.ws + WS_R0);
  u16* Dd = (u16*)(p.ws + WS_R3);
  float sm[8];
#pragma unroll
  for (int k = 0; k < 8; ++k) sm[k] = 0.f;
#define POOL_ACC(v_, m_) do { \
    sm[0] += (m_) * bflo((v_).x); sm[1] += (m_) * bfhi((v_).x); sm[2] += (m_) * bflo((v_).y); sm[3] += (m_) * bfhi((v_).y); \
    sm[4] += (m_) * bflo((v_).z); sm[5] += (m_) * bfhi((v_).z); sm[6] += (m_) * bflo((v_).w); sm[7] += (m_) * bfhi((v_).w); } while (0)
#pragma unroll
  for (int j = 0; j < 15; ++j) {
    const int t = t0 - hw + j;
    const uint4 v = *(const uint4*)(U1 + (size_t)min(max(t, s0), s1 - 1) * 1024 + c);
    const float mk = (j < w - 1 && t >= s0 && t < s1) ? 1.f : 0.f;
    POOL_ACC(v, mk);
  }
#pragma unroll 8
  for (int i = 0; i < 16; ++i) {
    const int t = t0 + i;
    const int ta = t + w - hw - 1, tr = t - hw - 1;
    const uint4 va = *(const uint4*)(U1 + (size_t)min(max(ta, s0), s1 - 1) * 1024 + c);
    const uint4 vr = *(const uint4*)(U1 + (size_t)min(max(tr, s0), s1 - 1) * 1024 + c);
    const uint4 cv = *(const uint4*)(U1 + (size_t)t * 1024 + c);
    const float ma = (ta < s1) ? 1.f : 0.f;
    const float mr = (tr >= s0 && i > 0) ? -1.f : 0.f;
    POOL_ACC(va, ma);
    POOL_ACC(vr, mr);
    const int lo = max(t - hw, s0), hi = min(t + w - hw, s1);
    const float rc = 1.f / (float)(hi - lo);
    uint4 o;
    o.x = pack2(sm[0] * rc - bflo(cv.x), sm[1] * rc - bfhi(cv.x));
    o.y = pack2(sm[2] * rc - bflo(cv.y), sm[3] * rc - bfhi(cv.y));
    o.z = pack2(sm[4] * rc - bflo(cv.z), sm[5] * rc - bfhi(cv.z));
    o.w = pack2(sm[6] * rc - bflo(cv.w), sm[7] * rc - bfhi(cv.w));
    *(uint4*)(Dd + (size_t)t * 1024 + c) = o;
  }
}

#define XB_TMO      128
#define XB_XCNT(j)  (256  + 64 * (j))
#define XB_XSUB(j)  (1280 + 64 * (j))
#define XB_XGEN(j)  (2304 + 64 * (j))
#define XB_TOP      3328
#define XB_TOPGEN   3392
#define XCD_BAR_WORDS 3456
#define XB_SPIN_CAP (1u << 22)
#define LAS __attribute__((address_space(3)))
DI unsigned xb_ld(unsigned* p)              { return __hip_atomic_load(p, __ATOMIC_RELAXED, __HIP_MEMORY_SCOPE_AGENT); }
DI unsigned xb_add(unsigned* p, unsigned v) { return __hip_atomic_fetch_add(p, v, __ATOMIC_RELAXED, __HIP_MEMORY_SCOPE_AGENT); }
DI unsigned xb_xcc_id() { return (unsigned)__builtin_amdgcn_s_getreg((3 << 11) | 20) & 0xFu; }
#define XB_SPIN(cond, bar) do { unsigned _sp = 0; while (cond) { __builtin_amdgcn_s_sleep(1); \
    if ((++_sp & 255u) == 0u) { if (xb_ld(&(bar)[XB_TMO])) break; if (_sp > XB_SPIN_CAP) { atomicAdd(&(bar)[XB_TMO], 1u); break; } } } } while (0)
struct XcdBarrier { unsigned* bar; unsigned x; volatile LAS unsigned* st; };
DI XcdBarrier xcd_barrier_post(unsigned* bar, volatile LAS unsigned* st) {
  XcdBarrier b; b.bar = bar; b.x = xb_xcc_id(); b.st = st;
  if (threadIdx.x == 0) (void)xb_add(&bar[XB_XCNT(b.x)], 1u);
  return b;
}
DI void xcd_barrier_complete(unsigned* bar, unsigned x, unsigned& nloc, unsigned& nx) {
  const unsigned G = gridDim.x * gridDim.y * gridDim.z;
  unsigned sum, cnt, mine, sp = 0u;
  for (;;) {
    sum = 0u; cnt = 0u; mine = 0u;
#pragma unroll
    for (unsigned j = 0; j < 16; ++j) { const unsigned c = xb_ld(&bar[XB_XCNT(j)]); sum += c; cnt += (c > 0u) ? 1u : 0u; mine = (j == x) ? c : mine; }
    if (sum == G) break;
    __builtin_amdgcn_s_sleep(1);
    if ((++sp & 255u) == 0u) { if (xb_ld(&bar[XB_TMO])) break; if (sp > XB_SPIN_CAP) { atomicAdd(&bar[XB_TMO], 1u); break; } }
  }
  nloc = mine > 0u ? mine : 1u; nx = cnt > 0u ? cnt : 1u;
}
DI void xcd_barrier(const XcdBarrier& b) {
  asm volatile("s_waitcnt vmcnt(0)" ::: "memory");
  __syncthreads();
  if (threadIdx.x == 0) {
    unsigned* bar = b.bar;
    __builtin_amdgcn_s_waitcnt(0);
    unsigned nloc = b.st[0], nx = b.st[1];
    if (nloc == 0u) { xcd_barrier_complete(bar, b.x, nloc, nx); b.st[0] = nloc; b.st[1] = nx; }
    const unsigned old = xb_add(&bar[XB_XSUB(b.x)], 1u);
    const unsigned gen = old / nloc;
    if (old + 1u == (gen + 1u) * nloc) {
      __builtin_amdgcn_fence(__ATOMIC_RELEASE, "agent");
      asm volatile("s_waitcnt vmcnt(0)" ::: "memory");
      const unsigned og = xb_add(&bar[XB_TOP], 1u);
      const unsigned tg = og / nx;
      if (og + 1u == (tg + 1u) * nx) xb_add(&bar[XB_TOPGEN], 1u);
      else XB_SPIN(xb_ld(&bar[XB_TOPGEN]) == tg, bar);
      __builtin_amdgcn_fence(__ATOMIC_ACQUIRE, "agent");
      xb_add(&bar[XB_XGEN(b.x)], 1u);
      asm volatile("s_waitcnt vmcnt(0)" ::: "memory");
    } else {
      XB_SPIN(xb_ld(&bar[XB_XGEN(b.x)]) == gen, bar);
      __builtin_amdgcn_fence(__ATOMIC_ACQUIRE, "agent");
      asm volatile("s_waitcnt vmcnt(0)" ::: "memory");
    }
  }
  __syncthreads();
}

constexpr int N_PHASES = 10;
#define PHASE_G(k, n, call) \
  if (p.ph_lo <= (k) && (k) < p.ph_hi) { \
    for (int it = blockIdx.x; it < (n); it += gridDim.x) { __syncthreads(); call; } \
  }
#define PHASE_H(k, n, call) \
  if (p.ph_lo <= (k) && (k) < p.ph_hi) { \
    for (int it = 2 * blockIdx.x + half; it < (n); it += 2 * gridDim.x) { __syncthreads(); call; } \
  }
#define SEAM(k) \
  if (p.ph_lo <= (k) && (k) + 1 < p.ph_hi) { if (p.ph_hi > 1000) grid.sync(); xcd_barrier(xb); }

__global__ void __launch_bounds__(512, 2) mega(P p) {
  __shared__ __attribute__((aligned(16))) char smem[SMEM_BYTES + 16];
  cg::grid_group grid = cg::this_grid();
  volatile LAS unsigned* xst = (volatile LAS unsigned*)(smem + SMEM_BYTES);
  if (threadIdx.x == 0) { xst[0] = 0u; xst[1] = 0u; }
  __syncthreads();
  XcdBarrier xb = xcd_barrier_post((unsigned*)(p.ws + WS_BAR), xst);
  const int half = threadIdx.x >> 8;
  char* hsm = smem + half * HALF_SMEM;
  PHASE_H(0, P0_ITEMS, p0_item(p, it, hsm))
  SEAM(0)
  PHASE_H(1, 256, p0_item(p, it, hsm, 1))
  PHASE_H(1, 1536, modnorm_item(p, it, 0))
  SEAM(1)
  PHASE_G(2, 14 * 128, gemm_item<1>(p, it, smem))
  SEAM(2)
  if (!(p.flags & 1)) { PHASE_H(3, P3_NA + P3_CTX, attn_item(p, it, hsm)) }
  if (!(p.flags & 2)) { PHASE_H(3, P3_CONV, conv_item(p, it, hsm)) }
  SEAM(3)
  PHASE_G(4, 4 * 192, gemm_item<2>(p, it, smem))
  if (p.ph_lo <= 4 && 6 < p.ph_hi) { if (p.ph_hi > 1000) grid.sync(); xcd_barrier(xb); }
  PHASE_G(6, 8 * 96, gemm_item<3>(p, it, smem))
  if (p.ph_lo <= 6 && 8 < p.ph_hi) { if (p.ph_hi > 1000) grid.sync(); xcd_barrier(xb); }
  PHASE_G(8, 4 * 192, gemm_item<4>(p, it, smem))
  SEAM(8)
  PHASE_G(9, 4 * 192, gemm_item<5>(p, it, smem))
}

extern "C" void kernel_launch(void* const* d_in, const int* in_sizes, int n_in, void* d_out, int out_size, void* d_ws, size_t ws_size, hipStream_t stream) {
  static int grid_blocks = 0;
  if (!grid_blocks) {
    int dev = 0, cus = 0, per_cu = 0;
    hipGetDevice(&dev);
    hipDeviceGetAttribute(&cus, hipDeviceAttributeMultiprocessorCount, dev);
    hipOccupancyMaxActiveBlocksPerMultiprocessor(&per_cu, mega, 512, 0);
    per_cu = 1;
    grid_blocks = cus * per_cu;
    if (ws_size < WS_END) fprintf(stderr, "kernel_launch: workspace too small: %zu < %zu\n", ws_size, (size_t)WS_END);
  }
  P p{};
  const float** f = (const float**)&p;
  for (int i = 0; i < 25; ++i) f[i] = (const float*)d_in[i];
  p.out = (float*)d_out;
  p.ws = (char*)d_ws;
#if MK_MULTI
  for (int ph = 0; ph < N_PHASES; ++ph) {
    p.ph_lo = ph; p.ph_hi = ph + 1;
#ifdef PROBE_PH
    if (ph == PROBE_PH) { p.flags = PROBE_FLAGS; for (int rr = 0; rr < PROBE_N; ++rr) hipLaunchKernelGGL(mega, dim3(grid_blocks), dim3(512), 0, stream, p); p.flags = 0; }
#endif
    hipLaunchKernelGGL(mega, dim3(grid_blocks), dim3(512), 0, stream, p);
  }
#else
  p.ph_lo = 0; p.ph_hi = N_PHASES;
  hipMemsetAsync((char*)d_ws + WS_BAR, 0, XCD_BAR_WORDS * 4, stream);
  void* args[] = {&p};
  hipError_t e = hipLaunchCooperativeKernel((void*)mega, dim3(grid_blocks), dim3(512), args, 0, stream);
  if (e != hipSuccess) fprintf(stderr, "cooperative launch failed: %s (grid %d)\n", hipGetErrorString(e), grid_blocks);
#endif
}
```

```cpp
#include <hip/hip_runtime.h>
#include <hip/hip_cooperative_groups.h>
#include <cstdio>
namespace cg = cooperative_groups;

#ifndef GD
#define GD 3
#endif
#ifndef MK_MULTI
#define MK_MULTI 0
#endif

typedef unsigned short u16;
using bf16x8 = __attribute__((ext_vector_type(8))) short;
using f32x16 = __attribute__((ext_vector_type(16))) float;
#define DI __device__ __forceinline__
#define MFMA(a, b, c) __builtin_amdgcn_mfma_f32_32x32x16_bf16((a), (b), (c), 0, 0, 0)

constexpr int TP = 8192;
constexpr int TT = 24576;
constexpr float EPS = 1e-6f;

constexpr size_t WS_MOD   = 0;
constexpr size_t WS_WIN0  = 131072;
constexpr size_t WS_WOUT0 = WS_WIN0 + (size_t)3584 * 1024 * 2;
constexpr size_t WS_WIN1  = WS_WOUT0 + (size_t)1024 * 1024 * 2;
constexpr size_t WS_WPOOL = WS_WIN1 + (size_t)2048 * 1024 * 2;
constexpr size_t WS_WOUT1 = WS_WPOOL + (size_t)4 * 256 * 256 * 2;
constexpr size_t WS_KC    = WS_WOUT1 + (size_t)1024 * 1024 * 2;
constexpr size_t WS_VTC   = WS_KC + (size_t)4 * 8 * 512 * 64 * 2;
constexpr size_t WS_R0    = WS_VTC + (size_t)4 * 8 * 512 * 64 * 2;
constexpr size_t RSZ      = (size_t)TT * 1024 * 2;
constexpr size_t WS_R1    = WS_R0 + RSZ;
constexpr size_t WS_R2    = WS_R1 + RSZ;
constexpr size_t WS_R3    = WS_R2 + RSZ;
constexpr size_t WS_BAR   = WS_R3 + RSZ;
constexpr size_t WS_UP    = WS_BAR + 16384;
constexpr size_t WS_SS    = WS_UP + (size_t)(24576 + 36 * 32) * 1024;
constexpr size_t WS_SW    = WS_SS + (size_t)TT * 4;
constexpr size_t WS_END   = WS_SW + 5 * 2048 * 4;
constexpr size_t HALF_R   = RSZ / 2;

struct P {
  const float *x_prompt, *x_sample, *cache_k, *cache_v, *c, *c_ctx;
  const float *norm_g0, *w_ada0, *b_ada0, *w_in0, *conv_w, *conv_b, *ln_g, *ln_b, *q_norm, *k_norm, *rpb, *w_out0;
  const float *norm_g1, *w_ada1, *b_ada1, *w_in1, *pool_w, *pool_scale, *w_out1;
  float* out;
  char* ws;
  int ph_lo, ph_hi, flags, pad;
};

typedef __bf16 hbf16x2 __attribute__((ext_vector_type(2)));
typedef float hf32x2 __attribute__((ext_vector_type(2)));
DI unsigned pack2(float a, float b) { hf32x2 v = {a, b}; hbf16x2 r = __builtin_convertvector(v, hbf16x2); return __builtin_bit_cast(unsigned, r); }
DI u16 f2bf(float x) { return (u16)(pack2(x, 0.f) & 0xffffu); }
DI float bf2f(u16 v) { return __uint_as_float(((unsigned)v) << 16); }
DI void swap32v(f32x16& x, f32x16& y) {
#pragma unroll
  for (int i = 0; i < 16; ++i) {
    auto r = __builtin_amdgcn_permlane32_swap(__float_as_uint(x[i]), __float_as_uint(y[i]), false, false);
    x[i] = __uint_as_float(r[0]); y[i] = __uint_as_float(r[1]);
  }
}
DI void swap32(float& x, float& y) {
  auto r = __builtin_amdgcn_permlane32_swap(__float_as_uint(x), __float_as_uint(y), false, false);
  x = __uint_as_float(r[0]); y = __uint_as_float(r[1]);
}
DI float bflo(unsigned v) { return __uint_as_float(v << 16); }
DI float bfhi(unsigned v) { return __uint_as_float(v & 0xffff0000u); }
DI float silu_f(float x) { return x * __builtin_amdgcn_rcpf(1.f + __builtin_amdgcn_exp2f(-1.4426950408889634f * x)); }
DI float sigm_f(float x) { return __builtin_amdgcn_rcpf(1.f + __builtin_amdgcn_exp2f(-1.4426950408889634f * x)); }
DI const float* xrow(const P& p, int t) { return t < TP ? p.x_prompt + (size_t)t * 1024 : p.x_sample + (size_t)(t - TP) * 1024; }
DI int midx(int t) { return t < TP ? 0 : 1 + ((t - TP) >> 12); }
DI int prow(int t) { const int seq = t < TP ? (t >> 8) : 32 + ((t - TP) >> 12); return t + 32 * seq + 16; }

constexpr int P0_ADA = 384, P0_TR = 2240, P0_KC = 256, P0_PAD = 36, P0_SS = 6, P0_ITEMS = P0_ADA + P0_TR + P0_KC + P0_PAD + P0_SS;

DI void p0_item(const P& p, int it, char* smem, int mode = 0) {
  const int tid = (threadIdx.x & 255);
  if (mode == 1 || it < P0_ADA) {
    const int NC = mode ? 8 : 16;
    const int QN = NC >> 2, KL = 256 / QN, NIT = 1024 / KL;
    const int layer = mode ? 0 : it / 192, n0 = mode ? it * 8 : (it % 192) * 16;
    const int ldw = mode ? 2048 : 3072;
    float* sc = (float*)smem;
    float* red = (float*)(smem + 20480);
    for (int e = tid; e < 5120; e += 256) {
      const int j = e >> 10, k = e & 1023;
      if (mode) sc[e] = ((const float*)(p.ws + WS_MOD))[(5 + j) * 3072 + k];
      else { const float v = (j == 0) ? p.c_ctx[k] : p.c[(j - 1) * 1024 + k]; sc[e] = silu_f(v); }
    }
    __syncthreads();
    const float* W = mode ? p.w_in1 : (layer ? p.w_ada1 : p.w_ada0);
    const float* bias = layer ? p.b_ada1 : p.b_ada0;
    const int cq = tid % QN, kl = tid / QN;
    float acc[5][4];
#pragma unroll
    for (int j = 0; j < 5; ++j) { acc[j][0] = acc[j][1] = acc[j][2] = acc[j][3] = 0.f; }
#pragma unroll 8
    for (int i = 0; i < NIT; ++i) {
      const int k = kl + KL * i;
      const float4 w = *(const float4*)(W + (size_t)k * ldw + n0 + 4 * cq);
#pragma unroll
      for (int j = 0; j < 5; ++j) {
        const float s = sc[j * 1024 + k];
        acc[j][0] += s * w.x; acc[j][1] += s * w.y; acc[j][2] += s * w.z; acc[j][3] += s * w.w;
      }
    }
#pragma unroll
    for (int j = 0; j < 5; ++j)
#pragma unroll
      for (int a = 0; a < 4; ++a) red[((kl * QN + cq) * 5 + j) * 4 + a] = acc[j][a];
    __syncthreads();
    if (tid < 5 * NC) {
      const int j = tid / NC, col = tid % NC;
      float s = mode ? 0.f : bias[n0 + col];
      for (int k2 = 0; k2 < KL; ++k2) s += red[((k2 * QN + (col >> 2)) * 5 + j) * 4 + (col & 3)];
      if (mode) ((float*)(p.ws + WS_SW))[j * 2048 + n0 + col] = s;
      else ((float*)(p.ws + WS_MOD))[(layer * 5 + j) * 3072 + n0 + col] = s;
    }
  } else if (it < P0_ADA + P0_TR) {
    int j = it - P0_ADA;
    const float* src; u16* dst; int sstride, dstride, r0, n0, dk0 = -1; bool perm = false;
    if (j < 896) { src = p.w_in0; sstride = 3584; r0 = (j / 56) * 64; n0 = (j % 56) * 64; dst = (u16*)(p.ws + WS_WIN0); dstride = 1024; perm = true; }
    else if (j < 1152) { j -= 896; src = p.w_out0; sstride = 1024; r0 = (j / 16) * 64; n0 = (j % 16) * 64; dst = (u16*)(p.ws + WS_WOUT0); dstride = 1024; }
    else if (j < 1664) { j -= 1152; src = p.w_in1; sstride = 2048; r0 = (j / 32) * 64; n0 = (j % 32) * 64; dst = (u16*)(p.ws + WS_WIN1); dstride = 1024; }
    else if (j < 1728) { j -= 1664; const int g = j >> 4; src = p.pool_w + g * 65536; sstride = 256; r0 = ((j & 15) >> 2) * 64; n0 = (j & 3) * 64; dst = (u16*)(p.ws + WS_WPOOL) + g * 65536; dstride = 256; }
    else if (j < 1984) { j -= 1728; src = p.w_out1; sstride = 1024; r0 = (j / 16) * 64; n0 = (j % 16) * 64; dst = (u16*)(p.ws + WS_WOUT1); dstride = 1024; }
    else { j -= 1984; const int bh = j >> 3, mt = j & 7; src = p.cache_v + (size_t)(bh >> 3) * 512 * 512 + (bh & 7) * 64; sstride = 512; r0 = mt * 64; n0 = 0; dst = (u16*)(p.ws + WS_VTC) + ((size_t)bh * 8 + mt) * 4096; dstride = 64; dk0 = 0; }
    float* tile = (float*)smem;
    {
      const int r = tid >> 4, c4 = (tid & 15) * 4;
      int nn = n0 + c4;
      if (perm && nn < 1024) { const int w = nn >> 6, rr = nn & 63; nn = (rr < 32) ? (32 * w + rr) : (512 + 32 * w + rr - 32); }
#pragma unroll
      for (int i = 0; i < 4; ++i) {
        const float4 v = *(const float4*)(src + (size_t)(r0 + r + 16 * i) * sstride + nn);
        *(float4*)(tile + (r + 16 * i) * 68 + c4) = v;
      }
    }
    __syncthreads();
    {
      const int n = tid >> 2, kseg = (tid & 3) * 16;
      unsigned pk[8];
#pragma unroll
      for (int j = 0; j < 8; ++j) pk[j] = pack2(tile[(kseg + 2 * j) * 68 + n], tile[(kseg + 2 * j + 1) * 68 + n]);
      u16* d = dst + (size_t)(n0 + n) * dstride + (dk0 < 0 ? r0 : dk0) + kseg;
      *(uint4*)d = make_uint4(pk[0], pk[1], pk[2], pk[3]);
      *(uint4*)(d + 8) = make_uint4(pk[4], pk[5], pk[6], pk[7]);
    }
  } else if (it >= P0_ADA + P0_TR + P0_KC + P0_PAD) {
    float* ss = (float*)(p.ws + WS_SS) + (it - P0_ADA - P0_TR - P0_KC - P0_PAD) * 4096;
#pragma unroll
    for (int i = 0; i < 4; ++i) *(float4*)(ss + (i * 256 + tid) * 4) = make_float4(0.f, 0.f, 0.f, 0.f);
  } else if (it >= P0_ADA + P0_TR + P0_KC) {
    const int sq = it - P0_ADA - P0_TR - P0_KC;
    const int st = sq < 32 ? sq * 256 : TP + (sq - 32) * 4096, en = st + (sq < 32 ? 256 : 4096);
    char* up = p.ws + WS_UP;
    const uint4 z = make_uint4(0u, 0u, 0u, 0u);
#pragma unroll
    for (int i = 0; i < 4; ++i) {
      *(uint4*)(up + (size_t)(st + 32 * sq) * 1024 + (i * 256 + tid) * 16) = z;
      *(uint4*)(up + (size_t)(en + 32 * sq + 16) * 1024 + (i * 256 + tid) * 16) = z;
    }
  } else {
    const int it2 = it - P0_ADA - P0_TR;
    u16* kc = (u16*)(p.ws + WS_KC);
#pragma unroll
    for (int e = 0; e < 16; ++e) {
      const int o = it2 * 4096 + e * 256 + tid;
      const int d = o & 63, m = (o >> 6) & 511, bh = o >> 15;
      kc[o] = f2bf(p.cache_k[(((size_t)(bh >> 3) * 512 + m) * 8 + (bh & 7)) * 64 + d]);
    }
  }
}

DI void modnorm_item(const P& p, int it, int layer) {
  const int tid = (threadIdx.x & 255), lane = tid & 63, wave = tid >> 6;
  const int row0 = it * 16 + wave * 4;
  const float* g = layer ? p.norm_g1 : p.norm_g0;
  const float* mod = (const float*)(p.ws + WS_MOD) + (size_t)(layer * 5 + midx(row0)) * 3072;
  u16* H = (u16*)(p.ws + WS_R0);
  float4 a[4], b[4];
#pragma unroll
  for (int j = 0; j < 4; ++j) {
    const int col = j * 256 + lane * 4;
    const float4 gv = *(const float4*)(g + col);
    const float4 sh = *(const float4*)(mod + col);
    const float4 sv = *(const float4*)(mod + 1024 + col);
    a[j] = make_float4(gv.x * (1.f + sv.x), gv.y * (1.f + sv.y), gv.z * (1.f + sv.z), gv.w * (1.f + sv.w));
    b[j] = sh;
  }
#pragma unroll
  for (int r = 0; r < 4; ++r) {
    const int row = row0 + r;
    const float* xr = layer ? (p.out + (size_t)row * 1024) : xrow(p, row);
    float4 v[4];
    float ss = 0.f;
#pragma unroll
    for (int j = 0; j < 4; ++j) {
      v[j] = *(const float4*)(xr + j * 256 + lane * 4);
      ss += v[j].x * v[j].x + v[j].y * v[j].y + v[j].z * v[j].z + v[j].w * v[j].w;
    }
#pragma unroll
    for (int o = 32; o >= 1; o >>= 1) ss += __shfl_xor(ss, o);
    const float rinv = rsqrtf(ss * (1.f / 1024.f) + EPS);
#pragma unroll
    for (int j = 0; j < 4; ++j) {
      uint2 o2;
      o2.x = pack2(v[j].x * rinv * a[j].x + b[j].x, v[j].y * rinv * a[j].y + b[j].y);
      o2.y = pack2(v[j].z * rinv * a[j].z + b[j].z, v[j].w * rinv * a[j].w + b[j].w);
      *(uint2*)(H + (size_t)row * 1024 + j * 256 + lane * 4) = o2;
    }
  }
}

DI int crow(int i, int hh) { return (i & 3) + 8 * (i >> 2) + 4 * hh; }

constexpr int LROW = 144;
constexpr int GSTAGE = 512 * LROW;
constexpr int SMEM_BYTES = 2 * GSTAGE;
constexpr int HALF_SMEM = GSTAGE;

template <int NK, int CFG>
DI void gemm_mainloop(const u16* Ag, int lda, const u16* Bg, int ldb, char* smem, f32x16 (&acc)[CFG == 0 ? 4 : 2][CFG == 2 ? 3 : 2]) {
  constexpr int MI = CFG == 0 ? 4 : 2;
  constexpr int NJ = CFG == 2 ? 3 : 2;
  int tid = threadIdx.x;
  asm volatile("" : "+v"(tid));
  const int lane = tid & 63, wave = tid >> 6;
  const int wm = CFG == 0 ? (wave >> 2) : (wave >> 1);
  const int wn = CFG == 0 ? (wave & 3) : (wave & 1);
  const int srow = tid >> 3, scol = tid & 7;
  const u16* ag = Ag + (size_t)srow * lda + scol * 8;
  const u16* bg = Bg + (size_t)srow * ldb + scol * 8;
  uint4 r0a0, r0a1, r0a2, r0a3, r0b0, r0b1, r0b2, r0b3, r1a0, r1a1, r1a2, r1a3, r1b0, r1b1, r1b2, r1b3;
#define G_LOAD(R, ko_) do { \
    R##a0 = *(const uint4*)(ag + (ko_)); R##a1 = *(const uint4*)(ag + (size_t)64 * lda + (ko_)); \
    R##a2 = *(const uint4*)(ag + (size_t)128 * lda + (ko_)); R##a3 = *(const uint4*)(ag + (size_t)192 * lda + (ko_)); \
    R##b0 = *(const uint4*)(bg + (ko_)); R##b1 = *(const uint4*)(bg + (size_t)64 * ldb + (ko_)); \
    if (CFG != 1) R##b2 = *(const uint4*)(bg + (size_t)128 * ldb + (ko_)); \
    if (CFG == 0) R##b3 = *(const uint4*)(bg + (size_t)192 * ldb + (ko_)); } while (0)
#define G_STORE(R, base_) do { char* b_ = (base_) + wofs; \
    *(uint4*)(b_) = R##a0; *(uint4*)(b_ + 64 * LROW) = R##a1; *(uint4*)(b_ + 128 * LROW) = R##a2; *(uint4*)(b_ + 192 * LROW) = R##a3; \
    *(uint4*)(b_ + 256 * LROW) = R##b0; *(uint4*)(b_ + 320 * LROW) = R##b1; \
    if (CFG != 1) *(uint4*)(b_ + 384 * LROW) = R##b2; \
    if (CFG == 0) *(uint4*)(b_ + 448 * LROW) = R##b3; } while (0)
  const int wofs = srow * LROW + scol * 16;
  const int aofs = (wm * (MI * 32) + (lane & 31)) * LROW + (lane >> 5) * 16;
  const int bofs = 256 * LROW + (wn * (NJ * 32) + (lane & 31)) * LROW + (lane >> 5) * 16;
  bf16x8 fa[2][MI], fb[2][NJ];
#define LOADF(buf_, ks_) do { \
    _Pragma("unroll") \
    for (int nj_ = 0; nj_ < NJ; ++nj_) fb[buf_][nj_] = *(const bf16x8*)(cur + bofs + nj_ * 32 * LROW + (ks_) * 32); \
    _Pragma("unroll") \
    for (int mi_ = 0; mi_ < MI; ++mi_) fa[buf_][mi_] = *(const bf16x8*)(cur + aofs + mi_ * 32 * LROW + (ks_) * 32); } while (0)
#define G_STEP(R, kt_, AH_) do { \
    constexpr int kt__ = (kt_); \
    if (kt__ < NK) { \
      const char* cur = smem + (kt__ & 1) * GSTAGE; \
      __syncthreads(); \
      if (kt__ + 1 < NK) G_STORE(R, smem + ((kt__ + 1) & 1) * GSTAGE); \
      if (kt__ + (AH_) < NK) G_LOAD(R, (kt__ + (AH_)) * 64); \
      __builtin_amdgcn_sched_barrier(0); \
      LOADF(0, 0); \
      _Pragma("unroll") \
      for (int ks = 0; ks < 4; ++ks) { \
        if (ks < 3) LOADF((ks + 1) & 1, ks + 1); \
        __builtin_amdgcn_s_setprio(1); \
        _Pragma("unroll") \
        for (int mi = 0; mi < MI; ++mi) { \
          _Pragma("unroll") \
          for (int nj = 0; nj < NJ; ++nj) acc[mi][nj] = MFMA(fa[ks & 1][mi], fb[ks & 1][nj], acc[mi][nj]); \
        } \
        __builtin_amdgcn_s_setprio(0); \
      } \
      __builtin_amdgcn_sched_barrier(0); \
    } \
  } while (0)
  static_assert(NK >= 4 && NK <= 16, "K tiles");
  G_LOAD(r0, 0);
  G_STORE(r0, smem);
  G_LOAD(r0, 64);
  if (CFG != 1) {
    G_STEP(r0, 0, 2);  G_STEP(r0, 1, 2);  G_STEP(r0, 2, 2);  G_STEP(r0, 3, 2);
    G_STEP(r0, 4, 2);  G_STEP(r0, 5, 2);  G_STEP(r0, 6, 2);  G_STEP(r0, 7, 2);
    G_STEP(r0, 8, 2);  G_STEP(r0, 9, 2);  G_STEP(r0, 10, 2); G_STEP(r0, 11, 2);
    G_STEP(r0, 12, 2); G_STEP(r0, 13, 2); G_STEP(r0, 14, 2); G_STEP(r0, 15, 2);
  } else {
    G_LOAD(r1, 128);
    G_STEP(r0, 0, 3);  G_STEP(r1, 1, 3);  G_STEP(r0, 2, 3);  G_STEP(r1, 3, 3);
    G_STEP(r0, 4, 3);  G_STEP(r1, 5, 3);  G_STEP(r0, 6, 3);  G_STEP(r1, 7, 3);
    G_STEP(r0, 8, 3);  G_STEP(r1, 9, 3);  G_STEP(r0, 10, 3); G_STEP(r1, 11, 3);
    G_STEP(r0, 12, 3); G_STEP(r1, 13, 3); G_STEP(r0, 14, 3); G_STEP(r1, 15, 3);
  }
}

DI void tile_remap(int item, int FG, int NFG, int& ft, int& tt) {
  const int G = gridDim.x;
  if (G & 7) { const int NF = FG * NFG; ft = item % NF; tt = item / NF; return; }
  const int b = item % G, k = item / G;
  const int xcd = b & 7, q = (b >> 3) + k * (G >> 3);
  const int S = FG * 8;
  const int sq = q / S, r = q - sq * S;
  const int sidx = sq * 8 + xcd;
  const int ftg = sidx % NFG, ttg = sidx / NFG;
  ft = ftg * FG + r % FG;
  tt = ttg * 8 + r / FG;
}

DI void kv_rows_out(float* wbuf, int lane, float* gbase  , int tok0) {
#pragma unroll
  for (int i = 0; i < 8; ++i) {
    const int row = 4 * i + (lane >> 4), col = (lane & 15) * 4;
    const float4 v = *(const float4*)(wbuf + row * 68 + col);
    if (tok0 + row < TP) *(float4*)(gbase + (size_t)row * 512 + col) = v;
  }
}

template <int EPI>
DI void gemm_item(const P& p, int item, char* smem) {
  constexpr int CFG = (EPI == 1) ? 2 : (EPI == 3) ? 0 : 1;
  constexpr int MI = CFG == 0 ? 4 : 2;
  constexpr int NJ = CFG == 2 ? 3 : 2;
  constexpr int TNT = CFG == 0 ? 256 : (CFG == 2 ? 192 : 128);
  int tid = threadIdx.x;
  asm volatile("" : "+v"(tid));
  const int lane = tid & 63, wave = tid >> 6, l31 = lane & 31, hh = lane >> 5;
  const int wm = CFG == 0 ? (wave >> 2) : (wave >> 1);
  const int wn = CFG == 0 ? (wave & 3) : (wave & 1);
  const u16 *A, *B; int lda, ldb, f0, t0, grp = 0;
  if (EPI == 1) { int ft, tt; tile_remap(item, 7, 2, ft, tt); f0 = ft * 256; t0 = tt * TNT; A = (const u16*)(p.ws + WS_WIN0) + (size_t)f0 * 1024; lda = 1024; B = (const u16*)(p.ws + WS_R0) + (size_t)t0 * 1024; ldb = 1024; }
  else if (EPI == 2) { int ft, tt; tile_remap(item, 4, 1, ft, tt); f0 = ft * 256; t0 = tt * TNT; A = (const u16*)(p.ws + WS_WOUT0) + (size_t)f0 * 1024; lda = 1024; B = (const u16*)(p.ws + WS_R0) + (size_t)t0 * 1024; ldb = 1024; }
  else if (EPI == 3) { int ft, tt; tile_remap(item, 4, 2, ft, tt); f0 = ft * 256; t0 = tt * TNT; A = (const u16*)(p.ws + WS_WIN1) + (size_t)f0 * 1024; lda = 1024; B = (const u16*)(p.ws + WS_R1) + (size_t)t0 * 1024; ldb = 1024; }
  else if (EPI == 4) { grp = item & 3; const int tt = item >> 2; f0 = 0; t0 = tt * TNT; A = (const u16*)(p.ws + WS_WPOOL) + grp * 65536; lda = 256; B = (const u16*)(p.ws + WS_R3) + (size_t)t0 * 1024 + grp * 256; ldb = 1024; }
  else { int ft, tt; tile_remap(item, 4, 1, ft, tt); f0 = ft * 256; t0 = tt * TNT; A = (const u16*)(p.ws + WS_WOUT1) + (size_t)f0 * 1024; lda = 1024; B = (const u16*)(p.ws + WS_R0) + (size_t)t0 * 1024; ldb = 1024; }

  f32x16 acc[MI][NJ];
#pragma unroll
  for (int a = 0; a < MI; ++a)
#pragma unroll
    for (int b = 0; b < NJ; ++b)
#pragma unroll
      for (int i = 0; i < 16; ++i) acc[a][b][i] = 0.f;
  if (EPI == 4 && t0 >= TP) {
    const int w = 2 << grp, hw = w >> 1;
    const int s0 = TP + ((t0 - TP) & ~4095), s1 = s0 + 4096;
    int rfix0, nfix;
    if ((t0 & 255) == 0) { rfix0 = t0; nfix = (t0 != s0) ? hw : 0; }
    else { nfix = (t0 + 128 != s1) ? (w - hw - 1) : 0; rfix0 = t0 + 128 - nfix; }
    const int rr = tid >> 6, cc = grp * 256 + (tid & 63) * 4;
    if (rr < nfix) {
      const u16* U1 = (const u16*)(p.ws + WS_R0);
      const int t = rfix0 + rr;
      const int lo = max(t - hw, s0), hi = min(t + w - hw, s1);
      float a0 = 0.f, a1 = 0.f, a2 = 0.f, a3 = 0.f;
      for (int tt = lo; tt < hi; ++tt) {
        const uint2 v = *(const uint2*)(U1 + (size_t)tt * 1024 + cc);
        a0 += bflo(v.x); a1 += bfhi(v.x); a2 += bflo(v.y); a3 += bfhi(v.y);
      }
      const uint2 cv = *(const uint2*)(U1 + (size_t)t * 1024 + cc);
      const float rc = 1.f / (float)(hi - lo);
      uint2 o; o.x = pack2(a0 * rc - bflo(cv.x), a1 * rc - bfhi(cv.x)); o.y = pack2(a2 * rc - bflo(cv.y), a3 * rc - bfhi(cv.y));
      *(uint2*)((u16*)(p.ws + WS_R3) + (size_t)t * 1024 + cc) = o;
    }
    asm volatile("s_waitcnt vmcnt(0)" ::: "memory");
    __syncthreads();
  }
  if (EPI == 4) gemm_mainloop<4, CFG>(A, lda, B, ldb, smem, acc); else gemm_mainloop<16, CFG>(A, lda, B, ldb, smem, acc);

  if (EPI == 2 || EPI == 4 || EPI == 5) {
    constexpr int SP = 260;
    float* st = (float*)smem;
    __syncthreads();
#pragma unroll
    for (int nj = 0; nj < 2; ++nj) {
      const int tokl = wn * 64 + nj * 32 + l31;
#pragma unroll
      for (int mi = 0; mi < 2; ++mi)
#pragma unroll
        for (int g = 0; g < 4; ++g)
          *(float4*)(st + tokl * SP + wm * 64 + mi * 32 + 8 * g + 4 * hh) = make_float4(acc[mi][nj][4 * g], acc[mi][nj][4 * g + 1], acc[mi][nj][4 * g + 2], acc[mi][nj][4 * g + 3]);
    }
    __syncthreads();
    const int col = lane * 4;
    if (EPI == 4) {
      const u16* SG1 = (const u16*)(p.ws + WS_R2);
      u16* Z1 = (u16*)(p.ws + WS_R0);
      const float4 sc = *(const float4*)(p.pool_scale + grp * 256 + col);
#pragma unroll 4
      for (int r = 0; r < 16; ++r) {
        const int tokl = wave * 16 + r, tok = t0 + tokl;
        const float4 a = *(const float4*)(st + tokl * SP + col);
        const uint2 sg = *(const uint2*)(SG1 + (size_t)tok * 1024 + grp * 256 + col);
        uint2 o;
        o.x = pack2(a.x * sc.x * bflo(sg.x), a.y * sc.y * bfhi(sg.x));
        o.y = pack2(a.z * sc.z * bflo(sg.y), a.w * sc.w * bfhi(sg.y));
        *(uint2*)(Z1 + (size_t)tok * 1024 + grp * 256 + col) = o;
      }
    } else {
      const int layer = (EPI == 2) ? 0 : 1;
      const float4 gv = *(const float4*)((const float*)(p.ws + WS_MOD) + (size_t)(layer * 5 + midx(t0)) * 3072 + 2048 + f0 + col);
      float4 a1 = make_float4(0.f, 0.f, 0.f, 0.f);
      if (EPI == 2) {
        const float4 g1 = *(const float4*)(p.norm_g1 + f0 + col);
        const float4 sc1 = *(const float4*)((const float*)(p.ws + WS_MOD) + (size_t)(5 + midx(t0)) * 3072 + 1024 + f0 + col);
        a1 = make_float4(g1.x * (1.f + sc1.x), g1.y * (1.f + sc1.y), g1.z * (1.f + sc1.z), g1.w * (1.f + sc1.w));
      }
      float ssq[16];
#pragma unroll
      for (int r = 0; r < 16; ++r) {
        const int tokl = wave * 16 + r, tok = t0 + tokl;
        const float4 a = *(const float4*)(st + tokl * SP + col);
        const float* xr = ((EPI == 2) ? xrow(p, tok) : (p.out + (size_t)tok * 1024)) + f0 + col;
        const float4 xv = *(const float4*)xr;
        float4 o;
        o.x = xv.x + gv.x * a.x; o.y = xv.y + gv.y * a.y; o.z = xv.z + gv.z * a.z; o.w = xv.w + gv.w * a.w;
        *(float4*)(p.out + (size_t)tok * 1024 + f0 + col) = o;
        if (EPI == 2) {
          uint2 ya; ya.x = pack2(o.x * a1.x, o.y * a1.y); ya.y = pack2(o.z * a1.z, o.w * a1.w);
          *(uint2*)((u16*)(p.ws + WS_R1) + (size_t)tok * 1024 + f0 + col) = ya;
          ssq[r] = o.x * o.x + o.y * o.y + o.z * o.z + o.w * o.w;
        }
      }
      if (EPI == 2) {
#pragma unroll
        for (int half = 8, bit = 32; half >= 1; half >>= 1, bit >>= 1) {
          const bool up = (lane & bit) != 0;
#pragma unroll
          for (int k = 0; k < half; ++k) {
            const float keep = up ? ssq[k + half] : ssq[k];
            const float send = up ? ssq[k] : ssq[k + half];
            ssq[k] = keep + __shfl_xor(send, bit);
          }
        }
        ssq[0] += __shfl_xor(ssq[0], 2);
        ssq[0] += __shfl_xor(ssq[0], 1);
        if ((lane & 3) == 0) atomicAdd((float*)(p.ws + WS_SS) + t0 + wave * 16 + (lane >> 2), ssq[0]);
      }
    }
    return;
  }
  const int tokb = t0 + wn * (NJ * 32);
  if (EPI == 3) __syncthreads();
  if (EPI == 1 && t0 < TP && f0 >= 2048 && f0 < 3072) __syncthreads();
#pragma unroll
  for (int fblk = 0; fblk < MI / 2; ++fblk) {
  const int fb = f0 + wm * (MI * 32) + fblk * 64;
  if (EPI == 1) {
    u16* U = (u16*)(p.ws + WS_UP);
    u16* SGA = (u16*)(p.ws + WS_R1 + HALF_R);
    u16* Q = (u16*)(p.ws + WS_R2);
    u16* Kb = (u16*)(p.ws + WS_R2 + HALF_R);
    u16* VT = (u16*)(p.ws + WS_R3);
    u16* SGB = (u16*)(p.ws + WS_R3 + HALF_R);
#pragma unroll
    for (int nj = 0; nj < NJ; ++nj) {
      const int tok = tokb + nj * 32 + l31;
      const bool kvst = (tokb + nj * 32 < TP);
      float* wbuf = (float*)smem + wave * (32 * 68);
      f32x16& X = acc[2 * fblk][nj];
      f32x16& Y = acc[2 * fblk + 1][nj];
      if (fb < 1024) {
        const int cb = (fb >> 6) * 32;
        float u[16];
#pragma unroll
        for (int i = 0; i < 16; ++i) u[i] = X[i] * sigm_f(Y[i]);
#pragma unroll
        for (int i = 0; i < 8; ++i) swap32(u[i], u[i + 8]);
#pragma unroll
        for (int gg = 0; gg < 2; ++gg) {
          uint4 o;
          o.x = pack2(u[4 * gg], u[4 * gg + 1]); o.y = pack2(u[4 * gg + 2], u[4 * gg + 3]);
          o.z = pack2(u[8 + 4 * gg], u[8 + 4 * gg + 1]); o.w = pack2(u[8 + 4 * gg + 2], u[8 + 4 * gg + 3]);
          *(uint4*)(U + (size_t)prow(tok) * 512 + cb + 16 * hh + 8 * gg) = o;
        }
      } else if (fb < 1536 || fb >= 3072) {
        u16* dst = (fb < 1536) ? (SGA + (size_t)tok * 512 + (fb - 1024)) : (SGB + (size_t)tok * 512 + (fb - 3072));
#pragma unroll
        for (int i = 0; i < 16; ++i) { X[i] = silu_f(X[i]); Y[i] = silu_f(Y[i]); }
        swap32v(X, Y);
#pragma unroll
        for (int g = 0; g < 4; ++g) {
          uint4 o;
          o.x = pack2(X[4 * g], X[4 * g + 1]); o.y = pack2(X[4 * g + 2], X[4 * g + 3]);
          o.z = pack2(Y[4 * g], Y[4 * g + 1]); o.w = pack2(Y[4 * g + 2], Y[4 * g + 3]);
          *(uint4*)(dst + 32 * hh + 8 * g) = o;
        }
      } else if (fb < 2560) {
        const bool isq = fb < 2048;
        const int hc = isq ? (fb - 1536) : (fb - 2048);
        float ss = 0.f;
#pragma unroll
        for (int i = 0; i < 16; ++i) ss += X[i] * X[i] + Y[i] * Y[i];
        ss += __shfl_xor(ss, 32);
        const float rinv = rsqrtf(ss * (1.f / 64.f) + EPS);
        swap32v(X, Y);
        const float* nw = (isq ? p.q_norm : p.k_norm) + 32 * hh;
        const float qs = isq ? (0.125f * 1.4426950408889634f) : 1.f;
        u16* dst = isq ? (Q + (size_t)tok * 512 + hc + 32 * hh) : (Kb + ((size_t)(hc >> 6) * TT + tok) * 64 + 32 * hh);
        float* kout = p.out + (size_t)TT * 1024 + (size_t)tok * 512 + hc + 32 * hh;
#pragma unroll
        for (int g = 0; g < 4; ++g) {
          const float4 w0 = *(const float4*)(nw + 8 * g);
          const float4 w1 = *(const float4*)(nw + 8 * g + 4);
          float4 v0, v1;
          v0.x = X[4 * g] * rinv * w0.x; v0.y = X[4 * g + 1] * rinv * w0.y; v0.z = X[4 * g + 2] * rinv * w0.z; v0.w = X[4 * g + 3] * rinv * w0.w;
          v1.x = Y[4 * g] * rinv * w1.x; v1.y = Y[4 * g + 1] * rinv * w1.y; v1.z = Y[4 * g + 2] * rinv * w1.z; v1.w = Y[4 * g + 3] * rinv * w1.w;
          if (!isq && kvst) { *(float4*)(wbuf + l31 * 68 + 32 * hh + 8 * g) = v0; *(float4*)(wbuf + l31 * 68 + 32 * hh + 8 * g + 4) = v1; }
          uint4 o;
          o.x = pack2(v0.x * qs, v0.y * qs); o.y = pack2(v0.z * qs, v0.w * qs);
          o.z = pack2(v1.x * qs, v1.y * qs); o.w = pack2(v1.z * qs, v1.w * qs);
          *(uint4*)(dst + 8 * g) = o;
        }
        if (!isq && kvst) kv_rows_out(wbuf, lane, p.out + (size_t)TT * 1024 + (size_t)(tokb + nj * 32) * 512 + hc, tokb + nj * 32);
      } else {
        const int hc = fb - 2560;
#pragma unroll
        for (int mi = 0; mi < 2; ++mi)
#pragma unroll
          for (int i = 0; i < 16; ++i) VT[(((size_t)(hc >> 6) * (TT / 64) + (tok >> 6)) * 64 + mi * 32 + crow(i, hh)) * 64 + (tok & 63)] = f2bf(acc[2 * fblk + mi][nj][i]);
        if (kvst) {
          swap32v(X, Y);
#pragma unroll
          for (int g = 0; g < 4; ++g) {
            *(float4*)(wbuf + l31 * 68 + 32 * hh + 8 * g) = make_float4(X[4 * g], X[4 * g + 1], X[4 * g + 2], X[4 * g + 3]);
            *(float4*)(wbuf + l31 * 68 + 32 * hh + 8 * g + 4) = make_float4(Y[4 * g], Y[4 * g + 1], Y[4 * g + 2], Y[4 * g + 3]);
          }
          kv_rows_out(wbuf, lane, p.out + (size_t)TT * 1024 + (size_t)TP * 512 + (size_t)(tokb + nj * 32) * 512 + hc, tokb + nj * 32);
        }
      }
    }
  } else if (EPI == 2 || EPI == 5) {
    const int layer = (EPI == 2) ? 0 : 1;
#pragma unroll
    for (int nj = 0; nj < 2; ++nj) {
      const int tok = tokb + nj * 32 + l31;
      f32x16& X = acc[2 * fblk][nj];
      f32x16& Y = acc[2 * fblk + 1][nj];
      swap32v(X, Y);
      const int colb = fb + 32 * hh;
      const float* gate = (const float*)(p.ws + WS_MOD) + (size_t)(layer * 5 + midx(tok)) * 3072 + 2048 + colb;
      const float* xr = ((EPI == 2) ? xrow(p, tok) : (p.out + (size_t)tok * 1024)) + colb;
      float* yr = p.out + (size_t)tok * 1024 + colb;
#pragma unroll
      for (int g = 0; g < 4; ++g) {
        const float4 x0 = *(const float4*)(xr + 8 * g), x1 = *(const float4*)(xr + 8 * g + 4);
        const float4 g0 = *(const float4*)(gate + 8 * g), g1 = *(const float4*)(gate + 8 * g + 4);
        float4 o0, o1;
        o0.x = x0.x + g0.x * X[4 * g]; o0.y = x0.y + g0.y * X[4 * g + 1]; o0.z = x0.z + g0.z * X[4 * g + 2]; o0.w = x0.w + g0.w * X[4 * g + 3];
        o1.x = x1.x + g1.x * Y[4 * g]; o1.y = x1.y + g1.y * Y[4 * g + 1]; o1.z = x1.z + g1.z * Y[4 * g + 2]; o1.w = x1.w + g1.w * Y[4 * g + 3];
        *(float4*)(yr + 8 * g) = o0; *(float4*)(yr + 8 * g + 4) = o1;
      }
    }
  } else if (EPI == 3) {
    u16* U1 = (u16*)(p.ws + WS_R0);
    u16* SG1 = (u16*)(p.ws + WS_R2);
#pragma unroll
    for (int nj = 0; nj < 2; ++nj) {
      const int tok = tokb + nj * 32 + l31;
      f32x16& X = acc[2 * fblk][nj];
      f32x16& Y = acc[2 * fblk + 1][nj];
      swap32v(X, Y);
      {
        const float rinv = rsqrtf(((const float*)(p.ws + WS_SS))[tok] * (1.f / 1024.f) + EPS);
        const float* sw = (const float*)(p.ws + WS_SW) + midx(tok) * 2048 + fb + 32 * hh;
#pragma unroll
        for (int g = 0; g < 4; ++g) {
          const float4 s0 = *(const float4*)(sw + 8 * g), s1 = *(const float4*)(sw + 8 * g + 4);
          X[4 * g] = X[4 * g] * rinv + s0.x; X[4 * g + 1] = X[4 * g + 1] * rinv + s0.y; X[4 * g + 2] = X[4 * g + 2] * rinv + s0.z; X[4 * g + 3] = X[4 * g + 3] * rinv + s0.w;
          Y[4 * g] = Y[4 * g] * rinv + s1.x; Y[4 * g + 1] = Y[4 * g + 1] * rinv + s1.y; Y[4 * g + 2] = Y[4 * g + 2] * rinv + s1.z; Y[4 * g + 3] = Y[4 * g + 3] * rinv + s1.w;
        }
      }
      if (fb >= 1024) {
#pragma unroll
        for (int i = 0; i < 16; ++i) { X[i] = silu_f(X[i]); Y[i] = silu_f(Y[i]); }
      }
      char* dst = smem + (wn * 64 + nj * 32 + l31) * 528 + (fb - f0 + 32 * hh) * 2;
#pragma unroll
      for (int g = 0; g < 4; ++g) {
        uint4 o;
        o.x = pack2(X[4 * g], X[4 * g + 1]); o.y = pack2(X[4 * g + 2], X[4 * g + 3]);
        o.z = pack2(Y[4 * g], Y[4 * g + 1]); o.w = pack2(Y[4 * g + 2], Y[4 * g + 3]);
        *(uint4*)(dst + 16 * g) = o;
      }
    }
  } else {
    const u16* SG1 = (const u16*)(p.ws + WS_R2);
    u16* Z1 = (u16*)(p.ws + WS_R0);
#pragma unroll
    for (int nj = 0; nj < 2; ++nj) {
      const int tok = tokb + nj * 32 + l31;
      f32x16& X = acc[2 * fblk][nj];
      f32x16& Y = acc[2 * fblk + 1][nj];
      swap32v(X, Y);
      const int colb = grp * 256 + fb + 32 * hh;
#pragma unroll
      for (int g = 0; g < 4; ++g) {
        const float4 s0 = *(const float4*)(p.pool_scale + colb + 8 * g), s1 = *(const float4*)(p.pool_scale + colb + 8 * g + 4);
        const uint4 sg = *(const uint4*)(SG1 + (size_t)tok * 1024 + colb + 8 * g);
        uint4 o;
        o.x = pack2(X[4 * g] * s0.x * bflo(sg.x), X[4 * g + 1] * s0.y * bfhi(sg.x));
        o.y = pack2(X[4 * g + 2] * s0.z * bflo(sg.y), X[4 * g + 3] * s0.w * bfhi(sg.y));
        o.z = pack2(Y[4 * g] * s1.x * bflo(sg.z), Y[4 * g + 1] * s1.y * bfhi(sg.z));
        o.w = pack2(Y[4 * g + 2] * s1.z * bflo(sg.w), Y[4 * g + 3] * s1.w * bfhi(sg.w));
        *(uint4*)(Z1 + (size_t)tok * 1024 + colb + 8 * g) = o;
      }
    }
  }
  }
  if (EPI == 3) {
    __syncthreads();
    u16* dstg = (f0 < 1024) ? ((u16*)(p.ws + WS_R0) + f0) : ((u16*)(p.ws + WS_R2) + f0 - 1024);
#pragma unroll 4
    for (int i = 0; i < 16; ++i) {
      const int row = wave * 32 + 2 * i + (lane >> 5), ch = lane & 31;
      const uint4 v = *(const uint4*)(smem + row * 528 + ch * 16);
      *(uint4*)(dstg + (size_t)(t0 + row) * 1024 + ch * 8) = v;
    }
    if (f0 < 1024) {
      const int w = 2 << (f0 >> 8), hw = w >> 1;
      int seqlo = 0, seqhi = 256;
      if (t0 >= TP) { const int s0 = TP + ((t0 - TP) & ~4095); seqlo = s0 - t0; seqhi = s0 + 4096 - t0; }
      const int lo_ok = max(seqlo, 0), hi_ok = min(seqhi, 256);
      const int ch = lane & 31, rb = wave * 32 + (lane >> 5) * 16;
      u16* Dd = (u16*)(p.ws + WS_R3);
      float sm[8];
#pragma unroll
      for (int k = 0; k < 8; ++k) sm[k] = 0.f;
#define EP_ACC(v_, m_) do { \
      sm[0] += (m_) * bflo((v_).x); sm[1] += (m_) * bfhi((v_).x); sm[2] += (m_) * bflo((v_).y); sm[3] += (m_) * bfhi((v_).y); \
      sm[4] += (m_) * bflo((v_).z); sm[5] += (m_) * bfhi((v_).z); sm[6] += (m_) * bflo((v_).w); sm[7] += (m_) * bfhi((v_).w); } while (0)
#pragma unroll
      for (int j = 0; j < 15; ++j) {
        const int t = rb - hw + j;
        const uint4 v = *(const uint4*)(smem + min(max(t, 0), 255) * 528 + ch * 16);
        const float mk = (j < w - 1 && t >= lo_ok && t < hi_ok) ? 1.f : 0.f;
        EP_ACC(v, mk);
      }
#pragma unroll 4
      for (int i = 0; i < 16; ++i) {
        const int r = rb + i;
        const int ta = r + w - hw - 1, tr = r - hw - 1;
        const uint4 va = *(const uint4*)(smem + min(ta, 255) * 528 + ch * 16);
        const uint4 vr = *(const uint4*)(smem + max(tr, 0) * 528 + ch * 16);
        const uint4 cv = *(const uint4*)(smem + r * 528 + ch * 16);
        const float ma = (ta < hi_ok) ? 1.f : 0.f;
        const float mr = (tr >= lo_ok && i > 0) ? -1.f : 0.f;
        EP_ACC(va, ma);
        EP_ACC(vr, mr);
        const int lo = max(r - hw, seqlo), hi = min(r + w - hw, seqhi);
        if (lo >= 0 && hi <= 256) {
          const float rc = 1.f / (float)(hi - lo);
          uint4 o;
          o.x = pack2(sm[0] * rc - bflo(cv.x), sm[1] * rc - bfhi(cv.x));
          o.y = pack2(sm[2] * rc - bflo(cv.y), sm[3] * rc - bfhi(cv.y));
          o.z = pack2(sm[4] * rc - bflo(cv.z), sm[5] * rc - bfhi(cv.z));
          o.w = pack2(sm[6] * rc - bflo(cv.w), sm[7] * rc - bfhi(cv.w));
          *(uint4*)(Dd + (size_t)(t0 + r) * 1024 + f0 + ch * 8) = o;
        }
      }
    }
  }
}

constexpr int P3_NA = 1024, P3_CTX = 512, P3_CONV = 1536, P3_ITEMS = P3_NA + P3_CTX + P3_CONV;

typedef float f32x2 __attribute__((ext_vector_type(2)));
DI void conv_item(const P& p, int it, char* smem) {
  const int tid = (threadIdx.x & 255), lane = tid & 63, wave = tid >> 6;
  const int t0 = it * 16;
  const int c = 2 * tid;
  const u16* UP = (const u16*)(p.ws + WS_UP) + (size_t)(prow(t0) - 15) * 512 + c;
  const u16* SGA = (const u16*)(p.ws + WS_R1 + HALF_R);
  u16* Z = (u16*)(p.ws + WS_R0);
  float* ylds = (float*)smem;
  f32x2 w[31];
#pragma unroll
  for (int j = 0; j < 31; ++j) w[j] = *(const f32x2*)(p.conv_w + j * 512 + c);
  const f32x2 cb = *(const f32x2*)(p.conv_b + c);
  unsigned uv[46];
#pragma unroll
  for (int r = 0; r < 46; ++r) uv[r] = *(const unsigned*)(UP + r * 512);
#pragma unroll
  for (int grp = 0; grp < 2; ++grp) {
    f32x2 y[8];
#pragma unroll
    for (int i = 0; i < 8; ++i) y[i] = cb;
#pragma unroll
    for (int r = 0; r < 38; ++r) {
      const unsigned v = uv[grp * 8 + r];
      f32x2 vv; vv.x = bflo(v); vv.y = bfhi(v);
#pragma unroll
      for (int i = 0; i < 8; ++i) {
        const int j = r - i;
        if (j >= 0 && j <= 30) y[i] = __builtin_elementwise_fma(vv, w[j], y[i]);
      }
    }
#pragma unroll
    for (int i = 0; i < 8; ++i) *(f32x2*)(ylds + (grp * 8 + i) * 512 + c) = y[i];
  }
  __syncthreads();
  const int c1 = lane * 4, c2 = 256 + lane * 4;
  const float4 g1 = *(const float4*)(p.ln_g + c1), g2 = *(const float4*)(p.ln_g + c2);
  const float4 b1 = *(const float4*)(p.ln_b + c1), b2 = *(const float4*)(p.ln_b + c2);
#pragma unroll
  for (int tt = 0; tt < 4; ++tt) {
    const int tl = wave * 4 + tt, tok = t0 + tl;
    const float4 a = *(const float4*)(ylds + tl * 512 + c1), b = *(const float4*)(ylds + tl * 512 + c2);
    float s1 = a.x + a.y + a.z + a.w + b.x + b.y + b.z + b.w;
    float s2 = a.x * a.x + a.y * a.y + a.z * a.z + a.w * a.w + b.x * b.x + b.y * b.y + b.z * b.z + b.w * b.w;
#pragma unroll
    for (int o = 32; o >= 1; o >>= 1) { s1 += __shfl_xor(s1, o); s2 += __shfl_xor(s2, o); }
    const float mean = s1 * (1.f / 512.f);
    const float var = fmaxf(s2 * (1.f / 512.f) - mean * mean, 0.f);
    const float rstd = rsqrtf(var + EPS);
    const uint2 ga1 = *(const uint2*)(SGA + (size_t)tok * 512 + c1), ga2 = *(const uint2*)(SGA + (size_t)tok * 512 + c2);
    uint2 o1, o2;
    o1.x = pack2(silu_f((a.x - mean) * rstd * g1.x + b1.x) * bflo(ga1.x), silu_f((a.y - mean) * rstd * g1.y + b1.y) * bfhi(ga1.x));
    o1.y = pack2(silu_f((a.z - mean) * rstd * g1.z + b1.z) * bflo(ga1.y), silu_f((a.w - mean) * rstd * g1.w + b1.w) * bfhi(ga1.y));
    o2.x = pack2(silu_f((b.x - mean) * rstd * g2.x + b2.x) * bflo(ga2.x), silu_f((b.y - mean) * rstd * g2.y + b2.y) * bfhi(ga2.x));
    o2.y = pack2(silu_f((b.z - mean) * rstd * g2.z + b2.z) * bflo(ga2.y), silu_f((b.w - mean) * rstd * g2.w + b2.w) * bfhi(ga2.y));
    *(uint2*)(Z + (size_t)tok * 1024 + c1) = o1;
    *(uint2*)(Z + (size_t)tok * 1024 + c2) = o2;
  }
}

constexpr int ACH = 64 * LROW;
constexpr int ABUF = 2 * ACH;

DI void attn_item(const P& p, int it, char* smem) {
  const int tid = (threadIdx.x & 255), lane = tid & 63, wave = tid >> 6, l31 = lane & 31, hh = lane >> 5;
  const bool is_na = it < P3_NA;
  const u16* Qb = (const u16*)(p.ws + WS_R2);
  const u16* Kb = (const u16*)(p.ws + WS_R2 + HALF_R);
  const u16* VT = (const u16*)(p.ws + WS_R3);
  const u16* SGB = (const u16*)(p.ws + WS_R3 + HALF_R);
  const u16* KC = (const u16*)(p.ws + WS_KC);
  const u16* VTC = (const u16*)(p.ws + WS_VTC);
  u16* Z = (u16*)(p.ws + WS_R0);
  int b, head, qtok, nchunks, tokbase;
  int r = 0, c = 0, qcs = 0, rsw = 0, rs_lo = 0;
  if (is_na) {
    b = it >> 8; head = it & 7; const int r0 = 2 * ((it >> 3) & 31);
    r = r0 + (wave >> 1); c = (wave & 1) * 32 + l31;
    qcs = min(max(c - 8, 0), 48);
    rsw = min(max(r - 4, 0), 56);
    rs_lo = min(max(r0 - 4, 0), 56);
    const int rs_hi = min(max(r0 - 3, 0), 56);
    tokbase = TP + b * 4096;
    qtok = tokbase + r * 64 + c;
    nchunks = 8 + rs_hi + 8 - rs_lo;
  } else {
    const int j = it - P3_NA;
    b = j >> 4; head = (j >> 1) & 7;
    tokbase = b * 256;
    qtok = tokbase + (j & 1) * 128 + wave * 32 + l31;
    nchunks = 4;
  }
  float* rpb_s = (float*)(smem + 2 * ABUF);
  if (is_na) for (int i = tid; i < 465; i += 256) rpb_s[i] = p.rpb[head * 465 + i] * 1.4426950408889634f;

  bf16x8 qf[4];
#pragma unroll
  for (int ks = 0; ks < 4; ++ks) qf[ks] = *(const bf16x8*)(Qb + (size_t)qtok * 512 + head * 64 + ks * 16 + hh * 8);

  f32x16 o0, o1;
#pragma unroll
  for (int i = 0; i < 16; ++i) { o0[i] = 0.f; o1[i] = 0.f; }
  float m_run = -INFINITY, l_run = 0.f;

  const int prow = tid >> 3, ppart = tid & 7;
  const int vpos0 = (16 * (ppart >> 1) + 4 * (ppart & 1)) * 2, vpos1 = vpos0 + 16;
  uint4 kreg0, kreg1, vreg0, vreg1;
#define LOAD_CHUNK(ci_) do { \
    const int ci__ = (ci_); const u16 *kp, *vp; size_t ks_, vs_; \
    if (is_na && ci__ < 8) { \
      kp = KC + ((size_t)(b * 8 + head) * 512 + ci__ * 64) * 64; ks_ = 64; \
      vp = VTC + ((size_t)(b * 8 + head) * 8 + ci__) * 4096; vs_ = 64; \
    } else { \
      const int kt0 = is_na ? (tokbase + (rs_lo + ci__ - 8) * 64) : (tokbase + ci__ * 64); \
      kp = Kb + ((size_t)head * TT + kt0) * 64; ks_ = 64; \
      vp = VT + ((size_t)head * (TT / 64) + (kt0 >> 6)) * 4096; vs_ = 64; \
    } \
    kreg0 = *(const uint4*)(kp + (size_t)prow * ks_ + ppart * 8); \
    kreg1 = *(const uint4*)(kp + (size_t)(prow + 32) * ks_ + ppart * 8); \
    vreg0 = *(const uint4*)(vp + (size_t)prow * vs_ + ppart * 8); \
    vreg1 = *(const uint4*)(vp + (size_t)(prow + 32) * vs_ + ppart * 8); \
  } while (0)
#define STORE_CHUNK(buf_) do { \
    char* bb_ = (buf_); \
    *(uint4*)(bb_ + prow * LROW + ppart * 16) = kreg0; \
    *(uint4*)(bb_ + (prow + 32) * LROW + ppart * 16) = kreg1; \
    char* vr0 = bb_ + ACH + prow * LROW; char* vr1 = bb_ + ACH + (prow + 32) * LROW; \
    *(uint2*)(vr0 + vpos0) = make_uint2(vreg0.x, vreg0.y); *(uint2*)(vr0 + vpos1) = make_uint2(vreg0.z, vreg0.w); \
    *(uint2*)(vr1 + vpos0) = make_uint2(vreg1.x, vreg1.y); *(uint2*)(vr1 + vpos1) = make_uint2(vreg1.z, vreg1.w); \
  } while (0)
  LOAD_CHUNK(0);
  STORE_CHUNK(smem);
  LOAD_CHUNK(1);
  for (int ci = 0; ci < nchunks; ++ci) {
    const char* cur = smem + (ci & 1) * ABUF;
    __syncthreads();
    STORE_CHUNK(smem + ((ci + 1) & 1) * ABUF);
    LOAD_CHUNK(min(ci + 2, nchunks - 1));
    __builtin_amdgcn_sched_barrier(0);
    bool act = true, window = false; int rowidx = 0;
    if (is_na && ci >= 8) { const int kr = rs_lo + ci - 8; act = (kr >= rsw) && (kr < rsw + 8); window = true; rowidx = kr - r + 7; }
    if (act) {
      f32x16 sa, sb;
#pragma unroll
      for (int i = 0; i < 16; ++i) { sa[i] = 0.f; sb[i] = 0.f; }
#pragma unroll
      for (int ks = 0; ks < 4; ++ks) {
        const bf16x8 ka = *(const bf16x8*)(cur + l31 * LROW + ks * 32 + hh * 16);
        const bf16x8 kb2 = *(const bf16x8*)(cur + (32 + l31) * LROW + ks * 32 + hh * 16);
        sa = MFMA(ka, qf[ks], sa);
        sb = MFMA(kb2, qf[ks], sb);
      }
      if (window) {
        const int kb = 4 * hh;
        const float* rp = rpb_s + rowidx * 31 + (kb - c + 15);
        const int kq = kb - qcs;
#pragma unroll
        for (int i = 0; i < 16; ++i) {
          const int co = (i & 3) + 8 * (i >> 2);
          sa[i] = ((unsigned)(kq + co) < 16u) ? (sa[i] + rp[co]) : -INFINITY;
          sb[i] = ((unsigned)(kq + 32 + co) < 16u) ? (sb[i] + rp[32 + co]) : -INFINITY;
        }
      }
      float mx = fmaxf(sa[0], sb[0]);
#pragma unroll
      for (int i = 1; i < 16; ++i) mx = fmaxf(mx, fmaxf(sa[i], sb[i]));
      mx = fmaxf(mx, __shfl_xor(mx, 32));
      if (__any(mx > m_run + 8.f)) {
        const float m_new = fmaxf(m_run, mx);
        const float alpha = __builtin_amdgcn_exp2f(m_run - m_new);
        m_run = m_new;
        l_run *= alpha;
#pragma unroll
        for (int i = 0; i < 16; ++i) { o0[i] *= alpha; o1[i] *= alpha; }
      }
      float ps = 0.f;
#pragma unroll
      for (int i = 0; i < 16; ++i) { sa[i] = __builtin_amdgcn_exp2f(sa[i] - m_run); sb[i] = __builtin_amdgcn_exp2f(sb[i] - m_run); ps += sa[i] + sb[i]; }
      l_run += ps;
#pragma unroll
      for (int kt = 0; kt < 2; ++kt)
#pragma unroll
        for (int sidx = 0; sidx < 2; ++sidx) {
          union { unsigned u[4]; bf16x8 v; } pb;
#pragma unroll
          for (int q2 = 0; q2 < 4; ++q2) pb.u[q2] = kt ? pack2(sb[8 * sidx + 2 * q2], sb[8 * sidx + 2 * q2 + 1]) : pack2(sa[8 * sidx + 2 * q2], sa[8 * sidx + 2 * q2 + 1]);
          const bf16x8 a0 = *(const bf16x8*)(cur + ACH + l31 * LROW + (kt * 32 + 16 * sidx + 8 * hh) * 2);
          const bf16x8 a1 = *(const bf16x8*)(cur + ACH + (32 + l31) * LROW + (kt * 32 + 16 * sidx + 8 * hh) * 2);
          o0 = MFMA(a0, pb.v, o0);
          o1 = MFMA(a1, pb.v, o1);
        }
    }
    __builtin_amdgcn_sched_barrier(0);
  }
  const float lt = l_run + __shfl_xor(l_run, 32);
  const float inv = 1.f / lt;
  swap32v(o0, o1);
  {
    const u16* sgp = SGB + (size_t)qtok * 512 + head * 64 + 32 * hh;
    u16* zp = Z + (size_t)qtok * 1024 + 512 + head * 64 + 32 * hh;
#pragma unroll
    for (int g = 0; g < 4; ++g) {
      const uint4 sg = *(const uint4*)(sgp + 8 * g);
      uint4 ov;
      ov.x = pack2(o0[4 * g] * inv * bflo(sg.x), o0[4 * g + 1] * inv * bfhi(sg.x));
      ov.y = pack2(o0[4 * g + 2] * inv * bflo(sg.y), o0[4 * g + 3] * inv * bfhi(sg.y));
      ov.z = pack2(o1[4 * g] * inv * bflo(sg.z), o1[4 * g + 1] * inv * bfhi(sg.z));
      ov.w = pack2(o1[4 * g + 2] * inv * bflo(sg.w), o1[4 * g + 3] * inv * bfhi(sg.w));
      *(uint4*)(zp + 8 * g) = ov;
    }
  }
}

DI void pool_item(const P& p, int it) {
  const int tid = (threadIdx.x & 255);
  const int t0 = it * 32 + (tid >> 7) * 16;
  int s0, s1;
  if (t0 < TP) { s0 = t0 & ~255; s1 = s0 + 256; } else { s0 = TP + ((t0 - TP) & ~4095); s1 = s0 + 4096; }
  const int c = (tid & 127) * 8;
  const int w = 2 << (c >> 8), hw = w >> 1;
  const u16* U1 = (const u16*)(p.ws + WS_R0);
  u16* Dd = (u16*)(p.ws + WS_R3);
  float sm[8];
#pragma unroll
  for (int k = 0; k < 8; ++k) sm[k] = 0.f;
#define POOL_ACC(v_, m_) do { \
    sm[0] += (m_) * bflo((v_).x); sm[1] += (m_) * bfhi((v_).x); sm[2] += (m_) * bflo((v_).y); sm[3] += (m_) * bfhi((v_).y); \
    sm[4] += (m_) * bflo((v_).z); sm[5] += (m_) * bfhi((v_).z); sm[6] += (m_) * bflo((v_).w); sm[7] += (m_) * bfhi((v_).w); } while (0)
#pragma unroll
  for (int j = 0; j < 15; ++j) {
    const int t = t0 - hw + j;
    const uint4 v = *(const uint4*)(U1 + (size_t)min(max(t, s0), s1 - 1) * 1024 + c);
    const float mk = (j < w - 1 && t >= s0 && t < s1) ? 1.f : 0.f;
    POOL_ACC(v, mk);
  }
#pragma unroll 8
  for (int i = 0; i < 16; ++i) {
    const int t = t0 + i;
    const int ta = t + w - hw - 1, tr = t - hw - 1;
    const uint4 va = *(const uint4*)(U1 + (size_t)min(max(ta, s0), s1 - 1) * 1024 + c);
    const uint4 vr = *(const uint4*)(U1 + (size_t)min(max(tr, s0), s1 - 1) * 1024 + c);
    const uint4 cv = *(const uint4*)(U1 + (size_t)t * 1024 + c);
    const float ma = (ta < s1) ? 1.f : 0.f;
    const float mr = (tr >= s0 && i > 0) ? -1.f : 0.f;
    POOL_ACC(va, ma);
    POOL_ACC(vr, mr);
    const int lo = max(t - hw, s0), hi = min(t + w - hw, s1);
    const float rc = 1.f / (float)(hi - lo);
    uint4 o;
    o.x = pack2(sm[0] * rc - bflo(cv.x), sm[1] * rc - bfhi(cv.x));
    o.y = pack2(sm[2] * rc - bflo(cv.y), sm[3] * rc - bfhi(cv.y));
    o.z = pack2(sm[4] * rc - bflo(cv.z), sm[5] * rc - bfhi(cv.z));
    o.w = pack2(sm[6] * rc - bflo(cv.w), sm[7] * rc - bfhi(cv.w));
    *(uint4*)(Dd + (size_t)t * 1024 + c) = o;
  }
}

#define XB_TMO      128
#define XB_XCNT(j)  (256  + 64 * (j))
#define XB_XSUB(j)  (1280 + 64 * (j))
#define XB_XGEN(j)  (2304 + 64 * (j))
#define XB_TOP      3328
#define XB_TOPGEN   3392
#define XCD_BAR_WORDS 3456
#define XB_SPIN_CAP (1u << 22)
#define LAS __attribute__((address_space(3)))
DI unsigned xb_ld(unsigned* p)              { return __hip_atomic_load(p, __ATOMIC_RELAXED, __HIP_MEMORY_SCOPE_AGENT); }
DI unsigned xb_add(unsigned* p, unsigned v) { return __hip_atomic_fetch_add(p, v, __ATOMIC_RELAXED, __HIP_MEMORY_SCOPE_AGENT); }
DI unsigned xb_xcc_id() { return (unsigned)__builtin_amdgcn_s_getreg((3 << 11) | 20) & 0xFu; }
#define XB_SPIN(cond, bar) do { unsigned _sp = 0; while (cond) { __builtin_amdgcn_s_sleep(1); \
    if ((++_sp & 255u) == 0u) { if (xb_ld(&(bar)[XB_TMO])) break; if (_sp > XB_SPIN_CAP) { atomicAdd(&(bar)[XB_TMO], 1u); break; } } } } while (0)
struct XcdBarrier { unsigned* bar; unsigned x; volatile LAS unsigned* st; };
DI XcdBarrier xcd_barrier_post(unsigned* bar, volatile LAS unsigned* st) {
  XcdBarrier b; b.bar = bar; b.x = xb_xcc_id(); b.st = st;
  if (threadIdx.x == 0) (void)xb_add(&bar[XB_XCNT(b.x)], 1u);
  return b;
}
DI void xcd_barrier_complete(unsigned* bar, unsigned x, unsigned& nloc, unsigned& nx) {
  const unsigned G = gridDim.x * gridDim.y * gridDim.z;
  unsigned sum, cnt, mine, sp = 0u;
  for (;;) {
    sum = 0u; cnt = 0u; mine = 0u;
#pragma unroll
    for (unsigned j = 0; j < 16; ++j) { const unsigned c = xb_ld(&bar[XB_XCNT(j)]); sum += c; cnt += (c > 0u) ? 1u : 0u; mine = (j == x) ? c : mine; }
    if (sum == G) break;
    __builtin_amdgcn_s_sleep(1);
    if ((++sp & 255u) == 0u) { if (xb_ld(&bar[XB_TMO])) break; if (sp > XB_SPIN_CAP) { atomicAdd(&bar[XB_TMO], 1u); break; } }
  }
  nloc = mine > 0u ? mine : 1u; nx = cnt > 0u ? cnt : 1u;
}
DI void xcd_barrier(const XcdBarrier& b) {
  asm volatile("s_waitcnt vmcnt(0)" ::: "memory");
  __syncthreads();
  if (threadIdx.x == 0) {
    unsigned* bar = b.bar;
    __builtin_amdgcn_s_waitcnt(0);
    unsigned nloc = b.st[0], nx = b.st[1];
    if (nloc == 0u) { xcd_barrier_complete(bar, b.x, nloc, nx); b.st[0] = nloc; b.st[1] = nx; }
    const unsigned old = xb_add(&bar[XB_XSUB(b.x)], 1u);
    const unsigned gen = old / nloc;
    if (old + 1u == (gen + 1u) * nloc) {
      __builtin_amdgcn_fence(__ATOMIC_RELEASE, "agent");
      asm volatile("s_waitcnt vmcnt(0)" ::: "memory");
      const unsigned og = xb_add(&bar[XB_TOP], 1u);
      const unsigned tg = og / nx;
      if (og + 1u == (tg + 1u) * nx) xb_add(&bar[XB_TOPGEN], 1u);
      else XB_SPIN(xb_ld(&bar[XB_TOPGEN]) == tg, bar);
      __builtin_amdgcn_fence(__ATOMIC_ACQUIRE, "agent");
      xb_add(&bar[XB_XGEN(b.x)], 1u);
      asm volatile("s_waitcnt vmcnt(0)" ::: "memory");
    } else {
      XB_SPIN(xb_ld(&bar[XB_XGEN(b.x)]) == gen, bar);
      __builtin_amdgcn_fence(__ATOMIC_ACQUIRE, "agent");
      asm volatile("s_waitcnt vmcnt(0)" ::: "memory");
    }
  }
  __syncthreads();
}

constexpr int N_PHASES = 10;
#define PHASE_G(k, n, call) \
  if (p.ph_lo <= (k) && (k) < p.ph_hi) { \
    for (int it = blockIdx.x; it < (n); it += gridDim.x) { __syncthreads(); call; } \
  }
#define PHASE_H(k, n, call) \
  if (p.ph_lo <= (k) && (k) < p.ph_hi) { \
    for (int it = 2 * blockIdx.x + half; it < (n); it += 2 * gridDim.x) { __syncthreads(); call; } \
  }
#define SEAM(k) \
  if (p.ph_lo <= (k) && (k) + 1 < p.ph_hi) { if (p.ph_hi > 1000) grid.sync(); xcd_barrier(xb); }

__global__ void __launch_bounds__(512, 2) mega(P p) {
  __shared__ __attribute__((aligned(16))) char smem[SMEM_BYTES + 16];
  cg::grid_group grid = cg::this_grid();
  volatile LAS unsigned* xst = (volatile LAS unsigned*)(smem + SMEM_BYTES);
  if (threadIdx.x == 0) { xst[0] = 0u; xst[1] = 0u; }
  __syncthreads();
  XcdBarrier xb = xcd_barrier_post((unsigned*)(p.ws + WS_BAR), xst);
  const int half = threadIdx.x >> 8;
  char* hsm = smem + half * HALF_SMEM;
  PHASE_H(0, P0_ITEMS, p0_item(p, it, hsm))
  SEAM(0)
  PHASE_H(1, 256, p0_item(p, it, hsm, 1))
  PHASE_H(1, 1536, modnorm_item(p, it, 0))
  SEAM(1)
  PHASE_G(2, 14 * 128, gemm_item<1>(p, it, smem))
  SEAM(2)
  if (!(p.flags & 1)) { PHASE_H(3, P3_NA + P3_CTX, attn_item(p, it, hsm)) }
  if (!(p.flags & 2)) { PHASE_H(3, P3_CONV, conv_item(p, it, hsm)) }
  SEAM(3)
  PHASE_G(4, 4 * 192, gemm_item<2>(p, it, smem))
  if (p.ph_lo <= 4 && 6 < p.ph_hi) { if (p.ph_hi > 1000) grid.sync(); xcd_barrier(xb); }
  PHASE_G(6, 8 * 96, gemm_item<3>(p, it, smem))
  if (p.ph_lo <= 6 && 8 < p.ph_hi) { if (p.ph_hi > 1000) grid.sync(); xcd_barrier(xb); }
  PHASE_G(8, 4 * 192, gemm_item<4>(p, it, smem))
  SEAM(8)
  PHASE_G(9, 4 * 192, gemm_item<5>(p, it, smem))
}

extern "C" void kernel_launch(void* const* d_in, const int* in_sizes, int n_in, void* d_out, int out_size, void* d_ws, size_t ws_size, hipStream_t stream) {
  static int grid_blocks = 0;
  if (!grid_blocks) {
    int dev = 0, cus = 0, per_cu = 0;
    hipGetDevice(&dev);
    hipDeviceGetAttribute(&cus, hipDeviceAttributeMultiprocessorCount, dev);
    hipOccupancyMaxActiveBlocksPerMultiprocessor(&per_cu, mega, 512, 0);
    per_cu = 1;
    grid_blocks = cus * per_cu;
    if (ws_size < WS_END) fprintf(stderr, "kernel_launch: workspace too small: %zu < %zu\n", ws_size, (size_t)WS_END);
  }
  P p{};
  const float** f = (const float**)&p;
  for (int i = 0; i < 25; ++i) f[i] = (const float*)d_in[i];
  p.out = (float*)d_out;
  p.ws = (char*)d_ws;
#if MK_MULTI
  for (int ph = 0; ph < N_PHASES; ++ph) {
    p.ph_lo = ph; p.ph_hi = ph + 1;
#ifdef PROBE_PH
    if (ph == PROBE_PH) { p.flags = PROBE_FLAGS; for (int rr = 0; rr < PROBE_N; ++rr) hipLaunchKernelGGL(mega, dim3(grid_blocks), dim3(512), 0, stream, p); p.flags = 0; }
#endif
    hipLaunchKernelGGL(mega, dim3(grid_blocks), dim3(512), 0, stream, p);
  }
#else
  p.ph_lo = 0; p.ph_hi = N_PHASES;
  hipMemsetAsync((char*)d_ws + WS_BAR, 0, XCD_BAR_WORDS * 4, stream);
  void* args[] = {&p};
  hipError_t e = hipLaunchCooperativeKernel((void*)mega, dim3(grid_blocks), dim3(512), args, 0, stream);
  if (e != hipSuccess) fprintf(stderr, "cooperative launch failed: %s (grid %d)\n", hipGetErrorString(e), grid_blocks);
#endif
}
```

```cpp
#include <hip/hip_runtime.h>
#include <hip/hip_cooperative_groups.h>
#include <cstdio>
namespace cg = cooperative_groups;

#ifndef GD
#define GD 3
#endif
#ifndef MK_MULTI
#define MK_MULTI 0
#endif

typedef unsigned short u16;
using bf16x8 = __attribute__((ext_vector_type(8))) short;
using f32x16 = __attribute__((ext_vector_type(16))) float;
#define DI __device__ __forceinline__
#define MFMA(a, b, c) __builtin_amdgcn_mfma_f32_32x32x16_bf16((a), (b), (c), 0, 0, 0)

constexpr int TP = 8192;
constexpr int TT = 24576;
constexpr float EPS = 1e-6f;

constexpr size_t WS_MOD   = 0;
constexpr size_t WS_WIN0  = 131072;
constexpr size_t WS_WOUT0 = WS_WIN0 + (size_t)3584 * 1024 * 2;
constexpr size_t WS_WIN1  = WS_WOUT0 + (size_t)1024 * 1024 * 2;
constexpr size_t WS_WPOOL = WS_WIN1 + (size_t)2048 * 1024 * 2;
constexpr size_t WS_WOUT1 = WS_WPOOL + (size_t)4 * 256 * 256 * 2;
constexpr size_t WS_KC    = WS_WOUT1 + (size_t)1024 * 1024 * 2;
constexpr size_t WS_VTC   = WS_KC + (size_t)4 * 8 * 512 * 64 * 2;
constexpr size_t WS_R0    = WS_VTC + (size_t)4 * 8 * 512 * 64 * 2;
constexpr size_t RSZ      = (size_t)TT * 1024 * 2;
constexpr size_t WS_R1    = WS_R0 + RSZ;
constexpr size_t WS_R2    = WS_R1 + RSZ;
constexpr size_t WS_R3    = WS_R2 + RSZ;
constexpr size_t WS_BAR   = WS_R3 + RSZ;
constexpr size_t WS_UP    = WS_BAR + 16384;
constexpr size_t WS_SS    = WS_UP + (size_t)(24576 + 36 * 32) * 1024;
constexpr size_t WS_SW    = WS_SS + (size_t)TT * 4;
constexpr size_t WS_END   = WS_SW + 5 * 2048 * 4;
constexpr size_t HALF_R   = RSZ / 2;

struct P {
  const float *x_prompt, *x_sample, *cache_k, *cache_v, *c, *c_ctx;
  const float *norm_g0, *w_ada0, *b_ada0, *w_in0, *conv_w, *conv_b, *ln_g, *ln_b, *q_norm, *k_norm, *rpb, *w_out0;
  const float *norm_g1, *w_ada1, *b_ada1, *w_in1, *pool_w, *pool_scale, *w_out1;
  float* out;
  char* ws;
  int ph_lo, ph_hi, flags, pad;
};

typedef __bf16 hbf16x2 __attribute__((ext_vector_type(2)));
typedef float hf32x2 __attribute__((ext_vector_type(2)));
DI unsigned pack2(float a, float b) { hf32x2 v = {a, b}; hbf16x2 r = __builtin_convertvector(v, hbf16x2); return __builtin_bit_cast(unsigned, r); }
DI u16 f2bf(float x) { return (u16)(pack2(x, 0.f) & 0xffffu); }
DI float bf2f(u16 v) { return __uint_as_float(((unsigned)v) << 16); }
DI void swap32v(f32x16& x, f32x16& y) {
#pragma unroll
  for (int i = 0; i < 16; ++i) {
    auto r = __builtin_amdgcn_permlane32_swap(__float_as_uint(x[i]), __float_as_uint(y[i]), false, false);
    x[i] = __uint_as_float(r[0]); y[i] = __uint_as_float(r[1]);
  }
}
DI void swap32(float& x, float& y) {
  auto r = __builtin_amdgcn_permlane32_swap(__float_as_uint(x), __float_as_uint(y), false, false);
  x = __uint_as_float(r[0]); y = __uint_as_float(r[1]);
}
DI float bflo(unsigned v) { return __uint_as_float(v << 16); }
DI float bfhi(unsigned v) { return __uint_as_float(v & 0xffff0000u); }
DI float silu_f(float x) { return x * __builtin_amdgcn_rcpf(1.f + __builtin_amdgcn_exp2f(-1.4426950408889634f * x)); }
DI float sigm_f(float x) { return __builtin_amdgcn_rcpf(1.f + __builtin_amdgcn_exp2f(-1.4426950408889634f * x)); }
DI const float* xrow(const P& p, int t) { return t < TP ? p.x_prompt + (size_t)t * 1024 : p.x_sample + (size_t)(t - TP) * 1024; }
DI int midx(int t) { return t < TP ? 0 : 1 + ((t - TP) >> 12); }
DI int prow(int t) { const int seq = t < TP ? (t >> 8) : 32 + ((t - TP) >> 12); return t + 32 * seq + 16; }

constexpr int P0_ADA = 384, P0_TR = 2240, P0_KC = 256, P0_PAD = 36, P0_SS = 6, P0_ITEMS = P0_ADA + P0_TR + P0_KC + P0_PAD + P0_SS;

DI void p0_item(const P& p, int it, char* smem, int mode = 0) {
  const int tid = (threadIdx.x & 255);
  if (mode == 1 || it < P0_ADA) {
    const int NC = mode ? 8 : 16;
    const int QN = NC >> 2, KL = 256 / QN, NIT = 1024 / KL;
    const int layer = mode ? 0 : it / 192, n0 = mode ? it * 8 : (it % 192) * 16;
    const int ldw = mode ? 2048 : 3072;
    float* sc = (float*)smem;
    float* red = (float*)(smem + 20480);
    for (int e = tid; e < 5120; e += 256) {
      const int j = e >> 10, k = e & 1023;
      if (mode) sc[e] = ((const float*)(p.ws + WS_MOD))[(5 + j) * 3072 + k];
      else { const float v = (j == 0) ? p.c_ctx[k] : p.c[(j - 1) * 1024 + k]; sc[e] = silu_f(v); }
    }
    __syncthreads();
    const float* W = mode ? p.w_in1 : (layer ? p.w_ada1 : p.w_ada0);
    const float* bias = layer ? p.b_ada1 : p.b_ada0;
    const int cq = tid % QN, kl = tid / QN;
    float acc[5][4];
#pragma unroll
    for (int j = 0; j < 5; ++j) { acc[j][0] = acc[j][1] = acc[j][2] = acc[j][3] = 0.f; }
#pragma unroll 8
    for (int i = 0; i < NIT; ++i) {
      const int k = kl + KL * i;
      const float4 w = *(const float4*)(W + (size_t)k * ldw + n0 + 4 * cq);
#pragma unroll
      for (int j = 0; j < 5; ++j) {
        const float s = sc[j * 1024 + k];
        acc[j][0] += s * w.x; acc[j][1] += s * w.y; acc[j][2] += s * w.z; acc[j][3] += s * w.w;
      }
    }
#pragma unroll
    for (int j = 0; j < 5; ++j)
#pragma unroll
      for (int a = 0; a < 4; ++a) red[((kl * QN + cq) * 5 + j) * 4 + a] = acc[j][a];
    __syncthreads();
    if (tid < 5 * NC) {
      const int j = tid / NC, col = tid % NC;
      float s = mode ? 0.f : bias[n0 + col];
      for (int k2 = 0; k2 < KL; ++k2) s += red[((k2 * QN + (col >> 2)) * 5 + j) * 4 + (col & 3)];
      if (mode) ((float*)(p.ws + WS_SW))[j * 2048 + n0 + col] = s;
      else ((float*)(p.ws + WS_MOD))[(layer * 5 + j) * 3072 + n0 + col] = s;
    }
  } else if (it < P0_ADA + P0_TR) {
    int j = it - P0_ADA;
    const float* src; u16* dst; int sstride, dstride, r0, n0, dk0 = -1; bool perm = false;
    if (j < 896) { src = p.w_in0; sstride = 3584; r0 = (j / 56) * 64; n0 = (j % 56) * 64; dst = (u16*)(p.ws + WS_WIN0); dstride = 1024; perm = true; }
    else if (j < 1152) { j -= 896; src = p.w_out0; sstride = 1024; r0 = (j / 16) * 64; n0 = (j % 16) * 64; dst = (u16*)(p.ws + WS_WOUT0); dstride = 1024; }
    else if (j < 1664) { j -= 1152; src = p.w_in1; sstride = 2048; r0 = (j / 32) * 64; n0 = (j % 32) * 64; dst = (u16*)(p.ws + WS_WIN1); dstride = 1024; }
    else if (j < 1728) { j -= 1664; const int g = j >> 4; src = p.pool_w + g * 65536; sstride = 256; r0 = ((j & 15) >> 2) * 64; n0 = (j & 3) * 64; dst = (u16*)(p.ws + WS_WPOOL) + g * 65536; dstride = 256; }
    else if (j < 1984) { j -= 1728; src = p.w_out1; sstride = 1024; r0 = (j / 16) * 64; n0 = (j % 16) * 64; dst = (u16*)(p.ws + WS_WOUT1); dstride = 1024; }
    else { j -= 1984; const int bh = j >> 3, mt = j & 7; src = p.cache_v + (size_t)(bh >> 3) * 512 * 512 + (bh & 7) * 64; sstride = 512; r0 = mt * 64; n0 = 0; dst = (u16*)(p.ws + WS_VTC) + ((size_t)bh * 8 + mt) * 4096; dstride = 64; dk0 = 0; }
    float* tile = (float*)smem;
    {
      const int r = tid >> 4, c4 = (tid & 15) * 4;
      int nn = n0 + c4;
      if (perm && nn < 1024) { const int w = nn >> 6, rr = nn & 63; nn = (rr < 32) ? (32 * w + rr) : (512 + 32 * w + rr - 32); }
#pragma unroll
      for (int i = 0; i < 4; ++i) {
        const float4 v = *(const float4*)(src + (size_t)(r0 + r + 16 * i) * sstride + nn);
        *(float4*)(tile + (r + 16 * i) * 68 + c4) = v;
      }
    }
    __syncthreads();
    {
      const int n = tid >> 2, kseg = (tid & 3) * 16;
      unsigned pk[8];
#pragma unroll
      for (int j = 0; j < 8; ++j) pk[j] = pack2(tile[(kseg + 2 * j) * 68 + n], tile[(kseg + 2 * j + 1) * 68 + n]);
      u16* d = dst + (size_t)(n0 + n) * dstride + (dk0 < 0 ? r0 : dk0) + kseg;
      *(uint4*)d = make_uint4(pk[0], pk[1], pk[2], pk[3]);
      *(uint4*)(d + 8) = make_uint4(pk[4], pk[5], pk[6], pk[7]);
    }
  } else if (it >= P0_ADA + P0_TR + P0_KC + P0_PAD) {
    float* ss = (float*)(p.ws + WS_SS) + (it - P0_ADA - P0_TR - P0_KC - P0_PAD) * 4096;
#pragma unroll
    for (int i = 0; i < 4; ++i) *(float4*)(ss + (i * 256 + tid) * 4) = make_float4(0.f, 0.f, 0.f, 0.f);
  } else if (it >= P0_ADA + P0_TR + P0_KC) {
    const int sq = it - P0_ADA - P0_TR - P0_KC;
    const int st = sq < 32 ? sq * 256 : TP + (sq - 32) * 4096, en = st + (sq < 32 ? 256 : 4096);
    char* up = p.ws + WS_UP;
    const uint4 z = make_uint4(0u, 0u, 0u, 0u);
#pragma unroll
    for (int i = 0; i < 4; ++i) {
      *(uint4*)(up + (size_t)(st + 32 * sq) * 1024 + (i * 256 + tid) * 16) = z;
      *(uint4*)(up + (size_t)(en + 32 * sq + 16) * 1024 + (i * 256 + tid) * 16) = z;
    }
  } else {
    const int it2 = it - P0_ADA - P0_TR;
    u16* kc = (u16*)(p.ws + WS_KC);
#pragma unroll
    for (int e = 0; e < 16; ++e) {
      const int o = it2 * 4096 + e * 256 + tid;
      const int d = o & 63, m = (o >> 6) & 511, bh = o >> 15;
      kc[o] = f2bf(p.cache_k[(((size_t)(bh >> 3) * 512 + m) * 8 + (bh & 7)) * 64 + d]);
    }
  }
}

DI void modnorm_item(const P& p, int it, int layer) {
  const int tid = (threadIdx.x & 255), lane = tid & 63, wave = tid >> 6;
  const int row0 = it * 16 + wave * 4;
  const float* g = layer ? p.norm_g1 : p.norm_g0;
  const float* mod = (const float*)(p.ws + WS_MOD) + (size_t)(layer * 5 + midx(row0)) * 3072;
  u16* H = (u16*)(p.ws + WS_R0);
  float4 a[4], b[4];
#pragma unroll
  for (int j = 0; j < 4; ++j) {
    const int col = j * 256 + lane * 4;
    const float4 gv = *(const float4*)(g + col);
    const float4 sh = *(const float4*)(mod + col);
    const float4 sv = *(const float4*)(mod + 1024 + col);
    a[j] = make_float4(gv.x * (1.f + sv.x), gv.y * (1.f + sv.y), gv.z * (1.f + sv.z), gv.w * (1.f + sv.w));
    b[j] = sh;
  }
#pragma unroll
  for (int r = 0; r < 4; ++r) {
    const int row = row0 + r;
    const float* xr = layer ? (p.out + (size_t)row * 1024) : xrow(p, row);
    float4 v[4];
    float ss = 0.f;
#pragma unroll
    for (int j = 0; j < 4; ++j) {
      v[j] = *(const float4*)(xr + j * 256 + lane * 4);
      ss += v[j].x * v[j].x + v[j].y * v[j].y + v[j].z * v[j].z + v[j].w * v[j].w;
    }
#pragma unroll
    for (int o = 32; o >= 1; o >>= 1) ss += __shfl_xor(ss, o);
    const float rinv = rsqrtf(ss * (1.f / 1024.f) + EPS);
#pragma unroll
    for (int j = 0; j < 4; ++j) {
      uint2 o2;
      o2.x = pack2(v[j].x * rinv * a[j].x + b[j].x, v[j].y * rinv * a[j].y + b[j].y);
      o2.y = pack2(v[j].z * rinv * a[j].z + b[j].z, v[j].w * rinv * a[j].w + b[j].w);
      *(uint2*)(H + (size_t)row * 1024 + j * 256 + lane * 4) = o2;
    }
  }
}

DI int crow(int i, int hh) { return (i & 3) + 8 * (i >> 2) + 4 * hh; }

constexpr int LROW = 144;
constexpr int GSTAGE = 512 * LROW;
constexpr int SMEM_BYTES = 2 * GSTAGE;
constexpr int HALF_SMEM = GSTAGE;

template <int NK, int CFG>
DI void gemm_mainloop(const u16* Ag, int lda, const u16* Bg, int ldb, char* smem, f32x16 (&acc)[CFG == 0 ? 4 : 2][CFG == 2 ? 3 : 2]) {
  constexpr int MI = CFG == 0 ? 4 : 2;
  constexpr int NJ = CFG == 2 ? 3 : 2;
  int tid = threadIdx.x;
  asm volatile("" : "+v"(tid));
  const int lane = tid & 63, wave = tid >> 6;
  const int wm = CFG == 0 ? (wave >> 2) : (wave >> 1);
  const int wn = CFG == 0 ? (wave & 3) : (wave & 1);
  const int srow = tid >> 3, scol = tid & 7;
  const u16* ag = Ag + (size_t)srow * lda + scol * 8;
  const u16* bg = Bg + (size_t)srow * ldb + scol * 8;
  uint4 r0a0, r0a1, r0a2, r0a3, r0b0, r0b1, r0b2, r0b3, r1a0, r1a1, r1a2, r1a3, r1b0, r1b1, r1b2, r1b3;
#define G_LOAD(R, ko_) do { \
    R##a0 = *(const uint4*)(ag + (ko_)); R##a1 = *(const uint4*)(ag + (size_t)64 * lda + (ko_)); \
    R##a2 = *(const uint4*)(ag + (size_t)128 * lda + (ko_)); R##a3 = *(const uint4*)(ag + (size_t)192 * lda + (ko_)); \
    R##b0 = *(const uint4*)(bg + (ko_)); R##b1 = *(const uint4*)(bg + (size_t)64 * ldb + (ko_)); \
    if (CFG != 1) R##b2 = *(const uint4*)(bg + (size_t)128 * ldb + (ko_)); \
    if (CFG == 0) R##b3 = *(const uint4*)(bg + (size_t)192 * ldb + (ko_)); } while (0)
#define G_STORE(R, base_) do { char* b_ = (base_) + wofs; \
    *(uint4*)(b_) = R##a0; *(uint4*)(b_ + 64 * LROW) = R##a1; *(uint4*)(b_ + 128 * LROW) = R##a2; *(uint4*)(b_ + 192 * LROW) = R##a3; \
    *(uint4*)(b_ + 256 * LROW) = R##b0; *(uint4*)(b_ + 320 * LROW) = R##b1; \
    if (CFG != 1) *(uint4*)(b_ + 384 * LROW) = R##b2; \
    if (CFG == 0) *(uint4*)(b_ + 448 * LROW) = R##b3; } while (0)
  const int wofs = srow * LROW + scol * 16;
  const int aofs = (wm * (MI * 32) + (lane & 31)) * LROW + (lane >> 5) * 16;
  const int bofs = 256 * LROW + (wn * (NJ * 32) + (lane & 31)) * LROW + (lane >> 5) * 16;
  bf16x8 fa[2][MI], fb[2][NJ];
#define LOADF(buf_, ks_) do { \
    _Pragma("unroll") \
    for (int nj_ = 0; nj_ < NJ; ++nj_) fb[buf_][nj_] = *(const bf16x8*)(cur + bofs + nj_ * 32 * LROW + (ks_) * 32); \
    _Pragma("unroll") \
    for (int mi_ = 0; mi_ < MI; ++mi_) fa[buf_][mi_] = *(const bf16x8*)(cur + aofs + mi_ * 32 * LROW + (ks_) * 32); } while (0)
#define G_STEP(R, kt_, AH_) do { \
    constexpr int kt__ = (kt_); \
    if (kt__ < NK) { \
      const char* cur = smem + (kt__ & 1) * GSTAGE; \
      __syncthreads(); \
      if (kt__ + 1 < NK) G_STORE(R, smem + ((kt__ + 1) & 1) * GSTAGE); \
      if (kt__ + (AH_) < NK) G_LOAD(R, (kt__ + (AH_)) * 64); \
      __builtin_amdgcn_sched_barrier(0); \
      LOADF(0, 0); \
      _Pragma("unroll") \
      for (int ks = 0; ks < 4; ++ks) { \
        if (ks < 3) LOADF((ks + 1) & 1, ks + 1); \
        __builtin_amdgcn_s_setprio(1); \
        _Pragma("unroll") \
        for (int mi = 0; mi < MI; ++mi) { \
          _Pragma("unroll") \
          for (int nj = 0; nj < NJ; ++nj) acc[mi][nj] = MFMA(fa[ks & 1][mi], fb[ks & 1][nj], acc[mi][nj]); \
        } \
        __builtin_amdgcn_s_setprio(0); \
      } \
      __builtin_amdgcn_sched_barrier(0); \
    } \
  } while (0)
  static_assert(NK >= 4 && NK <= 16, "K tiles");
  G_LOAD(r0, 0);
  G_STORE(r0, smem);
  G_LOAD(r0, 64);
  if (CFG != 1) {
    G_STEP(r0, 0, 2);  G_STEP(r0, 1, 2);  G_STEP(r0, 2, 2);  G_STEP(r0, 3, 2);
    G_STEP(r0, 4, 2);  G_STEP(r0, 5, 2);  G_STEP(r0, 6, 2);  G_STEP(r0, 7, 2);
    G_STEP(r0, 8, 2);  G_STEP(r0, 9, 2);  G_STEP(r0, 10, 2); G_STEP(r0, 11, 2);
    G_STEP(r0, 12, 2); G_STEP(r0, 13, 2); G_STEP(r0, 14, 2); G_STEP(r0, 15, 2);
  } else {
    G_LOAD(r1, 128);
    G_STEP(r0, 0, 3);  G_STEP(r1, 1, 3);  G_STEP(r0, 2, 3);  G_STEP(r1, 3, 3);
    G_STEP(r0, 4, 3);  G_STEP(r1, 5, 3);  G_STEP(r0, 6, 3);  G_STEP(r1, 7, 3);
    G_STEP(r0, 8, 3);  G_STEP(r1, 9, 3);  G_STEP(r0, 10, 3); G_STEP(r1, 11, 3);
    G_STEP(r0, 12, 3); G_STEP(r1, 13, 3); G_STEP(r0, 14, 3); G_STEP(r1, 15, 3);
  }
}

DI void tile_remap(int item, int FG, int NFG, int& ft, int& tt) {
  const int G = gridDim.x;
  if (G & 7) { const int NF = FG * NFG; ft = item % NF; tt = item / NF; return; }
  const int b = item % G, k = item / G;
  const int xcd = b & 7, q = (b >> 3) + k * (G >> 3);
  const int S = FG * 8;
  const int sq = q / S, r = q - sq * S;
  const int sidx = sq * 8 + xcd;
  const int ftg = sidx % NFG, ttg = sidx / NFG;
  ft = ftg * FG + r % FG;
  tt = ttg * 8 + r / FG;
}

DI void kv_rows_out(float* wbuf, int lane, float* gbase  , int tok0) {
#pragma unroll
  for (int i = 0; i < 8; ++i) {
    const int row = 4 * i + (lane >> 4), col = (lane & 15) * 4;
    const float4 v = *(const float4*)(wbuf + row * 68 + col);
    if (tok0 + row < TP) *(float4*)(gbase + (size_t)row * 512 + col) = v;
  }
}

template <int EPI>
DI void gemm_item(const P& p, int item, char* smem) {
  constexpr int CFG = (EPI == 1) ? 2 : (EPI == 3) ? 0 : 1;
  constexpr int MI = CFG == 0 ? 4 : 2;
  constexpr int NJ = CFG == 2 ? 3 : 2;
  constexpr int TNT = CFG == 0 ? 256 : (CFG == 2 ? 192 : 128);
  int tid = threadIdx.x;
  asm volatile("" : "+v"(tid));
  const int lane = tid & 63, wave = tid >> 6, l31 = lane & 31, hh = lane >> 5;
  const int wm = CFG == 0 ? (wave >> 2) : (wave >> 1);
  const int wn = CFG == 0 ? (wave & 3) : (wave & 1);
  const u16 *A, *B; int lda, ldb, f0, t0, grp = 0;
  if (EPI == 1) { int ft, tt; tile_remap(item, 7, 2, ft, tt); f0 = ft * 256; t0 = tt * TNT; A = (const u16*)(p.ws + WS_WIN0) + (size_t)f0 * 1024; lda = 1024; B = (const u16*)(p.ws + WS_R0) + (size_t)t0 * 1024; ldb = 1024; }
  else if (EPI == 2) { int ft, tt; tile_remap(item, 4, 1, ft, tt); f0 = ft * 256; t0 = tt * TNT; A = (const u16*)(p.ws + WS_WOUT0) + (size_t)f0 * 1024; lda = 1024; B = (const u16*)(p.ws + WS_R0) + (size_t)t0 * 1024; ldb = 1024; }
  else if (EPI == 3) { int ft, tt; tile_remap(item, 4, 2, ft, tt); f0 = ft * 256; t0 = tt * TNT; A = (const u16*)(p.ws + WS_WIN1) + (size_t)f0 * 1024; lda = 1024; B = (const u16*)(p.ws + WS_R1) + (size_t)t0 * 1024; ldb = 1024; }
  else if (EPI == 4) { grp = item & 3; const int tt = item >> 2; f0 = 0; t0 = tt * TNT; A = (const u16*)(p.ws + WS_WPOOL) + grp * 65536; lda = 256; B = (const u16*)(p.ws + WS_R3) + (size_t)t0 * 1024 + grp * 256; ldb = 1024; }
  else { int ft, tt; tile_remap(item, 4, 1, ft, tt); f0 = ft * 256; t0 = tt * TNT; A = (const u16*)(p.ws + WS_WOUT1) + (size_t)f0 * 1024; lda = 1024; B = (const u16*)(p.ws + WS_R0) + (size_t)t0 * 1024; ldb = 1024; }

  f32x16 acc[MI][NJ];
#pragma unroll
  for (int a = 0; a < MI; ++a)
#pragma unroll
    for (int b = 0; b < NJ; ++b)
#pragma unroll
      for (int i = 0; i < 16; ++i) acc[a][b][i] = 0.f;
  if (EPI == 4 && t0 >= TP) {
    const int w = 2 << grp, hw = w >> 1;
    const int s0 = TP + ((t0 - TP) & ~4095), s1 = s0 + 4096;
    int rfix0, nfix;
    if ((t0 & 255) == 0) { rfix0 = t0; nfix = (t0 != s0) ? hw : 0; }
    else { nfix = (t0 + 128 != s1) ? (w - hw - 1) : 0; rfix0 = t0 + 128 - nfix; }
    const int rr = tid >> 6, cc = grp * 256 + (tid & 63) * 4;
    if (rr < nfix) {
      const u16* U1 = (const u16*)(p.ws + WS_R0);
      const int t = rfix0 + rr;
      const int lo = max(t - hw, s0), hi = min(t + w - hw, s1);
      float a0 = 0.f, a1 = 0.f, a2 = 0.f, a3 = 0.f;
      for (int tt = lo; tt < hi; ++tt) {
        const uint2 v = *(const uint2*)(U1 + (size_t)tt * 1024 + cc);
        a0 += bflo(v.x); a1 += bfhi(v.x); a2 += bflo(v.y); a3 += bfhi(v.y);
      }
      const uint2 cv = *(const uint2*)(U1 + (size_t)t * 1024 + cc);
      const float rc = 1.f / (float)(hi - lo);
      uint2 o; o.x = pack2(a0 * rc - bflo(cv.x), a1 * rc - bfhi(cv.x)); o.y = pack2(a2 * rc - bflo(cv.y), a3 * rc - bfhi(cv.y));
      *(uint2*)((u16*)(p.ws + WS_R3) + (size_t)t * 1024 + cc) = o;
    }
    asm volatile("s_waitcnt vmcnt(0)" ::: "memory");
    __syncthreads();
  }
  if (EPI == 4) gemm_mainloop<4, CFG>(A, lda, B, ldb, smem, acc); else gemm_mainloop<16, CFG>(A, lda, B, ldb, smem, acc);

  if (EPI == 2 || EPI == 4 || EPI == 5) {
    constexpr int SP = 260;
    float* st = (float*)smem;
    __syncthreads();
#pragma unroll
    for (int nj = 0; nj < 2; ++nj) {
      const int tokl = wn * 64 + nj * 32 + l31;
#pragma unroll
      for (int mi = 0; mi < 2; ++mi)
#pragma unroll
        for (int g = 0; g < 4; ++g)
          *(float4*)(st + tokl * SP + wm * 64 + mi * 32 + 8 * g + 4 * hh) = make_float4(acc[mi][nj][4 * g], acc[mi][nj][4 * g + 1], acc[mi][nj][4 * g + 2], acc[mi][nj][4 * g + 3]);
    }
    __syncthreads();
    const int col = lane * 4;
    if (EPI == 4) {
      const u16* SG1 = (const u16*)(p.ws + WS_R2);
      u16* Z1 = (u16*)(p.ws + WS_R0);
      const float4 sc = *(const float4*)(p.pool_scale + grp * 256 + col);
#pragma unroll 4
      for (int r = 0; r < 16; ++r) {
        const int tokl = wave * 16 + r, tok = t0 + tokl;
        const float4 a = *(const float4*)(st + tokl * SP + col);
        const uint2 sg = *(const uint2*)(SG1 + (size_t)tok * 1024 + grp * 256 + col);
        uint2 o;
        o.x = pack2(a.x * sc.x * bflo(sg.x), a.y * sc.y * bfhi(sg.x));
        o.y = pack2(a.z * sc.z * bflo(sg.y), a.w * sc.w * bfhi(sg.y));
        *(uint2*)(Z1 + (size_t)tok * 1024 + grp * 256 + col) = o;
      }
    } else {
      const int layer = (EPI == 2) ? 0 : 1;
      const float4 gv = *(const float4*)((const float*)(p.ws + WS_MOD) + (size_t)(layer * 5 + midx(t0)) * 3072 + 2048 + f0 + col);
      float4 a1 = make_float4(0.f, 0.f, 0.f, 0.f);
      if (EPI == 2) {
        const float4 g1 = *(const float4*)(p.norm_g1 + f0 + col);
        const float4 sc1 = *(const float4*)((const float*)(p.ws + WS_MOD) + (size_t)(5 + midx(t0)) * 3072 + 1024 + f0 + col);
        a1 = make_float4(g1.x * (1.f + sc1.x), g1.y * (1.f + sc1.y), g1.z * (1.f + sc1.z), g1.w * (1.f + sc1.w));
      }
      float ssq[16];
#pragma unroll
      for (int r = 0; r < 16; ++r) {
        const int tokl = wave * 16 + r, tok = t0 + tokl;
        const float4 a = *(const float4*)(st + tokl * SP + col);
        const float* xr = ((EPI == 2) ? xrow(p, tok) : (p.out + (size_t)tok * 1024)) + f0 + col;
        const float4 xv = *(const float4*)xr;
        float4 o;
        o.x = xv.x + gv.x * a.x; o.y = xv.y + gv.y * a.y; o.z = xv.z + gv.z * a.z; o.w = xv.w + gv.w * a.w;
        *(float4*)(p.out + (size_t)tok * 1024 + f0 + col) = o;
        if (EPI == 2) {
          uint2 ya; ya.x = pack2(o.x * a1.x, o.y * a1.y); ya.y = pack2(o.z * a1.z, o.w * a1.w);
          *(uint2*)((u16*)(p.ws + WS_R1) + (size_t)tok * 1024 + f0 + col) = ya;
          ssq[r] = o.x * o.x + o.y * o.y + o.z * o.z + o.w * o.w;
        }
      }
      if (EPI == 2) {
#pragma unroll
        for (int half = 8, bit = 32; half >= 1; half >>= 1, bit >>= 1) {
          const bool up = (lane & bit) != 0;
#pragma unroll
          for (int k = 0; k < half; ++k) {
            const float keep = up ? ssq[k + half] : ssq[k];
            const float send = up ? ssq[k] : ssq[k + half];
            ssq[k] = keep + __shfl_xor(send, bit);
          }
        }
        ssq[0] += __shfl_xor(ssq[0], 2);
        ssq[0] += __shfl_xor(ssq[0], 1);
        if ((lane & 3) == 0) atomicAdd((float*)(p.ws + WS_SS) + t0 + wave * 16 + (lane >> 2), ssq[0]);
      }
    }
    return;
  }
  const int tokb = t0 + wn * (NJ * 32);
  if (EPI == 3) __syncthreads();
  if (EPI == 1 && t0 < TP && f0 >= 2048 && f0 < 3072) __syncthreads();
#pragma unroll
  for (int fblk = 0; fblk < MI / 2; ++fblk) {
  const int fb = f0 + wm * (MI * 32) + fblk * 64;
  if (EPI == 1) {
    u16* U = (u16*)(p.ws + WS_UP);
    u16* SGA = (u16*)(p.ws + WS_R1 + HALF_R);
    u16* Q = (u16*)(p.ws + WS_R2);
    u16* Kb = (u16*)(p.ws + WS_R2 + HALF_R);
    u16* VT = (u16*)(p.ws + WS_R3);
    u16* SGB = (u16*)(p.ws + WS_R3 + HALF_R);
#pragma unroll
    for (int nj = 0; nj < NJ; ++nj) {
      const int tok = tokb + nj * 32 + l31;
      const bool kvst = (tokb + nj * 32 < TP);
      float* wbuf = (float*)smem + wave * (32 * 68);
      f32x16& X = acc[2 * fblk][nj];
      f32x16& Y = acc[2 * fblk + 1][nj];
      if (fb < 1024) {
        const int cb = (fb >> 6) * 32;
        float u[16];
#pragma unroll
        for (int i = 0; i < 16; ++i) u[i] = X[i] * sigm_f(Y[i]);
#pragma unroll
        for (int i = 0; i < 8; ++i) swap32(u[i], u[i + 8]);
#pragma unroll
        for (int gg = 0; gg < 2; ++gg) {
          uint4 o;
          o.x = pack2(u[4 * gg], u[4 * gg + 1]); o.y = pack2(u[4 * gg + 2], u[4 * gg + 3]);
          o.z = pack2(u[8 + 4 * gg], u[8 + 4 * gg + 1]); o.w = pack2(u[8 + 4 * gg + 2], u[8 + 4 * gg + 3]);
          *(uint4*)(U + (size_t)prow(tok) * 512 + cb + 16 * hh + 8 * gg) = o;
        }
      } else if (fb < 1536 || fb >= 3072) {
        u16* dst = (fb < 1536) ? (SGA + (size_t)tok * 512 + (fb - 1024)) : (SGB + (size_t)tok * 512 + (fb - 3072));
#pragma unroll
        for (int i = 0; i < 16; ++i) { X[i] = silu_f(X[i]); Y[i] = silu_f(Y[i]); }
        swap32v(X, Y);
#pragma unroll
        for (int g = 0; g < 4; ++g) {
          uint4 o;
          o.x = pack2(X[4 * g], X[4 * g + 1]); o.y = pack2(X[4 * g + 2], X[4 * g + 3]);
          o.z = pack2(Y[4 * g], Y[4 * g + 1]); o.w = pack2(Y[4 * g + 2], Y[4 * g + 3]);
          *(uint4*)(dst + 32 * hh + 8 * g) = o;
        }
      } else if (fb < 2560) {
        const bool isq = fb < 2048;
        const int hc = isq ? (fb - 1536) : (fb - 2048);
        float ss = 0.f;
#pragma unroll
        for (int i = 0; i < 16; ++i) ss += X[i] * X[i] + Y[i] * Y[i];
        ss += __shfl_xor(ss, 32);
        const float rinv = rsqrtf(ss * (1.f / 64.f) + EPS);
        swap32v(X, Y);
        const float* nw = (isq ? p.q_norm : p.k_norm) + 32 * hh;
        const float qs = isq ? (0.125f * 1.4426950408889634f) : 1.f;
        u16* dst = isq ? (Q + (size_t)tok * 512 + hc + 32 * hh) : (Kb + ((size_t)(hc >> 6) * TT + tok) * 64 + 32 * hh);
        float* kout = p.out + (size_t)TT * 1024 + (size_t)tok * 512 + hc + 32 * hh;
#pragma unroll
        for (int g = 0; g < 4; ++g) {
          const float4 w0 = *(const float4*)(nw + 8 * g);
          const float4 w1 = *(const float4*)(nw + 8 * g + 4);
          float4 v0, v1;
          v0.x = X[4 * g] * rinv * w0.x; v0.y = X[4 * g + 1] * rinv * w0.y; v0.z = X[4 * g + 2] * rinv * w0.z; v0.w = X[4 * g + 3] * rinv * w0.w;
          v1.x = Y[4 * g] * rinv * w1.x; v1.y = Y[4 * g + 1] * rinv * w1.y; v1.z = Y[4 * g + 2] * rinv * w1.z; v1.w = Y[4 * g + 3] * rinv * w1.w;
          if (!isq && kvst) { *(float4*)(wbuf + l31 * 68 + 32 * hh + 8 * g) = v0; *(float4*)(wbuf + l31 * 68 + 32 * hh + 8 * g + 4) = v1; }
          uint4 o;
          o.x = pack2(v0.x * qs, v0.y * qs); o.y = pack2(v0.z * qs, v0.w * qs);
          o.z = pack2(v1.x * qs, v1.y * qs); o.w = pack2(v1.z * qs, v1.w * qs);
          *(uint4*)(dst + 8 * g) = o;
        }
        if (!isq && kvst) kv_rows_out(wbuf, lane, p.out + (size_t)TT * 1024 + (size_t)(tokb + nj * 32) * 512 + hc, tokb + nj * 32);
      } else {
        const int hc = fb - 2560;
#pragma unroll
        for (int mi = 0; mi < 2; ++mi)
#pragma unroll
          for (int i = 0; i < 16; ++i) VT[(((size_t)(hc >> 6) * (TT / 64) + (tok >> 6)) * 64 + mi * 32 + crow(i, hh)) * 64 + (tok & 63)] = f2bf(acc[2 * fblk + mi][nj][i]);
        if (kvst) {
          swap32v(X, Y);
#pragma unroll
          for (int g = 0; g < 4; ++g) {
            *(float4*)(wbuf + l31 * 68 + 32 * hh + 8 * g) = make_float4(X[4 * g], X[4 * g + 1], X[4 * g + 2], X[4 * g + 3]);
            *(float4*)(wbuf + l31 * 68 + 32 * hh + 8 * g + 4) = make_float4(Y[4 * g], Y[4 * g + 1], Y[4 * g + 2], Y[4 * g + 3]);
          }
          kv_rows_out(wbuf, lane, p.out + (size_t)TT * 1024 + (size_t)TP * 512 + (size_t)(tokb + nj * 32) * 512 + hc, tokb + nj * 32);
        }
      }
    }
  } else if (EPI == 2 || EPI == 5) {
    const int layer = (EPI == 2) ? 0 : 1;
#pragma unroll
    for (int nj = 0; nj < 2; ++nj) {
      const int tok = tokb + nj * 32 + l31;
      f32x16& X = acc[2 * fblk][nj];
      f32x16& Y = acc[2 * fblk + 1][nj];
      swap32v(X, Y);
      const int colb = fb + 32 * hh;
      const float* gate = (const float*)(p.ws + WS_MOD) + (size_t)(layer * 5 + midx(tok)) * 3072 + 2048 + colb;
      const float* xr = ((EPI == 2) ? xrow(p, tok) : (p.out + (size_t)tok * 1024)) + colb;
      float* yr = p.out + (size_t)tok * 1024 + colb;
#pragma unroll
      for (int g = 0; g < 4; ++g) {
        const float4 x0 = *(const float4*)(xr + 8 * g), x1 = *(const float4*)(xr + 8 * g + 4);
        const float4 g0 = *(const float4*)(gate + 8 * g), g1 = *(const float4*)(gate + 8 * g + 4);
        float4 o0, o1;
        o0.x = x0.x + g0.x * X[4 * g]; o0.y = x0.y + g0.y * X[4 * g + 1]; o0.z = x0.z + g0.z * X[4 * g + 2]; o0.w = x0.w + g0.w * X[4 * g + 3];
        o1.x = x1.x + g1.x * Y[4 * g]; o1.y = x1.y + g1.y * Y[4 * g + 1]; o1.z = x1.z + g1.z * Y[4 * g + 2]; o1.w = x1.w + g1.w * Y[4 * g + 3];
        *(float4*)(yr + 8 * g) = o0; *(float4*)(yr + 8 * g + 4) = o1;
      }
    }
  } else if (EPI == 3) {
    u16* U1 = (u16*)(p.ws + WS_R0);
    u16* SG1 = (u16*)(p.ws + WS_R2);
#pragma unroll
    for (int nj = 0; nj < 2; ++nj) {
      const int tok = tokb + nj * 32 + l31;
      f32x16& X = acc[2 * fblk][nj];
      f32x16& Y = acc[2 * fblk + 1][nj];
      swap32v(X, Y);
      {
        const float rinv = rsqrtf(((const float*)(p.ws + WS_SS))[tok] * (1.f / 1024.f) + EPS);
        const float* sw = (const float*)(p.ws + WS_SW) + midx(tok) * 2048 + fb + 32 * hh;
#pragma unroll
        for (int g = 0; g < 4; ++g) {
          const float4 s0 = *(const float4*)(sw + 8 * g), s1 = *(const float4*)(sw + 8 * g + 4);
          X[4 * g] = X[4 * g] * rinv + s0.x; X[4 * g + 1] = X[4 * g + 1] * rinv + s0.y; X[4 * g + 2] = X[4 * g + 2] * rinv + s0.z; X[4 * g + 3] = X[4 * g + 3] * rinv + s0.w;
          Y[4 * g] = Y[4 * g] * rinv + s1.x; Y[4 * g + 1] = Y[4 * g + 1] * rinv + s1.y; Y[4 * g + 2] = Y[4 * g + 2] * rinv + s1.z; Y[4 * g + 3] = Y[4 * g + 3] * rinv + s1.w;
        }
      }
      if (fb >= 1024) {
#pragma unroll
        for (int i = 0; i < 16; ++i) { X[i] = silu_f(X[i]); Y[i] = silu_f(Y[i]); }
      }
      char* dst = smem + (wn * 64 + nj * 32 + l31) * 528 + (fb - f0 + 32 * hh) * 2;
#pragma unroll
      for (int g = 0; g < 4; ++g) {
        uint4 o;
        o.x = pack2(X[4 * g], X[4 * g + 1]); o.y = pack2(X[4 * g + 2], X[4 * g + 3]);
        o.z = pack2(Y[4 * g], Y[4 * g + 1]); o.w = pack2(Y[4 * g + 2], Y[4 * g + 3]);
        *(uint4*)(dst + 16 * g) = o;
      }
    }
  } else {
    const u16* SG1 = (const u16*)(p.ws + WS_R2);
    u16* Z1 = (u16*)(p.ws + WS_R0);
#pragma unroll
    for (int nj = 0; nj < 2; ++nj) {
      const int tok = tokb + nj * 32 + l31;
      f32x16& X = acc[2 * fblk][nj];
      f32x16& Y = acc[2 * fblk + 1][nj];
      swap32v(X, Y);
      const int colb = grp * 256 + fb + 32 * hh;
#pragma unroll
      for (int g = 0; g < 4; ++g) {
        const float4 s0 = *(const float4*)(p.pool_scale + colb + 8 * g), s1 = *(const float4*)(p.pool_scale + colb + 8 * g + 4);
        const uint4 sg = *(const uint4*)(SG1 + (size_t)tok * 1024 + colb + 8 * g);
        uint4 o;
        o.x = pack2(X[4 * g] * s0.x * bflo(sg.x), X[4 * g + 1] * s0.y * bfhi(sg.x));
        o.y = pack2(X[4 * g + 2] * s0.z * bflo(sg.y), X[4 * g + 3] * s0.w * bfhi(sg.y));
        o.z = pack2(Y[4 * g] * s1.x * bflo(sg.z), Y[4 * g + 1] * s1.y * bfhi(sg.z));
        o.w = pack2(Y[4 * g + 2] * s1.z * bflo(sg.w), Y[4 * g + 3] * s1.w * bfhi(sg.w));
        *(uint4*)(Z1 + (size_t)tok * 1024 + colb + 8 * g) = o;
      }
    }
  }
  }
  if (EPI == 3) {
    __syncthreads();
    u16* dstg = (f0 < 1024) ? ((u16*)(p.ws + WS_R0) + f0) : ((u16*)(p.ws + WS_R2) + f0 - 1024);
#pragma unroll 4
    for (int i = 0; i < 16; ++i) {
      const int row = wave * 32 + 2 * i + (lane >> 5), ch = lane & 31;
      const uint4 v = *(const uint4*)(smem + row * 528 + ch * 16);
      *(uint4*)(dstg + (size_t)(t0 + row) * 1024 + ch * 8) = v;
    }
    if (f0 < 1024) {
      const int w = 2 << (f0 >> 8), hw = w >> 1;
      int seqlo = 0, seqhi = 256;
      if (t0 >= TP) { const int s0 = TP + ((t0 - TP) & ~4095); seqlo = s0 - t0; seqhi = s0 + 4096 - t0; }
      const int lo_ok = max(seqlo, 0), hi_ok = min(seqhi, 256);
      const int ch = lane & 31, rb = wave * 32 + (lane >> 5) * 16;
      u16* Dd = (u16*)(p.ws + WS_R3);
      float sm[8];
#pragma unroll
      for (int k = 0; k < 8; ++k) sm[k] = 0.f;
#define EP_ACC(v_, m_) do { \
      sm[0] += (m_) * bflo((v_).x); sm[1] += (m_) * bfhi((v_).x); sm[2] += (m_) * bflo((v_).y); sm[3] += (m_) * bfhi((v_).y); \
      sm[4] += (m_) * bflo((v_).z); sm[5] += (m_) * bfhi((v_).z); sm[6] += (m_) * bflo((v_).w); sm[7] += (m_) * bfhi((v_).w); } while (0)
#pragma unroll
      for (int j = 0; j < 15; ++j) {
        const int t = rb - hw + j;
        const uint4 v = *(const uint4*)(smem + min(max(t, 0), 255) * 528 + ch * 16);
        const float mk = (j < w - 1 && t >= lo_ok && t < hi_ok) ? 1.f : 0.f;
        EP_ACC(v, mk);
      }
#pragma unroll 4
      for (int i = 0; i < 16; ++i) {
        const int r = rb + i;
        const int ta = r + w - hw - 1, tr = r - hw - 1;
        const uint4 va = *(const uint4*)(smem + min(ta, 255) * 528 + ch * 16);
        const uint4 vr = *(const uint4*)(smem + max(tr, 0) * 528 + ch * 16);
        const uint4 cv = *(const uint4*)(smem + r * 528 + ch * 16);
        const float ma = (ta < hi_ok) ? 1.f : 0.f;
        const float mr = (tr >= lo_ok && i > 0) ? -1.f : 0.f;
        EP_ACC(va, ma);
        EP_ACC(vr, mr);
        const int lo = max(r - hw, seqlo), hi = min(r + w - hw, seqhi);
        if (lo >= 0 && hi <= 256) {
          const float rc = 1.f / (float)(hi - lo);
          uint4 o;
          o.x = pack2(sm[0] * rc - bflo(cv.x), sm[1] * rc - bfhi(cv.x));
          o.y = pack2(sm[2] * rc - bflo(cv.y), sm[3] * rc - bfhi(cv.y));
          o.z = pack2(sm[4] * rc - bflo(cv.z), sm[5] * rc - bfhi(cv.z));
          o.w = pack2(sm[6] * rc - bflo(cv.w), sm[7] * rc - bfhi(cv.w));
          *(uint4*)(Dd + (size_t)(t0 + r) * 1024 + f0 + ch * 8) = o;
        }
      }
    }
  }
}

constexpr int P3_NA = 1024, P3_CTX = 512, P3_CONV = 1536, P3_ITEMS = P3_NA + P3_CTX + P3_CONV;

typedef float f32x2 __attribute__((ext_vector_type(2)));
DI void conv_item(const P& p, int it, char* smem) {
  const int tid = (threadIdx.x & 255), lane = tid & 63, wave = tid >> 6;
  const int t0 = it * 16;
  const int c = 2 * tid;
  const u16* UP = (const u16*)(p.ws + WS_UP) + (size_t)(prow(t0) - 15) * 512 + c;
  const u16* SGA = (const u16*)(p.ws + WS_R1 + HALF_R);
  u16* Z = (u16*)(p.ws + WS_R0);
  float* ylds = (float*)smem;
  f32x2 w[31];
#pragma unroll
  for (int j = 0; j < 31; ++j) w[j] = *(const f32x2*)(p.conv_w + j * 512 + c);
  const f32x2 cb = *(const f32x2*)(p.conv_b + c);
  unsigned uv[46];
#pragma unroll
  for (int r = 0; r < 46; ++r) uv[r] = *(const unsigned*)(UP + r * 512);
#pragma unroll
  for (int grp = 0; grp < 2; ++grp) {
    f32x2 y[8];
#pragma unroll
    for (int i = 0; i < 8; ++i) y[i] = cb;
#pragma unroll
    for (int r = 0; r < 38; ++r) {
      const unsigned v = uv[grp * 8 + r];
      f32x2 vv; vv.x = bflo(v); vv.y = bfhi(v);
#pragma unroll
      for (int i = 0; i < 8; ++i) {
        const int j = r - i;
        if (j >= 0 && j <= 30) y[i] = __builtin_elementwise_fma(vv, w[j], y[i]);
      }
    }
#pragma unroll
    for (int i = 0; i < 8; ++i) *(f32x2*)(ylds + (grp * 8 + i) * 512 + c) = y[i];
  }
  __syncthreads();
  const int c1 = lane * 4, c2 = 256 + lane * 4;
  const float4 g1 = *(const float4*)(p.ln_g + c1), g2 = *(const float4*)(p.ln_g + c2);
  const float4 b1 = *(const float4*)(p.ln_b + c1), b2 = *(const float4*)(p.ln_b + c2);
#pragma unroll
  for (int tt = 0; tt < 4; ++tt) {
    const int tl = wave * 4 + tt, tok = t0 + tl;
    const float4 a = *(const float4*)(ylds + tl * 512 + c1), b = *(const float4*)(ylds + tl * 512 + c2);
    float s1 = a.x + a.y + a.z + a.w + b.x + b.y + b.z + b.w;
    float s2 = a.x * a.x + a.y * a.y + a.z * a.z + a.w * a.w + b.x * b.x + b.y * b.y + b.z * b.z + b.w * b.w;
#pragma unroll
    for (int o = 32; o >= 1; o >>= 1) { s1 += __shfl_xor(s1, o); s2 += __shfl_xor(s2, o); }
    const float mean = s1 * (1.f / 512.f);
    const float var = fmaxf(s2 * (1.f / 512.f) - mean * mean, 0.f);
    const float rstd = rsqrtf(var + EPS);
    const uint2 ga1 = *(const uint2*)(SGA + (size_t)tok * 512 + c1), ga2 = *(const uint2*)(SGA + (size_t)tok * 512 + c2);
    uint2 o1, o2;
    o1.x = pack2(silu_f((a.x - mean) * rstd * g1.x + b1.x) * bflo(ga1.x), silu_f((a.y - mean) * rstd * g1.y + b1.y) * bfhi(ga1.x));
    o1.y = pack2(silu_f((a.z - mean) * rstd * g1.z + b1.z) * bflo(ga1.y), silu_f((a.w - mean) * rstd * g1.w + b1.w) * bfhi(ga1.y));
    o2.x = pack2(silu_f((b.x - mean) * rstd * g2.x + b2.x) * bflo(ga2.x), silu_f((b.y - mean) * rstd * g2.y + b2.y) * bfhi(ga2.x));
    o2.y = pack2(silu_f((b.z - mean) * rstd * g2.z + b2.z) * bflo(ga2.y), silu_f((b.w - mean) * rstd * g2.w + b2.w) * bfhi(ga2.y));
    *(uint2*)(Z + (size_t)tok * 1024 + c1) = o1;
    *(uint2*)(Z + (size_t)tok * 1024 + c2) = o2;
  }
}

constexpr int ACH = 64 * LROW;
constexpr int ABUF = 2 * ACH;

DI void attn_item(const P& p, int it, char* smem) {
  const int tid = (threadIdx.x & 255), lane = tid & 63, wave = tid >> 6, l31 = lane & 31, hh = lane >> 5;
  const bool is_na = it < P3_NA;
  const u16* Qb = (const u16*)(p.ws + WS_R2);
  const u16* Kb = (const u16*)(p.ws + WS_R2 + HALF_R);
  const u16* VT = (const u16*)(p.ws + WS_R3);
  const u16* SGB = (const u16*)(p.ws + WS_R3 + HALF_R);
  const u16* KC = (const u16*)(p.ws + WS_KC);
  const u16* VTC = (const u16*)(p.ws + WS_VTC);
  u16* Z = (u16*)(p.ws + WS_R0);
  int b, head, qtok, nchunks, tokbase;
  int r = 0, c = 0, qcs = 0, rsw = 0, rs_lo = 0;
  if (is_na) {
    const int vb = it & 511;
    head = (vb >> 1) & 7; b = 2 * (it >> 9) + (vb & 1); const int r0 = 2 * (vb >> 4);
    r = r0 + (wave >> 1); c = (wave & 1) * 32 + l31;
    qcs = min(max(c - 8, 0), 48);
    rsw = min(max(r - 4, 0), 56);
    rs_lo = min(max(r0 - 4, 0), 56);
    const int rs_hi = min(max(r0 - 3, 0), 56);
    tokbase = TP + b * 4096;
    qtok = tokbase + r * 64 + c;
    nchunks = 8 + rs_hi + 8 - rs_lo;
  } else {
    const int j = it - P3_NA;
    b = j >> 4; head = (j >> 1) & 7;
    tokbase = b * 256;
    qtok = tokbase + (j & 1) * 128 + wave * 32 + l31;
    nchunks = 4;
  }
  float* rpb_s = (float*)(smem + 2 * ABUF);
  if (is_na) for (int i = tid; i < 465; i += 256) rpb_s[i] = p.rpb[head * 465 + i] * 1.4426950408889634f;

  bf16x8 qf[4];
#pragma unroll
  for (int ks = 0; ks < 4; ++ks) qf[ks] = *(const bf16x8*)(Qb + (size_t)qtok * 512 + head * 64 + ks * 16 + hh * 8);

  f32x16 o0, o1;
#pragma unroll
  for (int i = 0; i < 16; ++i) { o0[i] = 0.f; o1[i] = 0.f; }
  float m_run = -INFINITY, l_run = 0.f;

  const int prow = tid >> 3, ppart = tid & 7;
  const int vpos0 = (16 * (ppart >> 1) + 4 * (ppart & 1)) * 2, vpos1 = vpos0 + 16;
  uint4 kreg0, kreg1, vreg0, vreg1;
#define LOAD_CHUNK(ci_) do { \
    const int ci__ = (ci_); const u16 *kp, *vp; size_t ks_, vs_; \
    if (is_na && ci__ < 8) { \
      kp = KC + ((size_t)(b * 8 + head) * 512 + ci__ * 64) * 64; ks_ = 64; \
      vp = VTC + ((size_t)(b * 8 + head) * 8 + ci__) * 4096; vs_ = 64; \
    } else { \
      const int kt0 = is_na ? (tokbase + (rs_lo + ci__ - 8) * 64) : (tokbase + ci__ * 64); \
      kp = Kb + ((size_t)head * TT + kt0) * 64; ks_ = 64; \
      vp = VT + ((size_t)head * (TT / 64) + (kt0 >> 6)) * 4096; vs_ = 64; \
    } \
    kreg0 = *(const uint4*)(kp + (size_t)prow * ks_ + ppart * 8); \
    kreg1 = *(const uint4*)(kp + (size_t)(prow + 32) * ks_ + ppart * 8); \
    vreg0 = *(const uint4*)(vp + (size_t)prow * vs_ + ppart * 8); \
    vreg1 = *(const uint4*)(vp + (size_t)(prow + 32) * vs_ + ppart * 8); \
  } while (0)
#define STORE_CHUNK(buf_) do { \
    char* bb_ = (buf_); \
    *(uint4*)(bb_ + prow * LROW + ppart * 16) = kreg0; \
    *(uint4*)(bb_ + (prow + 32) * LROW + ppart * 16) = kreg1; \
    char* vr0 = bb_ + ACH + prow * LROW; char* vr1 = bb_ + ACH + (prow + 32) * LROW; \
    *(uint2*)(vr0 + vpos0) = make_uint2(vreg0.x, vreg0.y); *(uint2*)(vr0 + vpos1) = make_uint2(vreg0.z, vreg0.w); \
    *(uint2*)(vr1 + vpos0) = make_uint2(vreg1.x, vreg1.y); *(uint2*)(vr1 + vpos1) = make_uint2(vreg1.z, vreg1.w); \
  } while (0)
  LOAD_CHUNK(0);
  STORE_CHUNK(smem);
  LOAD_CHUNK(1);
  for (int ci = 0; ci < nchunks; ++ci) {
    const char* cur = smem + (ci & 1) * ABUF;
    __syncthreads();
    STORE_CHUNK(smem + ((ci + 1) & 1) * ABUF);
    LOAD_CHUNK(min(ci + 2, nchunks - 1));
    __builtin_amdgcn_sched_barrier(0);
    bool act = true, window = false; int rowidx = 0;
    if (is_na && ci >= 8) { const int kr = rs_lo + ci - 8; act = (kr >= rsw) && (kr < rsw + 8); window = true; rowidx = kr - r + 7; }
    if (act) {
      f32x16 sa, sb;
#pragma unroll
      for (int i = 0; i < 16; ++i) { sa[i] = 0.f; sb[i] = 0.f; }
#pragma unroll
      for (int ks = 0; ks < 4; ++ks) {
        const bf16x8 ka = *(const bf16x8*)(cur + l31 * LROW + ks * 32 + hh * 16);
        const bf16x8 kb2 = *(const bf16x8*)(cur + (32 + l31) * LROW + ks * 32 + hh * 16);
        sa = MFMA(ka, qf[ks], sa);
        sb = MFMA(kb2, qf[ks], sb);
      }
      if (window) {
        const int kb = 4 * hh;
        const float* rp = rpb_s + rowidx * 31 + (kb - c + 15);
        const int kq = kb - qcs;
#pragma unroll
        for (int i = 0; i < 16; ++i) {
          const int co = (i & 3) + 8 * (i >> 2);
          sa[i] = ((unsigned)(kq + co) < 16u) ? (sa[i] + rp[co]) : -INFINITY;
          sb[i] = ((unsigned)(kq + 32 + co) < 16u) ? (sb[i] + rp[32 + co]) : -INFINITY;
        }
      }
      float mx = fmaxf(sa[0], sb[0]);
#pragma unroll
      for (int i = 1; i < 16; ++i) mx = fmaxf(mx, fmaxf(sa[i], sb[i]));
      mx = fmaxf(mx, __shfl_xor(mx, 32));
      if (__any(mx > m_run + 8.f)) {
        const float m_new = fmaxf(m_run, mx);
        const float alpha = __builtin_amdgcn_exp2f(m_run - m_new);
        m_run = m_new;
        l_run *= alpha;
#pragma unroll
        for (int i = 0; i < 16; ++i) { o0[i] *= alpha; o1[i] *= alpha; }
      }
      float ps = 0.f;
#pragma unroll
      for (int i = 0; i < 16; ++i) { sa[i] = __builtin_amdgcn_exp2f(sa[i] - m_run); sb[i] = __builtin_amdgcn_exp2f(sb[i] - m_run); ps += sa[i] + sb[i]; }
      l_run += ps;
#pragma unroll
      for (int kt = 0; kt < 2; ++kt)
#pragma unroll
        for (int sidx = 0; sidx < 2; ++sidx) {
          union { unsigned u[4]; bf16x8 v; } pb;
#pragma unroll
          for (int q2 = 0; q2 < 4; ++q2) pb.u[q2] = kt ? pack2(sb[8 * sidx + 2 * q2], sb[8 * sidx + 2 * q2 + 1]) : pack2(sa[8 * sidx + 2 * q2], sa[8 * sidx + 2 * q2 + 1]);
          const bf16x8 a0 = *(const bf16x8*)(cur + ACH + l31 * LROW + (kt * 32 + 16 * sidx + 8 * hh) * 2);
          const bf16x8 a1 = *(const bf16x8*)(cur + ACH + (32 + l31) * LROW + (kt * 32 + 16 * sidx + 8 * hh) * 2);
          o0 = MFMA(a0, pb.v, o0);
          o1 = MFMA(a1, pb.v, o1);
        }
    }
    __builtin_amdgcn_sched_barrier(0);
  }
  const float lt = l_run + __shfl_xor(l_run, 32);
  const float inv = 1.f / lt;
  swap32v(o0, o1);
  {
    const u16* sgp = SGB + (size_t)qtok * 512 + head * 64 + 32 * hh;
    u16* zp = Z + (size_t)qtok * 1024 + 512 + head * 64 + 32 * hh;
#pragma unroll
    for (int g = 0; g < 4; ++g) {
      const uint4 sg = *(const uint4*)(sgp + 8 * g);
      uint4 ov;
      ov.x = pack2(o0[4 * g] * inv * bflo(sg.x), o0[4 * g + 1] * inv * bfhi(sg.x));
      ov.y = pack2(o0[4 * g + 2] * inv * bflo(sg.y), o0[4 * g + 3] * inv * bfhi(sg.y));
      ov.z = pack2(o1[4 * g] * inv * bflo(sg.z), o1[4 * g + 1] * inv * bfhi(sg.z));
      ov.w = pack2(o1[4 * g + 2] * inv * bflo(sg.w), o1[4 * g + 3] * inv * bfhi(sg.w));
      *(uint4*)(zp + 8 * g) = ov;
    }
  }
}

DI void pool_item(const P& p, int it) {
  const int tid = (threadIdx.x & 255);
  const int t0 = it * 32 + (tid >> 7) * 16;
  int s0, s1;
  if (t0 < TP) { s0 = t0 & ~255; s1 = s0 + 256; } else { s0 = TP + ((t0 - TP) & ~4095); s1 = s0 + 4096; }
  const int c = (tid & 127) * 8;
  const int w = 2 << (c >> 8), hw = w >> 1;
  const u16* U1 = (const u16*)(p.ws + WS_R0);
  u16* Dd = (u16*)(p.ws + WS_R3);
  float sm[8];
#pragma unroll
  for (int k = 0; k < 8; ++k) sm[k] = 0.f;
#define POOL_ACC(v_, m_) do { \
    sm[0] += (m_) * bflo((v_).x); sm[1] += (m_) * bfhi((v_).x); sm[2] += (m_) * bflo((v_).y); sm[3] += (m_) * bfhi((v_).y); \
    sm[4] += (m_) * bflo((v_).z); sm[5] += (m_) * bfhi((v_).z); sm[6] += (m_) * bflo((v_).w); sm[7] += (m_) * bfhi((v_).w); } while (0)
#pragma unroll
  for (int j = 0; j < 15; ++j) {
    const int t = t0 - hw + j;
    const uint4 v = *(const uint4*)(U1 + (size_t)min(max(t, s0), s1 - 1) * 1024 + c);
    const float mk = (j < w - 1 && t >= s0 && t < s1) ? 1.f : 0.f;
    POOL_ACC(v, mk);
  }
#pragma unroll 8
  for (int i = 0; i < 16; ++i) {
    const int t = t0 + i;
    const int ta = t + w - hw - 1, tr = t - hw - 1;
    const uint4 va = *(const uint4*)(U1 + (size_t)min(max(ta, s0), s1 - 1) * 1024 + c);
    const uint4 vr = *(const uint4*)(U1 + (size_t)min(max(tr, s0), s1 - 1) * 1024 + c);
    const uint4 cv = *(const uint4*)(U1 + (size_t)t * 1024 + c);
    const float ma = (ta < s1) ? 1.f : 0.f;
    const float mr = (tr >= s0 && i > 0) ? -1.f : 0.f;
    POOL_ACC(va, ma);
    POOL_ACC(vr, mr);
    const int lo = max(t - hw, s0), hi = min(t + w - hw, s1);
    const float rc = 1.f / (float)(hi - lo);
    uint4 o;
    o.x = pack2(sm[0] * rc - bflo(cv.x), sm[1] * rc - bfhi(cv.x));
    o.y = pack2(sm[2] * rc - bflo(cv.y), sm[3] * rc - bfhi(cv.y));
    o.z = pack2(sm[4] * rc - bflo(cv.z), sm[5] * rc - bfhi(cv.z));
    o.w = pack2(sm[6] * rc - bflo(cv.w), sm[7] * rc - bfhi(cv.w));
    *(uint4*)(Dd + (size_t)t * 1024 + c) = o;
  }
}

#define XB_TMO      128
#define XB_XCNT(j)  (256  + 64 * (j))
#define XB_XSUB(j)  (1280 + 64 * (j))
#define XB_XGEN(j)  (2304 + 64 * (j))
#define XB_TOP      3328
#define XB_TOPGEN   3392
#define XCD_BAR_WORDS 3456
#define XB_SPIN_CAP (1u << 22)
#define LAS __attribute__((address_space(3)))
DI unsigned xb_ld(unsigned* p)              { return __hip_atomic_load(p, __ATOMIC_RELAXED, __HIP_MEMORY_SCOPE_AGENT); }
DI unsigned xb_add(unsigned* p, unsigned v) { return __hip_atomic_fetch_add(p, v, __ATOMIC_RELAXED, __HIP_MEMORY_SCOPE_AGENT); }
DI unsigned xb_xcc_id() { return (unsigned)__builtin_amdgcn_s_getreg((3 << 11) | 20) & 0xFu; }
#define XB_SPIN(cond, bar) do { unsigned _sp = 0; while (cond) { __builtin_amdgcn_s_sleep(1); \
    if ((++_sp & 255u) == 0u) { if (xb_ld(&(bar)[XB_TMO])) break; if (_sp > XB_SPIN_CAP) { atomicAdd(&(bar)[XB_TMO], 1u); break; } } } } while (0)
struct XcdBarrier { unsigned* bar; unsigned x; volatile LAS unsigned* st; };
DI XcdBarrier xcd_barrier_post(unsigned* bar, volatile LAS unsigned* st) {
  XcdBarrier b; b.bar = bar; b.x = xb_xcc_id(); b.st = st;
  if (threadIdx.x == 0) (void)xb_add(&bar[XB_XCNT(b.x)], 1u);
  return b;
}
DI void xcd_barrier_complete(unsigned* bar, unsigned x, unsigned& nloc, unsigned& nx) {
  const unsigned G = gridDim.x * gridDim.y * gridDim.z;
  unsigned sum, cnt, mine, sp = 0u;
  for (;;) {
    sum = 0u; cnt = 0u; mine = 0u;
#pragma unroll
    for (unsigned j = 0; j < 16; ++j) { const unsigned c = xb_ld(&bar[XB_XCNT(j)]); sum += c; cnt += (c > 0u) ? 1u : 0u; mine = (j == x) ? c : mine; }
    if (sum == G) break;
    __builtin_amdgcn_s_sleep(1);
    if ((++sp & 255u) == 0u) { if (xb_ld(&bar[XB_TMO])) break; if (sp > XB_SPIN_CAP) { atomicAdd(&bar[XB_TMO], 1u); break; } }
  }
  nloc = mine > 0u ? mine : 1u; nx = cnt > 0u ? cnt : 1u;
}
DI void xcd_barrier(const XcdBarrier& b) {
  asm volatile("s_waitcnt vmcnt(0)" ::: "memory");
  __syncthreads();
  if (threadIdx.x == 0) {
    unsigned* bar = b.bar;
    __builtin_amdgcn_s_waitcnt(0);
    unsigned nloc = b.st[0], nx = b.st[1];
    if (nloc == 0u) { xcd_barrier_complete(bar, b.x, nloc, nx); b.st[0] = nloc; b.st[1] = nx; }
    const unsigned old = xb_add(&bar[XB_XSUB(b.x)], 1u);
    const unsigned gen = old / nloc;
    if (old + 1u == (gen + 1u) * nloc) {
      __builtin_amdgcn_fence(__ATOMIC_RELEASE, "agent");
      asm volatile("s_waitcnt vmcnt(0)" ::: "memory");
      const unsigned og = xb_add(&bar[XB_TOP], 1u);
      const unsigned tg = og / nx;
      if (og + 1u == (tg + 1u) * nx) xb_add(&bar[XB_TOPGEN], 1u);
      else XB_SPIN(xb_ld(&bar[XB_TOPGEN]) == tg, bar);
      __builtin_amdgcn_fence(__ATOMIC_ACQUIRE, "agent");
      xb_add(&bar[XB_XGEN(b.x)], 1u);
      asm volatile("s_waitcnt vmcnt(0)" ::: "memory");
    } else {
      XB_SPIN(xb_ld(&bar[XB_XGEN(b.x)]) == gen, bar);
      __builtin_amdgcn_fence(__ATOMIC_ACQUIRE, "agent");
      asm volatile("s_waitcnt vmcnt(0)" ::: "memory");
    }
  }
  __syncthreads();
}

constexpr int N_PHASES = 10;
#define PHASE_G(k, n, call) \
  if (p.ph_lo <= (k) && (k) < p.ph_hi) { \
    for (int it = blockIdx.x; it < (n); it += gridDim.x) { __syncthreads(); call; } \
  }
#define PHASE_H(k, n, call) \
  if (p.ph_lo <= (k) && (k) < p.ph_hi) { \
    for (int it = 2 * blockIdx.x + half; it < (n); it += 2 * gridDim.x) { __syncthreads(); call; } \
  }
#define SEAM(k) \
  if (p.ph_lo <= (k) && (k) + 1 < p.ph_hi) { if (p.ph_hi > 1000) grid.sync(); xcd_barrier(xb); }

__global__ void __launch_bounds__(512, 2) mega(P p) {
  __shared__ __attribute__((aligned(16))) char smem[SMEM_BYTES + 16];
  cg::grid_group grid = cg::this_grid();
  volatile LAS unsigned* xst = (volatile LAS unsigned*)(smem + SMEM_BYTES);
  if (threadIdx.x == 0) { xst[0] = 0u; xst[1] = 0u; }
  __syncthreads();
  XcdBarrier xb = xcd_barrier_post((unsigned*)(p.ws + WS_BAR), xst);
  const int half = threadIdx.x >> 8;
  char* hsm = smem + half * HALF_SMEM;
  PHASE_H(0, P0_ITEMS, p0_item(p, it, hsm))
  SEAM(0)
  PHASE_H(1, 256, p0_item(p, it, hsm, 1))
  PHASE_H(1, 1536, modnorm_item(p, it, 0))
  SEAM(1)
  PHASE_G(2, 14 * 128, gemm_item<1>(p, it, smem))
  SEAM(2)
  if (!(p.flags & 1)) { PHASE_H(3, P3_NA + P3_CTX, attn_item(p, it, hsm)) }
  if (!(p.flags & 2)) { PHASE_H(3, P3_CONV, conv_item(p, it, hsm)) }
  SEAM(3)
  PHASE_G(4, 4 * 192, gemm_item<2>(p, it, smem))
  if (p.ph_lo <= 4 && 6 < p.ph_hi) { if (p.ph_hi > 1000) grid.sync(); xcd_barrier(xb); }
  PHASE_G(6, 8 * 96, gemm_item<3>(p, it, smem))
  if (p.ph_lo <= 6 && 8 < p.ph_hi) { if (p.ph_hi > 1000) grid.sync(); xcd_barrier(xb); }
  PHASE_G(8, 4 * 192, gemm_item<4>(p, it, smem))
  SEAM(8)
  PHASE_G(9, 4 * 192, gemm_item<5>(p, it, smem))
}

extern "C" void kernel_launch(void* const* d_in, const int* in_sizes, int n_in, void* d_out, int out_size, void* d_ws, size_t ws_size, hipStream_t stream) {
  static int grid_blocks = 0;
  if (!grid_blocks) {
    int dev = 0, cus = 0, per_cu = 0;
    hipGetDevice(&dev);
    hipDeviceGetAttribute(&cus, hipDeviceAttributeMultiprocessorCount, dev);
    hipOccupancyMaxActiveBlocksPerMultiprocessor(&per_cu, mega, 512, 0);
    per_cu = 1;
    grid_blocks = cus * per_cu;
    if (ws_size < WS_END) fprintf(stderr, "kernel_launch: workspace too small: %zu < %zu\n", ws_size, (size_t)WS_END);
  }
  P p{};
  const float** f = (const float**)&p;
  for (int i = 0; i < 25; ++i) f[i] = (const float*)d_in[i];
  p.out = (float*)d_out;
  p.ws = (char*)d_ws;
#if MK_MULTI
  for (int ph = 0; ph < N_PHASES; ++ph) {
    p.ph_lo = ph; p.ph_hi = ph + 1;
#ifdef PROBE_PH
    if (ph == PROBE_PH) { p.flags = PROBE_FLAGS; for (int rr = 0; rr < PROBE_N; ++rr) hipLaunchKernelGGL(mega, dim3(grid_blocks), dim3(512), 0, stream, p); p.flags = 0; }
#endif
    hipLaunchKernelGGL(mega, dim3(grid_blocks), dim3(512), 0, stream, p);
  }
#else
  p.ph_lo = 0; p.ph_hi = N_PHASES;
  hipMemsetAsync((char*)d_ws + WS_BAR, 0, XCD_BAR_WORDS * 4, stream);
  void* args[] = {&p};
  hipError_t e = hipLaunchCooperativeKernel((void*)mega, dim3(grid_blocks), dim3(512), args, 0, stream);
  if (e != hipSuccess) fprintf(stderr, "cooperative launch failed: %s (grid %d)\n", hipGetErrorString(e), grid_blocks);
#endif
}
```

```cpp
#include <hip/hip_runtime.h>
#include <hip/hip_cooperative_groups.h>
#include <cstdio>
namespace cg = cooperative_groups;

#ifndef GD
#define GD 3
#endif
#ifndef MK_MULTI
#define MK_MULTI 0
#endif

typedef unsigned short u16;
using bf16x8 = __attribute__((ext_vector_type(8))) short;
using f32x16 = __attribute__((ext_vector_type(16))) float;
#define DI __device__ __forceinline__
#define MFMA(a, b, c) __builtin_amdgcn_mfma_f32_32x32x16_bf16((a), (b), (c), 0, 0, 0)

constexpr int TP = 8192;
constexpr int TT = 24576;
constexpr float EPS = 1e-6f;

constexpr size_t WS_MOD   = 0;
constexpr size_t WS_WIN0  = 131072;
constexpr size_t WS_WOUT0 = WS_WIN0 + (size_t)3584 * 1024 * 2;
constexpr size_t WS_WIN1  = WS_WOUT0 + (size_t)1024 * 1024 * 2;
constexpr size_t WS_WPOOL = WS_WIN1 + (size_t)2048 * 1024 * 2;
constexpr size_t WS_WOUT1 = WS_WPOOL + (size_t)4 * 256 * 256 * 2;
constexpr size_t WS_KC    = WS_WOUT1 + (size_t)1024 * 1024 * 2;
constexpr size_t WS_VTC   = WS_KC + (size_t)4 * 8 * 512 * 64 * 2;
constexpr size_t WS_R0    = WS_VTC + (size_t)4 * 8 * 512 * 64 * 2;
constexpr size_t RSZ      = (size_t)TT * 1024 * 2;
constexpr size_t WS_R1    = WS_R0 + RSZ;
constexpr size_t WS_R2    = WS_R1 + RSZ;
constexpr size_t WS_R3    = WS_R2 + RSZ;
constexpr size_t WS_BAR   = WS_R3 + RSZ;
constexpr size_t WS_UP    = WS_BAR + 16384;
constexpr size_t WS_SS    = WS_UP + (size_t)(24576 + 36 * 32) * 1024;
constexpr size_t WS_SW    = WS_SS + (size_t)TT * 4;
constexpr size_t WS_END   = WS_SW + 5 * 2048 * 4;
constexpr size_t HALF_R   = RSZ / 2;

struct P {
  const float *x_prompt, *x_sample, *cache_k, *cache_v, *c, *c_ctx;
  const float *norm_g0, *w_ada0, *b_ada0, *w_in0, *conv_w, *conv_b, *ln_g, *ln_b, *q_norm, *k_norm, *rpb, *w_out0;
  const float *norm_g1, *w_ada1, *b_ada1, *w_in1, *pool_w, *pool_scale, *w_out1;
  float* out;
  char* ws;
  int ph_lo, ph_hi, flags, pad;
};

typedef __bf16 hbf16x2 __attribute__((ext_vector_type(2)));
typedef float hf32x2 __attribute__((ext_vector_type(2)));
DI unsigned pack2(float a, float b) { hf32x2 v = {a, b}; hbf16x2 r = __builtin_convertvector(v, hbf16x2); return __builtin_bit_cast(unsigned, r); }
DI u16 f2bf(float x) { return (u16)(pack2(x, 0.f) & 0xffffu); }
DI float bf2f(u16 v) { return __uint_as_float(((unsigned)v) << 16); }
DI void swap32v(f32x16& x, f32x16& y) {
#pragma unroll
  for (int i = 0; i < 16; ++i) {
    auto r = __builtin_amdgcn_permlane32_swap(__float_as_uint(x[i]), __float_as_uint(y[i]), false, false);
    x[i] = __uint_as_float(r[0]); y[i] = __uint_as_float(r[1]);
  }
}
DI void swap32(float& x, float& y) {
  auto r = __builtin_amdgcn_permlane32_swap(__float_as_uint(x), __float_as_uint(y), false, false);
  x = __uint_as_float(r[0]); y = __uint_as_float(r[1]);
}
DI float bflo(unsigned v) { return __uint_as_float(v << 16); }
DI float bfhi(unsigned v) { return __uint_as_float(v & 0xffff0000u); }
DI float silu_f(float x) { return x * __builtin_amdgcn_rcpf(1.f + __builtin_amdgcn_exp2f(-1.4426950408889634f * x)); }
DI float sigm_f(float x) { return __builtin_amdgcn_rcpf(1.f + __builtin_amdgcn_exp2f(-1.4426950408889634f * x)); }
DI const float* xrow(const P& p, int t) { return t < TP ? p.x_prompt + (size_t)t * 1024 : p.x_sample + (size_t)(t - TP) * 1024; }
DI int midx(int t) { return t < TP ? 0 : 1 + ((t - TP) >> 12); }
DI int prow(int t) { const int seq = t < TP ? (t >> 8) : 32 + ((t - TP) >> 12); return t + 32 * seq + 16; }

constexpr int P0_ADA = 384, P0_TR = 2240, P0_KC = 256, P0_PAD = 36, P0_SS = 6, P0_ITEMS = P0_ADA + P0_TR + P0_KC + P0_PAD + P0_SS;

DI void p0_item(const P& p, int it, char* smem, int mode = 0) {
  const int tid = (threadIdx.x & 255);
  if (mode == 1 || it < P0_ADA) {
    const int NC = mode ? 8 : 16;
    const int QN = NC >> 2, KL = 256 / QN, NIT = 1024 / KL;
    const int layer = mode ? 0 : it / 192, n0 = mode ? it * 8 : (it % 192) * 16;
    const int ldw = mode ? 2048 : 3072;
    float* sc = (float*)smem;
    float* red = (float*)(smem + 20480);
    for (int e = tid; e < 5120; e += 256) {
      const int j = e >> 10, k = e & 1023;
      if (mode) sc[e] = ((const float*)(p.ws + WS_MOD))[(5 + j) * 3072 + k];
      else { const float v = (j == 0) ? p.c_ctx[k] : p.c[(j - 1) * 1024 + k]; sc[e] = silu_f(v); }
    }
    __syncthreads();
    const float* W = mode ? p.w_in1 : (layer ? p.w_ada1 : p.w_ada0);
    const float* bias = layer ? p.b_ada1 : p.b_ada0;
    const int cq = tid % QN, kl = tid / QN;
    float acc[5][4];
#pragma unroll
    for (int j = 0; j < 5; ++j) { acc[j][0] = acc[j][1] = acc[j][2] = acc[j][3] = 0.f; }
#pragma unroll 8
    for (int i = 0; i < NIT; ++i) {
      const int k = kl + KL * i;
      const float4 w = *(const float4*)(W + (size_t)k * ldw + n0 + 4 * cq);
#pragma unroll
      for (int j = 0; j < 5; ++j) {
        const float s = sc[j * 1024 + k];
        acc[j][0] += s * w.x; acc[j][1] += s * w.y; acc[j][2] += s * w.z; acc[j][3] += s * w.w;
      }
    }
#pragma unroll
    for (int j = 0; j < 5; ++j)
#pragma unroll
      for (int a = 0; a < 4; ++a) red[((kl * QN + cq) * 5 + j) * 4 + a] = acc[j][a];
    __syncthreads();
    if (tid < 5 * NC) {
      const int j = tid / NC, col = tid % NC;
      float s = mode ? 0.f : bias[n0 + col];
      for (int k2 = 0; k2 < KL; ++k2) s += red[((k2 * QN + (col >> 2)) * 5 + j) * 4 + (col & 3)];
      if (mode) ((float*)(p.ws + WS_SW))[j * 2048 + n0 + col] = s;
      else ((float*)(p.ws + WS_MOD))[(layer * 5 + j) * 3072 + n0 + col] = s;
    }
  } else if (it < P0_ADA + P0_TR) {
    int j = it - P0_ADA;
    const float* src; u16* dst; int sstride, dstride, r0, n0, dk0 = -1; bool perm = false;
    if (j < 896) { src = p.w_in0; sstride = 3584; r0 = (j / 56) * 64; n0 = (j % 56) * 64; dst = (u16*)(p.ws + WS_WIN0); dstride = 1024; perm = true; }
    else if (j < 1152) { j -= 896; src = p.w_out0; sstride = 1024; r0 = (j / 16) * 64; n0 = (j % 16) * 64; dst = (u16*)(p.ws + WS_WOUT0); dstride = 1024; }
    else if (j < 1664) { j -= 1152; src = p.w_in1; sstride = 2048; r0 = (j / 32) * 64; n0 = (j % 32) * 64; dst = (u16*)(p.ws + WS_WIN1); dstride = 1024; }
    else if (j < 1728) { j -= 1664; const int g = j >> 4; src = p.pool_w + g * 65536; sstride = 256; r0 = ((j & 15) >> 2) * 64; n0 = (j & 3) * 64; dst = (u16*)(p.ws + WS_WPOOL) + g * 65536; dstride = 256; }
    else if (j < 1984) { j -= 1728; src = p.w_out1; sstride = 1024; r0 = (j / 16) * 64; n0 = (j % 16) * 64; dst = (u16*)(p.ws + WS_WOUT1); dstride = 1024; }
    else { j -= 1984; const int bh = j >> 3, mt = j & 7; src = p.cache_v + (size_t)(bh >> 3) * 512 * 512 + (bh & 7) * 64; sstride = 512; r0 = mt * 64; n0 = 0; dst = (u16*)(p.ws + WS_VTC) + ((size_t)bh * 8 + mt) * 4096; dstride = 64; dk0 = 0; }
    float* tile = (float*)smem;
    {
      const int r = tid >> 4, c4 = (tid & 15) * 4;
      int nn = n0 + c4;
      if (perm && nn < 1024) { const int w = nn >> 6, rr = nn & 63; nn = (rr < 32) ? (32 * w + rr) : (512 + 32 * w + rr - 32); }
#pragma unroll
      for (int i = 0; i < 4; ++i) {
        const float4 v = *(const float4*)(src + (size_t)(r0 + r + 16 * i) * sstride + nn);
        *(float4*)(tile + (r + 16 * i) * 68 + c4) = v;
      }
    }
    __syncthreads();
    {
      const int n = tid >> 2, kseg = (tid & 3) * 16;
      unsigned pk[8];
#pragma unroll
      for (int j = 0; j < 8; ++j) pk[j] = pack2(tile[(kseg + 2 * j) * 68 + n], tile[(kseg + 2 * j + 1) * 68 + n]);
      u16* d = dst + (size_t)(n0 + n) * dstride + (dk0 < 0 ? r0 : dk0) + kseg;
      *(uint4*)d = make_uint4(pk[0], pk[1], pk[2], pk[3]);
      *(uint4*)(d + 8) = make_uint4(pk[4], pk[5], pk[6], pk[7]);
    }
  } else if (it >= P0_ADA + P0_TR + P0_KC + P0_PAD) {
    float* ss = (float*)(p.ws + WS_SS) + (it - P0_ADA - P0_TR - P0_KC - P0_PAD) * 4096;
#pragma unroll
    for (int i = 0; i < 4; ++i) *(float4*)(ss + (i * 256 + tid) * 4) = make_float4(0.f, 0.f, 0.f, 0.f);
  } else if (it >= P0_ADA + P0_TR + P0_KC) {
    const int sq = it - P0_ADA - P0_TR - P0_KC;
    const int st = sq < 32 ? sq * 256 : TP + (sq - 32) * 4096, en = st + (sq < 32 ? 256 : 4096);
    char* up = p.ws + WS_UP;
    const uint4 z = make_uint4(0u, 0u, 0u, 0u);
#pragma unroll
    for (int i = 0; i < 4; ++i) {
      *(uint4*)(up + (size_t)(st + 32 * sq) * 1024 + (i * 256 + tid) * 16) = z;
      *(uint4*)(up + (size_t)(en + 32 * sq + 16) * 1024 + (i * 256 + tid) * 16) = z;
    }
  } else {
    const int it2 = it - P0_ADA - P0_TR;
    u16* kc = (u16*)(p.ws + WS_KC);
#pragma unroll
    for (int e = 0; e < 4; ++e) {
      const int o = it2 * 4096 + (e * 256 + tid) * 4;
      const int d = o & 63, m = (o >> 6) & 511, bh = o >> 15;
      const float4 v = *(const float4*)(p.cache_k + (((size_t)(bh >> 3) * 512 + m) * 8 + (bh & 7)) * 64 + d);
      uint2 w; w.x = pack2(v.x, v.y); w.y = pack2(v.z, v.w);
      *(uint2*)(kc + o) = w;
    }
  }
}

DI void modnorm_item(const P& p, int it, int layer) {
  const int tid = (threadIdx.x & 255), lane = tid & 63, wave = tid >> 6;
  const int row0 = it * 16 + wave * 4;
  const float* g = layer ? p.norm_g1 : p.norm_g0;
  const float* mod = (const float*)(p.ws + WS_MOD) + (size_t)(layer * 5 + midx(row0)) * 3072;
  u16* H = (u16*)(p.ws + WS_R0);
  float4 a[4], b[4];
#pragma unroll
  for (int j = 0; j < 4; ++j) {
    const int col = j * 256 + lane * 4;
    const float4 gv = *(const float4*)(g + col);
    const float4 sh = *(const float4*)(mod + col);
    const float4 sv = *(const float4*)(mod + 1024 + col);
    a[j] = make_float4(gv.x * (1.f + sv.x), gv.y * (1.f + sv.y), gv.z * (1.f + sv.z), gv.w * (1.f + sv.w));
    b[j] = sh;
  }
#pragma unroll
  for (int r = 0; r < 4; ++r) {
    const int row = row0 + r;
    const float* xr = layer ? (p.out + (size_t)row * 1024) : xrow(p, row);
    float4 v[4];
    float ss = 0.f;
#pragma unroll
    for (int j = 0; j < 4; ++j) {
      v[j] = *(const float4*)(xr + j * 256 + lane * 4);
      ss += v[j].x * v[j].x + v[j].y * v[j].y + v[j].z * v[j].z + v[j].w * v[j].w;
    }
#pragma unroll
    for (int o = 32; o >= 1; o >>= 1) ss += __shfl_xor(ss, o);
    const float rinv = rsqrtf(ss * (1.f / 1024.f) + EPS);
#pragma unroll
    for (int j = 0; j < 4; ++j) {
      uint2 o2;
      o2.x = pack2(v[j].x * rinv * a[j].x + b[j].x, v[j].y * rinv * a[j].y + b[j].y);
      o2.y = pack2(v[j].z * rinv * a[j].z + b[j].z, v[j].w * rinv * a[j].w + b[j].w);
      *(uint2*)(H + (size_t)row * 1024 + j * 256 + lane * 4) = o2;
    }
  }
}

DI int crow(int i, int hh) { return (i & 3) + 8 * (i >> 2) + 4 * hh; }

constexpr int LROW = 144;
constexpr int GSTAGE = 512 * LROW;
constexpr int SMEM_BYTES = 2 * GSTAGE;
constexpr int HALF_SMEM = GSTAGE;

template <int NK, int CFG>
DI void gemm_mainloop(const u16* Ag, int lda, const u16* Bg, int ldb, char* smem, f32x16 (&acc)[CFG == 0 ? 4 : 2][CFG == 2 ? 3 : 2]) {
  constexpr int MI = CFG == 0 ? 4 : 2;
  constexpr int NJ = CFG == 2 ? 3 : 2;
  int tid = threadIdx.x;
  asm volatile("" : "+v"(tid));
  const int lane = tid & 63, wave = tid >> 6;
  const int wm = CFG == 0 ? (wave >> 2) : (wave >> 1);
  const int wn = CFG == 0 ? (wave & 3) : (wave & 1);
  const int srow = tid >> 3, scol = tid & 7;
  const u16* ag = Ag + (size_t)srow * lda + scol * 8;
  const u16* bg = Bg + (size_t)srow * ldb + scol * 8;
  uint4 r0a0, r0a1, r0a2, r0a3, r0b0, r0b1, r0b2, r0b3, r1a0, r1a1, r1a2, r1a3, r1b0, r1b1, r1b2, r1b3;
#define G_LOAD(R, ko_) do { \
    R##a0 = *(const uint4*)(ag + (ko_)); R##a1 = *(const uint4*)(ag + (size_t)64 * lda + (ko_)); \
    R##a2 = *(const uint4*)(ag + (size_t)128 * lda + (ko_)); R##a3 = *(const uint4*)(ag + (size_t)192 * lda + (ko_)); \
    R##b0 = *(const uint4*)(bg + (ko_)); R##b1 = *(const uint4*)(bg + (size_t)64 * ldb + (ko_)); \
    if (CFG != 1) R##b2 = *(const uint4*)(bg + (size_t)128 * ldb + (ko_)); \
    if (CFG == 0) R##b3 = *(const uint4*)(bg + (size_t)192 * ldb + (ko_)); } while (0)
#define G_STORE(R, base_) do { char* b_ = (base_) + wofs; \
    *(uint4*)(b_) = R##a0; *(uint4*)(b_ + 64 * LROW) = R##a1; *(uint4*)(b_ + 128 * LROW) = R##a2; *(uint4*)(b_ + 192 * LROW) = R##a3; \
    *(uint4*)(b_ + 256 * LROW) = R##b0; *(uint4*)(b_ + 320 * LROW) = R##b1; \
    if (CFG != 1) *(uint4*)(b_ + 384 * LROW) = R##b2; \
    if (CFG == 0) *(uint4*)(b_ + 448 * LROW) = R##b3; } while (0)
  const int wofs = srow * LROW + scol * 16;
  const int aofs = (wm * (MI * 32) + (lane & 31)) * LROW + (lane >> 5) * 16;
  const int bofs = 256 * LROW + (wn * (NJ * 32) + (lane & 31)) * LROW + (lane >> 5) * 16;
  bf16x8 fa[2][MI], fb[2][NJ];
#define LOADF(buf_, ks_) do { \
    _Pragma("unroll") \
    for (int nj_ = 0; nj_ < NJ; ++nj_) fb[buf_][nj_] = *(const bf16x8*)(cur + bofs + nj_ * 32 * LROW + (ks_) * 32); \
    _Pragma("unroll") \
    for (int mi_ = 0; mi_ < MI; ++mi_) fa[buf_][mi_] = *(const bf16x8*)(cur + aofs + mi_ * 32 * LROW + (ks_) * 32); } while (0)
#define G_STEP(R, kt_, AH_) do { \
    constexpr int kt__ = (kt_); \
    if (kt__ < NK) { \
      const char* cur = smem + (kt__ & 1) * GSTAGE; \
      __syncthreads(); \
      if (kt__ + 1 < NK) G_STORE(R, smem + ((kt__ + 1) & 1) * GSTAGE); \
      if (kt__ + (AH_) < NK) G_LOAD(R, (kt__ + (AH_)) * 64); \
      __builtin_amdgcn_sched_barrier(0); \
      LOADF(0, 0); \
      _Pragma("unroll") \
      for (int ks = 0; ks < 4; ++ks) { \
        if (ks < 3) LOADF((ks + 1) & 1, ks + 1); \
        __builtin_amdgcn_s_setprio(1); \
        _Pragma("unroll") \
        for (int mi = 0; mi < MI; ++mi) { \
          _Pragma("unroll") \
          for (int nj = 0; nj < NJ; ++nj) acc[mi][nj] = MFMA(fa[ks & 1][mi], fb[ks & 1][nj], acc[mi][nj]); \
        } \
        __builtin_amdgcn_s_setprio(0); \
      } \
      __builtin_amdgcn_sched_barrier(0); \
    } \
  } while (0)
  static_assert(NK >= 4 && NK <= 16, "K tiles");
  G_LOAD(r0, 0);
  G_STORE(r0, smem);
  G_LOAD(r0, 64);
  if (CFG != 1) {
    G_STEP(r0, 0, 2);  G_STEP(r0, 1, 2);  G_STEP(r0, 2, 2);  G_STEP(r0, 3, 2);
    G_STEP(r0, 4, 2);  G_STEP(r0, 5, 2);  G_STEP(r0, 6, 2);  G_STEP(r0, 7, 2);
    G_STEP(r0, 8, 2);  G_STEP(r0, 9, 2);  G_STEP(r0, 10, 2); G_STEP(r0, 11, 2);
    G_STEP(r0, 12, 2); G_STEP(r0, 13, 2); G_STEP(r0, 14, 2); G_STEP(r0, 15, 2);
  } else {
    G_LOAD(r1, 128);
    G_STEP(r0, 0, 3);  G_STEP(r1, 1, 3);  G_STEP(r0, 2, 3);  G_STEP(r1, 3, 3);
    G_STEP(r0, 4, 3);  G_STEP(r1, 5, 3);  G_STEP(r0, 6, 3);  G_STEP(r1, 7, 3);
    G_STEP(r0, 8, 3);  G_STEP(r1, 9, 3);  G_STEP(r0, 10, 3); G_STEP(r1, 11, 3);
    G_STEP(r0, 12, 3); G_STEP(r1, 13, 3); G_STEP(r0, 14, 3); G_STEP(r1, 15, 3);
  }
}

DI void tile_remap(int item, int FG, int NFG, int& ft, int& tt) {
  const int G = gridDim.x;
  if (G & 7) { const int NF = FG * NFG; ft = item % NF; tt = item / NF; return; }
  const int b = item % G, k = item / G;
  const int xcd = b & 7, q = (b >> 3) + k * (G >> 3);
  const int S = FG * 8;
  const int sq = q / S, r = q - sq * S;
  const int sidx = sq * 8 + xcd;
  const int ftg = sidx % NFG, ttg = sidx / NFG;
  ft = ftg * FG + r % FG;
  tt = ttg * 8 + r / FG;
}

DI void kv_rows_out(float* wbuf, int lane, float* gbase  , int tok0) {
#pragma unroll
  for (int i = 0; i < 8; ++i) {
    const int row = 4 * i + (lane >> 4), col = (lane & 15) * 4;
    const float4 v = *(const float4*)(wbuf + row * 68 + col);
    if (tok0 + row < TP) *(float4*)(gbase + (size_t)row * 512 + col) = v;
  }
}

template <int EPI>
DI void gemm_item(const P& p, int item, char* smem) {
  constexpr int CFG = (EPI == 1) ? 2 : (EPI == 3) ? 0 : 1;
  constexpr int MI = CFG == 0 ? 4 : 2;
  constexpr int NJ = CFG == 2 ? 3 : 2;
  constexpr int TNT = CFG == 0 ? 256 : (CFG == 2 ? 192 : 128);
  int tid = threadIdx.x;
  asm volatile("" : "+v"(tid));
  const int lane = tid & 63, wave = tid >> 6, l31 = lane & 31, hh = lane >> 5;
  const int wm = CFG == 0 ? (wave >> 2) : (wave >> 1);
  const int wn = CFG == 0 ? (wave & 3) : (wave & 1);
  const u16 *A, *B; int lda, ldb, f0, t0, grp = 0;
  if (EPI == 1) { int ft, tt; tile_remap(item, 7, 2, ft, tt); f0 = ft * 256; t0 = tt * TNT; A = (const u16*)(p.ws + WS_WIN0) + (size_t)f0 * 1024; lda = 1024; B = (const u16*)(p.ws + WS_R0) + (size_t)t0 * 1024; ldb = 1024; }
  else if (EPI == 2) { int ft, tt; tile_remap(item, 4, 1, ft, tt); f0 = ft * 256; t0 = tt * TNT; A = (const u16*)(p.ws + WS_WOUT0) + (size_t)f0 * 1024; lda = 1024; B = (const u16*)(p.ws + WS_R0) + (size_t)t0 * 1024; ldb = 1024; }
  else if (EPI == 3) { int ft, tt; tile_remap(item, 4, 2, ft, tt); f0 = ft * 256; t0 = tt * TNT; A = (const u16*)(p.ws + WS_WIN1) + (size_t)f0 * 1024; lda = 1024; B = (const u16*)(p.ws + WS_R1) + (size_t)t0 * 1024; ldb = 1024; }
  else if (EPI == 4) { grp = item & 3; const int tt = item >> 2; f0 = 0; t0 = tt * TNT; A = (const u16*)(p.ws + WS_WPOOL) + grp * 65536; lda = 256; B = (const u16*)(p.ws + WS_R3) + (size_t)t0 * 1024 + grp * 256; ldb = 1024; }
  else { int ft, tt; tile_remap(item, 4, 1, ft, tt); f0 = ft * 256; t0 = tt * TNT; A = (const u16*)(p.ws + WS_WOUT1) + (size_t)f0 * 1024; lda = 1024; B = (const u16*)(p.ws + WS_R0) + (size_t)t0 * 1024; ldb = 1024; }

  f32x16 acc[MI][NJ];
#pragma unroll
  for (int a = 0; a < MI; ++a)
#pragma unroll
    for (int b = 0; b < NJ; ++b)
#pragma unroll
      for (int i = 0; i < 16; ++i) acc[a][b][i] = 0.f;
  if (EPI == 4 && t0 >= TP) {
    const int w = 2 << grp, hw = w >> 1;
    const int s0 = TP + ((t0 - TP) & ~4095), s1 = s0 + 4096;
    int rfix0, nfix;
    if ((t0 & 255) == 0) { rfix0 = t0; nfix = (t0 != s0) ? hw : 0; }
    else { nfix = (t0 + 128 != s1) ? (w - hw - 1) : 0; rfix0 = t0 + 128 - nfix; }
    const int rr = tid >> 6, cc = grp * 256 + (tid & 63) * 4;
    if (rr < nfix) {
      const u16* U1 = (const u16*)(p.ws + WS_R0);
      const int t = rfix0 + rr;
      const int lo = max(t - hw, s0), hi = min(t + w - hw, s1);
      float a0 = 0.f, a1 = 0.f, a2 = 0.f, a3 = 0.f;
      for (int tt = lo; tt < hi; ++tt) {
        const uint2 v = *(const uint2*)(U1 + (size_t)tt * 1024 + cc);
        a0 += bflo(v.x); a1 += bfhi(v.x); a2 += bflo(v.y); a3 += bfhi(v.y);
      }
      const uint2 cv = *(const uint2*)(U1 + (size_t)t * 1024 + cc);
      const float rc = 1.f / (float)(hi - lo);
      uint2 o; o.x = pack2(a0 * rc - bflo(cv.x), a1 * rc - bfhi(cv.x)); o.y = pack2(a2 * rc - bflo(cv.y), a3 * rc - bfhi(cv.y));
      *(uint2*)((u16*)(p.ws + WS_R3) + (size_t)t * 1024 + cc) = o;
    }
    asm volatile("s_waitcnt vmcnt(0)" ::: "memory");
    __syncthreads();
  }
  if (EPI == 4) gemm_mainloop<4, CFG>(A, lda, B, ldb, smem, acc); else gemm_mainloop<16, CFG>(A, lda, B, ldb, smem, acc);

  if (EPI == 2 || EPI == 4 || EPI == 5) {
    constexpr int SP = 260;
    float* st = (float*)smem;
    __syncthreads();
#pragma unroll
    for (int nj = 0; nj < 2; ++nj) {
      const int tokl = wn * 64 + nj * 32 + l31;
#pragma unroll
      for (int mi = 0; mi < 2; ++mi)
#pragma unroll
        for (int g = 0; g < 4; ++g)
          *(float4*)(st + tokl * SP + wm * 64 + mi * 32 + 8 * g + 4 * hh) = make_float4(acc[mi][nj][4 * g], acc[mi][nj][4 * g + 1], acc[mi][nj][4 * g + 2], acc[mi][nj][4 * g + 3]);
    }
    __syncthreads();
    const int col = lane * 4;
    if (EPI == 4) {
      const u16* SG1 = (const u16*)(p.ws + WS_R2);
      u16* Z1 = (u16*)(p.ws + WS_R0);
      const float4 sc = *(const float4*)(p.pool_scale + grp * 256 + col);
#pragma unroll 4
      for (int r = 0; r < 16; ++r) {
        const int tokl = wave * 16 + r, tok = t0 + tokl;
        const float4 a = *(const float4*)(st + tokl * SP + col);
        const uint2 sg = *(const uint2*)(SG1 + (size_t)tok * 1024 + grp * 256 + col);
        uint2 o;
        o.x = pack2(a.x * sc.x * bflo(sg.x), a.y * sc.y * bfhi(sg.x));
        o.y = pack2(a.z * sc.z * bflo(sg.y), a.w * sc.w * bfhi(sg.y));
        *(uint2*)(Z1 + (size_t)tok * 1024 + grp * 256 + col) = o;
      }
    } else {
      const int layer = (EPI == 2) ? 0 : 1;
      const float4 gv = *(const float4*)((const float*)(p.ws + WS_MOD) + (size_t)(layer * 5 + midx(t0)) * 3072 + 2048 + f0 + col);
      float4 a1 = make_float4(0.f, 0.f, 0.f, 0.f);
      if (EPI == 2) {
        const float4 g1 = *(const float4*)(p.norm_g1 + f0 + col);
        const float4 sc1 = *(const float4*)((const float*)(p.ws + WS_MOD) + (size_t)(5 + midx(t0)) * 3072 + 1024 + f0 + col);
        a1 = make_float4(g1.x * (1.f + sc1.x), g1.y * (1.f + sc1.y), g1.z * (1.f + sc1.z), g1.w * (1.f + sc1.w));
      }
      float ssq[16];
#pragma unroll
      for (int r = 0; r < 16; ++r) {
        const int tokl = wave * 16 + r, tok = t0 + tokl;
        const float4 a = *(const float4*)(st + tokl * SP + col);
        const float* xr = ((EPI == 2) ? xrow(p, tok) : (p.out + (size_t)tok * 1024)) + f0 + col;
        const float4 xv = *(const float4*)xr;
        float4 o;
        o.x = xv.x + gv.x * a.x; o.y = xv.y + gv.y * a.y; o.z = xv.z + gv.z * a.z; o.w = xv.w + gv.w * a.w;
        *(float4*)(p.out + (size_t)tok * 1024 + f0 + col) = o;
        if (EPI == 2) {
          uint2 ya; ya.x = pack2(o.x * a1.x, o.y * a1.y); ya.y = pack2(o.z * a1.z, o.w * a1.w);
          *(uint2*)((u16*)(p.ws + WS_R1) + (size_t)tok * 1024 + f0 + col) = ya;
          ssq[r] = o.x * o.x + o.y * o.y + o.z * o.z + o.w * o.w;
        }
      }
      if (EPI == 2) {
#pragma unroll
        for (int half = 8, bit = 32; half >= 1; half >>= 1, bit >>= 1) {
          const bool up = (lane & bit) != 0;
#pragma unroll
          for (int k = 0; k < half; ++k) {
            const float keep = up ? ssq[k + half] : ssq[k];
            const float send = up ? ssq[k] : ssq[k + half];
            ssq[k] = keep + __shfl_xor(send, bit);
          }
        }
        ssq[0] += __shfl_xor(ssq[0], 2);
        ssq[0] += __shfl_xor(ssq[0], 1);
        if ((lane & 3) == 0) atomicAdd((float*)(p.ws + WS_SS) + t0 + wave * 16 + (lane >> 2), ssq[0]);
      }
    }
    return;
  }
  const int tokb = t0 + wn * (NJ * 32);
  if (EPI == 3) __syncthreads();
  if (EPI == 1 && t0 < TP && f0 >= 2048 && f0 < 3072) __syncthreads();
#pragma unroll
  for (int fblk = 0; fblk < MI / 2; ++fblk) {
  const int fb = f0 + wm * (MI * 32) + fblk * 64;
  if (EPI == 1) {
    u16* U = (u16*)(p.ws + WS_UP);
    u16* SGA = (u16*)(p.ws + WS_R1 + HALF_R);
    u16* Q = (u16*)(p.ws + WS_R2);
    u16* Kb = (u16*)(p.ws + WS_R2 + HALF_R);
    u16* VT = (u16*)(p.ws + WS_R3);
    u16* SGB = (u16*)(p.ws + WS_R3 + HALF_R);
#pragma unroll
    for (int nj = 0; nj < NJ; ++nj) {
      const int tok = tokb + nj * 32 + l31;
      const bool kvst = (tokb + nj * 32 < TP);
      float* wbuf = (float*)smem + wave * (32 * 68);
      f32x16& X = acc[2 * fblk][nj];
      f32x16& Y = acc[2 * fblk + 1][nj];
      if (fb < 1024) {
        const int cb = (fb >> 6) * 32;
        float u[16];
#pragma unroll
        for (int i = 0; i < 16; ++i) u[i] = X[i] * sigm_f(Y[i]);
#pragma unroll
        for (int i = 0; i < 8; ++i) swap32(u[i], u[i + 8]);
#pragma unroll
        for (int gg = 0; gg < 2; ++gg) {
          uint4 o;
          o.x = pack2(u[4 * gg], u[4 * gg + 1]); o.y = pack2(u[4 * gg + 2], u[4 * gg + 3]);
          o.z = pack2(u[8 + 4 * gg], u[8 + 4 * gg + 1]); o.w = pack2(u[8 + 4 * gg + 2], u[8 + 4 * gg + 3]);
          *(uint4*)(U + (size_t)prow(tok) * 512 + cb + 16 * hh + 8 * gg) = o;
        }
      } else if (fb < 1536 || fb >= 3072) {
        u16* dst = (fb < 1536) ? (SGA + (size_t)tok * 512 + (fb - 1024)) : (SGB + (size_t)tok * 512 + (fb - 3072));
#pragma unroll
        for (int i = 0; i < 16; ++i) { X[i] = silu_f(X[i]); Y[i] = silu_f(Y[i]); }
        swap32v(X, Y);
#pragma unroll
        for (int g = 0; g < 4; ++g) {
          uint4 o;
          o.x = pack2(X[4 * g], X[4 * g + 1]); o.y = pack2(X[4 * g + 2], X[4 * g + 3]);
          o.z = pack2(Y[4 * g], Y[4 * g + 1]); o.w = pack2(Y[4 * g + 2], Y[4 * g + 3]);
          *(uint4*)(dst + 32 * hh + 8 * g) = o;
        }
      } else if (fb < 2560) {
        const bool isq = fb < 2048;
        const int hc = isq ? (fb - 1536) : (fb - 2048);
        float ss = 0.f;
#pragma unroll
        for (int i = 0; i < 16; ++i) ss += X[i] * X[i] + Y[i] * Y[i];
        ss += __shfl_xor(ss, 32);
        const float rinv = rsqrtf(ss * (1.f / 64.f) + EPS);
        swap32v(X, Y);
        const float* nw = (isq ? p.q_norm : p.k_norm) + 32 * hh;
        const float qs = isq ? (0.125f * 1.4426950408889634f) : 1.f;
        u16* dst = isq ? (Q + (size_t)tok * 512 + hc + 32 * hh) : (Kb + ((size_t)(hc >> 6) * TT + tok) * 64 + 32 * hh);
        float* kout = p.out + (size_t)TT * 1024 + (size_t)tok * 512 + hc + 32 * hh;
#pragma unroll
        for (int g = 0; g < 4; ++g) {
          const float4 w0 = *(const float4*)(nw + 8 * g);
          const float4 w1 = *(const float4*)(nw + 8 * g + 4);
          float4 v0, v1;
          v0.x = X[4 * g] * rinv * w0.x; v0.y = X[4 * g + 1] * rinv * w0.y; v0.z = X[4 * g + 2] * rinv * w0.z; v0.w = X[4 * g + 3] * rinv * w0.w;
          v1.x = Y[4 * g] * rinv * w1.x; v1.y = Y[4 * g + 1] * rinv * w1.y; v1.z = Y[4 * g + 2] * rinv * w1.z; v1.w = Y[4 * g + 3] * rinv * w1.w;
          if (!isq && kvst) { *(float4*)(wbuf + l31 * 68 + 32 * hh + 8 * g) = v0; *(float4*)(wbuf + l31 * 68 + 32 * hh + 8 * g + 4) = v1; }
          uint4 o;
          o.x = pack2(v0.x * qs, v0.y * qs); o.y = pack2(v0.z * qs, v0.w * qs);
          o.z = pack2(v1.x * qs, v1.y * qs); o.w = pack2(v1.z * qs, v1.w * qs);
          *(uint4*)(dst + 8 * g) = o;
        }
        if (!isq && kvst) kv_rows_out(wbuf, lane, p.out + (size_t)TT * 1024 + (size_t)(tokb + nj * 32) * 512 + hc, tokb + nj * 32);
      } else {
        const int hc = fb - 2560;
#pragma unroll
        for (int mi = 0; mi < 2; ++mi)
#pragma unroll
          for (int i = 0; i < 16; ++i) VT[(((size_t)(hc >> 6) * (TT / 64) + (tok >> 6)) * 64 + mi * 32 + crow(i, hh)) * 64 + (tok & 63)] = f2bf(acc[2 * fblk + mi][nj][i]);
        if (kvst) {
          swap32v(X, Y);
#pragma unroll
          for (int g = 0; g < 4; ++g) {
            *(float4*)(wbuf + l31 * 68 + 32 * hh + 8 * g) = make_float4(X[4 * g], X[4 * g + 1], X[4 * g + 2], X[4 * g + 3]);
            *(float4*)(wbuf + l31 * 68 + 32 * hh + 8 * g + 4) = make_float4(Y[4 * g], Y[4 * g + 1], Y[4 * g + 2], Y[4 * g + 3]);
          }
          kv_rows_out(wbuf, lane, p.out + (size_t)TT * 1024 + (size_t)TP * 512 + (size_t)(tokb + nj * 32) * 512 + hc, tokb + nj * 32);
        }
      }
    }
  } else if (EPI == 2 || EPI == 5) {
    const int layer = (EPI == 2) ? 0 : 1;
#pragma unroll
    for (int nj = 0; nj < 2; ++nj) {
      const int tok = tokb + nj * 32 + l31;
      f32x16& X = acc[2 * fblk][nj];
      f32x16& Y = acc[2 * fblk + 1][nj];
      swap32v(X, Y);
      const int colb = fb + 32 * hh;
      const float* gate = (const float*)(p.ws + WS_MOD) + (size_t)(layer * 5 + midx(tok)) * 3072 + 2048 + colb;
      const float* xr = ((EPI == 2) ? xrow(p, tok) : (p.out + (size_t)tok * 1024)) + colb;
      float* yr = p.out + (size_t)tok * 1024 + colb;
#pragma unroll
      for (int g = 0; g < 4; ++g) {
        const float4 x0 = *(const float4*)(xr + 8 * g), x1 = *(const float4*)(xr + 8 * g + 4);
        const float4 g0 = *(const float4*)(gate + 8 * g), g1 = *(const float4*)(gate + 8 * g + 4);
        float4 o0, o1;
        o0.x = x0.x + g0.x * X[4 * g]; o0.y = x0.y + g0.y * X[4 * g + 1]; o0.z = x0.z + g0.z * X[4 * g + 2]; o0.w = x0.w + g0.w * X[4 * g + 3];
        o1.x = x1.x + g1.x * Y[4 * g]; o1.y = x1.y + g1.y * Y[4 * g + 1]; o1.z = x1.z + g1.z * Y[4 * g + 2]; o1.w = x1.w + g1.w * Y[4 * g + 3];
        *(float4*)(yr + 8 * g) = o0; *(float4*)(yr + 8 * g + 4) = o1;
      }
    }
  } else if (EPI == 3) {
    u16* U1 = (u16*)(p.ws + WS_R0);
    u16* SG1 = (u16*)(p.ws + WS_R2);
#pragma unroll
    for (int nj = 0; nj < 2; ++nj) {
      const int tok = tokb + nj * 32 + l31;
      f32x16& X = acc[2 * fblk][nj];
      f32x16& Y = acc[2 * fblk + 1][nj];
      swap32v(X, Y);
      {
        const float rinv = rsqrtf(((const float*)(p.ws + WS_SS))[tok] * (1.f / 1024.f) + EPS);
        const float* sw = (const float*)(p.ws + WS_SW) + midx(tok) * 2048 + fb + 32 * hh;
#pragma unroll
        for (int g = 0; g < 4; ++g) {
          const float4 s0 = *(const float4*)(sw + 8 * g), s1 = *(const float4*)(sw + 8 * g + 4);
          X[4 * g] = X[4 * g] * rinv + s0.x; X[4 * g + 1] = X[4 * g + 1] * rinv + s0.y; X[4 * g + 2] = X[4 * g + 2] * rinv + s0.z; X[4 * g + 3] = X[4 * g + 3] * rinv + s0.w;
          Y[4 * g] = Y[4 * g] * rinv + s1.x; Y[4 * g + 1] = Y[4 * g + 1] * rinv + s1.y; Y[4 * g + 2] = Y[4 * g + 2] * rinv + s1.z; Y[4 * g + 3] = Y[4 * g + 3] * rinv + s1.w;
        }
      }
      if (fb >= 1024) {
#pragma unroll
        for (int i = 0; i < 16; ++i) { X[i] = silu_f(X[i]); Y[i] = silu_f(Y[i]); }
      }
      char* dst = smem + (wn * 64 + nj * 32 + l31) * 528 + (fb - f0 + 32 * hh) * 2;
#pragma unroll
      for (int g = 0; g < 4; ++g) {
        uint4 o;
        o.x = pack2(X[4 * g], X[4 * g + 1]); o.y = pack2(X[4 * g + 2], X[4 * g + 3]);
        o.z = pack2(Y[4 * g], Y[4 * g + 1]); o.w = pack2(Y[4 * g + 2], Y[4 * g + 3]);
        *(uint4*)(dst + 16 * g) = o;
      }
    }
  } else {
    const u16* SG1 = (const u16*)(p.ws + WS_R2);
    u16* Z1 = (u16*)(p.ws + WS_R0);
#pragma unroll
    for (int nj = 0; nj < 2; ++nj) {
      const int tok = tokb + nj * 32 + l31;
      f32x16& X = acc[2 * fblk][nj];
      f32x16& Y = acc[2 * fblk + 1][nj];
      swap32v(X, Y);
      const int colb = grp * 256 + fb + 32 * hh;
#pragma unroll
      for (int g = 0; g < 4; ++g) {
        const float4 s0 = *(const float4*)(p.pool_scale + colb + 8 * g), s1 = *(const float4*)(p.pool_scale + colb + 8 * g + 4);
        const uint4 sg = *(const uint4*)(SG1 + (size_t)tok * 1024 + colb + 8 * g);
        uint4 o;
        o.x = pack2(X[4 * g] * s0.x * bflo(sg.x), X[4 * g + 1] * s0.y * bfhi(sg.x));
        o.y = pack2(X[4 * g + 2] * s0.z * bflo(sg.y), X[4 * g + 3] * s0.w * bfhi(sg.y));
        o.z = pack2(Y[4 * g] * s1.x * bflo(sg.z), Y[4 * g + 1] * s1.y * bfhi(sg.z));
        o.w = pack2(Y[4 * g + 2] * s1.z * bflo(sg.w), Y[4 * g + 3] * s1.w * bfhi(sg.w));
        *(uint4*)(Z1 + (size_t)tok * 1024 + colb + 8 * g) = o;
      }
    }
  }
  }
  if (EPI == 3) {
    __syncthreads();
    u16* dstg = (f0 < 1024) ? ((u16*)(p.ws + WS_R0) + f0) : ((u16*)(p.ws + WS_R2) + f0 - 1024);
#pragma unroll 4
    for (int i = 0; i < 16; ++i) {
      const int row = wave * 32 + 2 * i + (lane >> 5), ch = lane & 31;
      const uint4 v = *(const uint4*)(smem + row * 528 + ch * 16);
      *(uint4*)(dstg + (size_t)(t0 + row) * 1024 + ch * 8) = v;
    }
    if (f0 < 1024) {
      const int w = 2 << (f0 >> 8), hw = w >> 1;
      int seqlo = 0, seqhi = 256;
      if (t0 >= TP) { const int s0 = TP + ((t0 - TP) & ~4095); seqlo = s0 - t0; seqhi = s0 + 4096 - t0; }
      const int lo_ok = max(seqlo, 0), hi_ok = min(seqhi, 256);
      const int ch = lane & 31, rb = wave * 32 + (lane >> 5) * 16;
      u16* Dd = (u16*)(p.ws + WS_R3);
      float sm[8];
#pragma unroll
      for (int k = 0; k < 8; ++k) sm[k] = 0.f;
#define EP_ACC(v_, m_) do { \
      sm[0] += (m_) * bflo((v_).x); sm[1] += (m_) * bfhi((v_).x); sm[2] += (m_) * bflo((v_).y); sm[3] += (m_) * bfhi((v_).y); \
      sm[4] += (m_) * bflo((v_).z); sm[5] += (m_) * bfhi((v_).z); sm[6] += (m_) * bflo((v_).w); sm[7] += (m_) * bfhi((v_).w); } while (0)
#pragma unroll
      for (int j = 0; j < 15; ++j) {
        const int t = rb - hw + j;
        const uint4 v = *(const uint4*)(smem + min(max(t, 0), 255) * 528 + ch * 16);
        const float mk = (j < w - 1 && t >= lo_ok && t < hi_ok) ? 1.f : 0.f;
        EP_ACC(v, mk);
      }
#pragma unroll 4
      for (int i = 0; i < 16; ++i) {
        const int r = rb + i;
        const int ta = r + w - hw - 1, tr = r - hw - 1;
        const uint4 va = *(const uint4*)(smem + min(ta, 255) * 528 + ch * 16);
        const uint4 vr = *(const uint4*)(smem + max(tr, 0) * 528 + ch * 16);
        const uint4 cv = *(const uint4*)(smem + r * 528 + ch * 16);
        const float ma = (ta < hi_ok) ? 1.f : 0.f;
        const float mr = (tr >= lo_ok && i > 0) ? -1.f : 0.f;
        EP_ACC(va, ma);
        EP_ACC(vr, mr);
        const int lo = max(r - hw, seqlo), hi = min(r + w - hw, seqhi);
        if (lo >= 0 && hi <= 256) {
          const float rc = 1.f / (float)(hi - lo);
          uint4 o;
          o.x = pack2(sm[0] * rc - bflo(cv.x), sm[1] * rc - bfhi(cv.x));
          o.y = pack2(sm[2] * rc - bflo(cv.y), sm[3] * rc - bfhi(cv.y));
          o.z = pack2(sm[4] * rc - bflo(cv.z), sm[5] * rc - bfhi(cv.z));
          o.w = pack2(sm[6] * rc - bflo(cv.w), sm[7] * rc - bfhi(cv.w));
          *(uint4*)(Dd + (size_t)(t0 + r) * 1024 + f0 + ch * 8) = o;
        }
      }
    }
  }
}

constexpr int P3_NA = 1024, P3_CTX = 512, P3_CONV = 1536, P3_ITEMS = P3_NA + P3_CTX + P3_CONV;

typedef float f32x2 __attribute__((ext_vector_type(2)));
DI void conv_item(const P& p, int it, char* smem) {
  const int tid = (threadIdx.x & 255), lane = tid & 63, wave = tid >> 6;
  const int t0 = it * 16;
  const int c = 2 * tid;
  const u16* UP = (const u16*)(p.ws + WS_UP) + (size_t)(prow(t0) - 15) * 512 + c;
  const u16* SGA = (const u16*)(p.ws + WS_R1 + HALF_R);
  u16* Z = (u16*)(p.ws + WS_R0);
  float* ylds = (float*)smem;
  f32x2 w[31];
#pragma unroll
  for (int j = 0; j < 31; ++j) w[j] = *(const f32x2*)(p.conv_w + j * 512 + c);
  const f32x2 cb = *(const f32x2*)(p.conv_b + c);
  unsigned uv[46];
#pragma unroll
  for (int r = 0; r < 46; ++r) uv[r] = *(const unsigned*)(UP + r * 512);
#pragma unroll
  for (int grp = 0; grp < 2; ++grp) {
    f32x2 y[8];
#pragma unroll
    for (int i = 0; i < 8; ++i) y[i] = cb;
#pragma unroll
    for (int r = 0; r < 38; ++r) {
      const unsigned v = uv[grp * 8 + r];
      f32x2 vv; vv.x = bflo(v); vv.y = bfhi(v);
#pragma unroll
      for (int i = 0; i < 8; ++i) {
        const int j = r - i;
        if (j >= 0 && j <= 30) y[i] = __builtin_elementwise_fma(vv, w[j], y[i]);
      }
    }
#pragma unroll
    for (int i = 0; i < 8; ++i) *(f32x2*)(ylds + (grp * 8 + i) * 512 + c) = y[i];
  }
  __syncthreads();
  const int c1 = lane * 4, c2 = 256 + lane * 4;
  const float4 g1 = *(const float4*)(p.ln_g + c1), g2 = *(const float4*)(p.ln_g + c2);
  const float4 b1 = *(const float4*)(p.ln_b + c1), b2 = *(const float4*)(p.ln_b + c2);
#pragma unroll
  for (int tt = 0; tt < 4; ++tt) {
    const int tl = wave * 4 + tt, tok = t0 + tl;
    const float4 a = *(const float4*)(ylds + tl * 512 + c1), b = *(const float4*)(ylds + tl * 512 + c2);
    float s1 = a.x + a.y + a.z + a.w + b.x + b.y + b.z + b.w;
    float s2 = a.x * a.x + a.y * a.y + a.z * a.z + a.w * a.w + b.x * b.x + b.y * b.y + b.z * b.z + b.w * b.w;
#pragma unroll
    for (int o = 32; o >= 1; o >>= 1) { s1 += __shfl_xor(s1, o); s2 += __shfl_xor(s2, o); }
    const float mean = s1 * (1.f / 512.f);
    const float var = fmaxf(s2 * (1.f / 512.f) - mean * mean, 0.f);
    const float rstd = rsqrtf(var + EPS);
    const uint2 ga1 = *(const uint2*)(SGA + (size_t)tok * 512 + c1), ga2 = *(const uint2*)(SGA + (size_t)tok * 512 + c2);
    uint2 o1, o2;
    o1.x = pack2(silu_f((a.x - mean) * rstd * g1.x + b1.x) * bflo(ga1.x), silu_f((a.y - mean) * rstd * g1.y + b1.y) * bfhi(ga1.x));
    o1.y = pack2(silu_f((a.z - mean) * rstd * g1.z + b1.z) * bflo(ga1.y), silu_f((a.w - mean) * rstd * g1.w + b1.w) * bfhi(ga1.y));
    o2.x = pack2(silu_f((b.x - mean) * rstd * g2.x + b2.x) * bflo(ga2.x), silu_f((b.y - mean) * rstd * g2.y + b2.y) * bfhi(ga2.x));
    o2.y = pack2(silu_f((b.z - mean) * rstd * g2.z + b2.z) * bflo(ga2.y), silu_f((b.w - mean) * rstd * g2.w + b2.w) * bfhi(ga2.y));
    *(uint2*)(Z + (size_t)tok * 1024 + c1) = o1;
    *(uint2*)(Z + (size_t)tok * 1024 + c2) = o2;
  }
}

constexpr int ACH = 64 * LROW;
constexpr int ABUF = 2 * ACH;

DI void attn_item(const P& p, int it, char* smem) {
  const int tid = (threadIdx.x & 255), lane = tid & 63, wave = tid >> 6, l31 = lane & 31, hh = lane >> 5;
  const bool is_na = it < P3_NA;
  const u16* Qb = (const u16*)(p.ws + WS_R2);
  const u16* Kb = (const u16*)(p.ws + WS_R2 + HALF_R);
  const u16* VT = (const u16*)(p.ws + WS_R3);
  const u16* SGB = (const u16*)(p.ws + WS_R3 + HALF_R);
  const u16* KC = (const u16*)(p.ws + WS_KC);
  const u16* VTC = (const u16*)(p.ws + WS_VTC);
  u16* Z = (u16*)(p.ws + WS_R0);
  int b, head, qtok, nchunks, tokbase;
  int r = 0, c = 0, qcs = 0, rsw = 0, rs_lo = 0;
  if (is_na) {
    const int vb = it & 511;
    head = (vb >> 1) & 7; b = 2 * (it >> 9) + (vb & 1); const int r0 = 2 * (vb >> 4);
    r = r0 + (wave >> 1); c = (wave & 1) * 32 + l31;
    qcs = min(max(c - 8, 0), 48);
    rsw = min(max(r - 4, 0), 56);
    rs_lo = min(max(r0 - 4, 0), 56);
    const int rs_hi = min(max(r0 - 3, 0), 56);
    tokbase = TP + b * 4096;
    qtok = tokbase + r * 64 + c;
    nchunks = 8 + rs_hi + 8 - rs_lo;
  } else {
    const int j = it - P3_NA;
    b = j >> 4; head = (j >> 1) & 7;
    tokbase = b * 256;
    qtok = tokbase + (j & 1) * 128 + wave * 32 + l31;
    nchunks = 4;
  }
  float* rpb_s = (float*)(smem + 2 * ABUF);
  if (is_na) for (int i = tid; i < 465; i += 256) rpb_s[i] = p.rpb[head * 465 + i] * 1.4426950408889634f;

  bf16x8 qf[4];
#pragma unroll
  for (int ks = 0; ks < 4; ++ks) qf[ks] = *(const bf16x8*)(Qb + (size_t)qtok * 512 + head * 64 + ks * 16 + hh * 8);

  f32x16 o0, o1;
#pragma unroll
  for (int i = 0; i < 16; ++i) { o0[i] = 0.f; o1[i] = 0.f; }
  float m_run = -INFINITY, l_run = 0.f;

  const int prow = tid >> 3, ppart = tid & 7;
  const int vpos0 = (16 * (ppart >> 1) + 4 * (ppart & 1)) * 2, vpos1 = vpos0 + 16;
  uint4 kreg0, kreg1, vreg0, vreg1;
#define LOAD_CHUNK(ci_) do { \
    const int ci__ = (ci_); const u16 *kp, *vp; size_t ks_, vs_; \
    if (is_na && ci__ < 8) { \
      kp = KC + ((size_t)(b * 8 + head) * 512 + ci__ * 64) * 64; ks_ = 64; \
      vp = VTC + ((size_t)(b * 8 + head) * 8 + ci__) * 4096; vs_ = 64; \
    } else { \
      const int kt0 = is_na ? (tokbase + (rs_lo + ci__ - 8) * 64) : (tokbase + ci__ * 64); \
      kp = Kb + ((size_t)head * TT + kt0) * 64; ks_ = 64; \
      vp = VT + ((size_t)head * (TT / 64) + (kt0 >> 6)) * 4096; vs_ = 64; \
    } \
    kreg0 = *(const uint4*)(kp + (size_t)prow * ks_ + ppart * 8); \
    kreg1 = *(const uint4*)(kp + (size_t)(prow + 32) * ks_ + ppart * 8); \
    vreg0 = *(const uint4*)(vp + (size_t)prow * vs_ + ppart * 8); \
    vreg1 = *(const uint4*)(vp + (size_t)(prow + 32) * vs_ + ppart * 8); \
  } while (0)
#define STORE_CHUNK(buf_) do { \
    char* bb_ = (buf_); \
    *(uint4*)(bb_ + prow * LROW + ppart * 16) = kreg0; \
    *(uint4*)(bb_ + (prow + 32) * LROW + ppart * 16) = kreg1; \
    char* vr0 = bb_ + ACH + prow * LROW; char* vr1 = bb_ + ACH + (prow + 32) * LROW; \
    *(uint2*)(vr0 + vpos0) = make_uint2(vreg0.x, vreg0.y); *(uint2*)(vr0 + vpos1) = make_uint2(vreg0.z, vreg0.w); \
    *(uint2*)(vr1 + vpos0) = make_uint2(vreg1.x, vreg1.y); *(uint2*)(vr1 + vpos1) = make_uint2(vreg1.z, vreg1.w); \
  } while (0)
  LOAD_CHUNK(0);
  STORE_CHUNK(smem);
  LOAD_CHUNK(1);
  for (int ci = 0; ci < nchunks; ++ci) {
    const char* cur = smem + (ci & 1) * ABUF;
    __syncthreads();
    STORE_CHUNK(smem + ((ci + 1) & 1) * ABUF);
    LOAD_CHUNK(min(ci + 2, nchunks - 1));
    __builtin_amdgcn_sched_barrier(0);
    bool act = true, window = false; int rowidx = 0;
    if (is_na && ci >= 8) { const int kr = rs_lo + ci - 8; act = (kr >= rsw) && (kr < rsw + 8); window = true; rowidx = kr - r + 7; }
    if (act) {
      f32x16 sa, sb;
#pragma unroll
      for (int i = 0; i < 16; ++i) { sa[i] = 0.f; sb[i] = 0.f; }
#pragma unroll
      for (int ks = 0; ks < 4; ++ks) {
        const bf16x8 ka = *(const bf16x8*)(cur + l31 * LROW + ks * 32 + hh * 16);
        const bf16x8 kb2 = *(const bf16x8*)(cur + (32 + l31) * LROW + ks * 32 + hh * 16);
        sa = MFMA(ka, qf[ks], sa);
        sb = MFMA(kb2, qf[ks], sb);
      }
      if (window) {
        const int kb = 4 * hh;
        const float* rp = rpb_s + rowidx * 31 + (kb - c + 15);
        const int kq = kb - qcs;
#pragma unroll
        for (int i = 0; i < 16; ++i) {
          const int co = (i & 3) + 8 * (i >> 2);
          sa[i] = ((unsigned)(kq + co) < 16u) ? (sa[i] + rp[co]) : -INFINITY;
          sb[i] = ((unsigned)(kq + 32 + co) < 16u) ? (sb[i] + rp[32 + co]) : -INFINITY;
        }
      }
      float mx = fmaxf(sa[0], sb[0]);
#pragma unroll
      for (int i = 1; i < 16; ++i) mx = fmaxf(mx, fmaxf(sa[i], sb[i]));
      mx = fmaxf(mx, __shfl_xor(mx, 32));
      if (__any(mx > m_run + 8.f)) {
        const float m_new = fmaxf(m_run, mx);
        const float alpha = __builtin_amdgcn_exp2f(m_run - m_new);
        m_run = m_new;
        l_run *= alpha;
#pragma unroll
        for (int i = 0; i < 16; ++i) { o0[i] *= alpha; o1[i] *= alpha; }
      }
      float ps = 0.f;
#pragma unroll
      for (int i = 0; i < 16; ++i) { sa[i] = __builtin_amdgcn_exp2f(sa[i] - m_run); sb[i] = __builtin_amdgcn_exp2f(sb[i] - m_run); ps += sa[i] + sb[i]; }
      l_run += ps;
#pragma unroll
      for (int kt = 0; kt < 2; ++kt)
#pragma unroll
        for (int sidx = 0; sidx < 2; ++sidx) {
          union { unsigned u[4]; bf16x8 v; } pb;
#pragma unroll
          for (int q2 = 0; q2 < 4; ++q2) pb.u[q2] = kt ? pack2(sb[8 * sidx + 2 * q2], sb[8 * sidx + 2 * q2 + 1]) : pack2(sa[8 * sidx + 2 * q2], sa[8 * sidx + 2 * q2 + 1]);
          const bf16x8 a0 = *(const bf16x8*)(cur + ACH + l31 * LROW + (kt * 32 + 16 * sidx + 8 * hh) * 2);
          const bf16x8 a1 = *(const bf16x8*)(cur + ACH + (32 + l31) * LROW + (kt * 32 + 16 * sidx + 8 * hh) * 2);
          o0 = MFMA(a0, pb.v, o0);
          o1 = MFMA(a1, pb.v, o1);
        }
    }
    __builtin_amdgcn_sched_barrier(0);
  }
  const float lt = l_run + __shfl_xor(l_run, 32);
  const float inv = 1.f / lt;
  swap32v(o0, o1);
  {
    const u16* sgp = SGB + (size_t)qtok * 512 + head * 64 + 32 * hh;
    u16* zp = Z + (size_t)qtok * 1024 + 512 + head * 64 + 32 * hh;
#pragma unroll
    for (int g = 0; g < 4; ++g) {
      const uint4 sg = *(const uint4*)(sgp + 8 * g);
      uint4 ov;
      ov.x = pack2(o0[4 * g] * inv * bflo(sg.x), o0[4 * g + 1] * inv * bfhi(sg.x));
      ov.y = pack2(o0[4 * g + 2] * inv * bflo(sg.y), o0[4 * g + 3] * inv * bfhi(sg.y));
      ov.z = pack2(o1[4 * g] * inv * bflo(sg.z), o1[4 * g + 1] * inv * bfhi(sg.z));
      ov.w = pack2(o1[4 * g + 2] * inv * bflo(sg.w), o1[4 * g + 3] * inv * bfhi(sg.w));
      *(uint4*)(zp + 8 * g) = ov;
    }
  }
}

DI void pool_item(const P& p, int it) {
  const int tid = (threadIdx.x & 255);
  const int t0 = it * 32 + (tid >> 7) * 16;
  int s0, s1;
  if (t0 < TP) { s0 = t0 & ~255; s1 = s0 + 256; } else { s0 = TP + ((t0 - TP) & ~4095); s1 = s0 + 4096; }
  const int c = (tid & 127) * 8;
  const int w = 2 << (c >> 8), hw = w >> 1;
  const u16* U1 = (const u16*)(p.ws + WS_R0);
  u16* Dd = (u16*)(p.ws + WS_R3);
  float sm[8];
#pragma unroll
  for (int k = 0; k < 8; ++k) sm[k] = 0.f;
#define POOL_ACC(v_, m_) do { \
    sm[0] += (m_) * bflo((v_).x); sm[1] += (m_) * bfhi((v_).x); sm[2] += (m_) * bflo((v_).y); sm[3] += (m_) * bfhi((v_).y); \
    sm[4] += (m_) * bflo((v_).z); sm[5] += (m_) * bfhi((v_).z); sm[6] += (m_) * bflo((v_).w); sm[7] += (m_) * bfhi((v_).w); } while (0)
#pragma unroll
  for (int j = 0; j < 15; ++j) {
    const int t = t0 - hw + j;
    const uint4 v = *(const uint4*)(U1 + (size_t)min(max(t, s0), s1 - 1) * 1024 + c);
    const float mk = (j < w - 1 && t >= s0 && t < s1) ? 1.f : 0.f;
    POOL_ACC(v, mk);
  }
#pragma unroll 8
  for (int i = 0; i < 16; ++i) {
    const int t = t0 + i;
    const int ta = t + w - hw - 1, tr = t - hw - 1;
    const uint4 va = *(const uint4*)(U1 + (size_t)min(max(ta, s0), s1 - 1) * 1024 + c);
    const uint4 vr = *(const uint4*)(U1 + (size_t)min(max(tr, s0), s1 - 1) * 1024 + c);
    const uint4 cv = *(const uint4*)(U1 + (size_t)t * 1024 + c);
    const float ma = (ta < s1) ? 1.f : 0.f;
    const float mr = (tr >= s0 && i > 0) ? -1.f : 0.f;
    POOL_ACC(va, ma);
    POOL_ACC(vr, mr);
    const int lo = max(t - hw, s0), hi = min(t + w - hw, s1);
    const float rc = 1.f / (float)(hi - lo);
    uint4 o;
    o.x = pack2(sm[0] * rc - bflo(cv.x), sm[1] * rc - bfhi(cv.x));
    o.y = pack2(sm[2] * rc - bflo(cv.y), sm[3] * rc - bfhi(cv.y));
    o.z = pack2(sm[4] * rc - bflo(cv.z), sm[5] * rc - bfhi(cv.z));
    o.w = pack2(sm[6] * rc - bflo(cv.w), sm[7] * rc - bfhi(cv.w));
    *(uint4*)(Dd + (size_t)t * 1024 + c) = o;
  }
}

#define XB_TMO      128
#define XB_XCNT(j)  (256  + 64 * (j))
#define XB_XSUB(j)  (1280 + 64 * (j))
#define XB_XGEN(j)  (2304 + 64 * (j))
#define XB_TOP      3328
#define XB_TOPGEN   3392
#define XCD_BAR_WORDS 3456
#define XB_SPIN_CAP (1u << 22)
#define LAS __attribute__((address_space(3)))
DI unsigned xb_ld(unsigned* p)              { return __hip_atomic_load(p, __ATOMIC_RELAXED, __HIP_MEMORY_SCOPE_AGENT); }
DI unsigned xb_add(unsigned* p, unsigned v) { return __hip_atomic_fetch_add(p, v, __ATOMIC_RELAXED, __HIP_MEMORY_SCOPE_AGENT); }
DI unsigned xb_xcc_id() { return (unsigned)__builtin_amdgcn_s_getreg((3 << 11) | 20) & 0xFu; }
#define XB_SPIN(cond, bar) do { unsigned _sp = 0; while (cond) { __builtin_amdgcn_s_sleep(1); \
    if ((++_sp & 255u) == 0u) { if (xb_ld(&(bar)[XB_TMO])) break; if (_sp > XB_SPIN_CAP) { atomicAdd(&(bar)[XB_TMO], 1u); break; } } } } while (0)
struct XcdBarrier { unsigned* bar; unsigned x; volatile LAS unsigned* st; };
DI XcdBarrier xcd_barrier_post(unsigned* bar, volatile LAS unsigned* st) {
  XcdBarrier b; b.bar = bar; b.x = xb_xcc_id(); b.st = st;
  if (threadIdx.x == 0) (void)xb_add(&bar[XB_XCNT(b.x)], 1u);
  return b;
}
DI void xcd_barrier_complete(unsigned* bar, unsigned x, unsigned& nloc, unsigned& nx) {
  const unsigned G = gridDim.x * gridDim.y * gridDim.z;
  unsigned sum, cnt, mine, sp = 0u;
  for (;;) {
    sum = 0u; cnt = 0u; mine = 0u;
#pragma unroll
    for (unsigned j = 0; j < 16; ++j) { const unsigned c = xb_ld(&bar[XB_XCNT(j)]); sum += c; cnt += (c > 0u) ? 1u : 0u; mine = (j == x) ? c : mine; }
    if (sum == G) break;
    __builtin_amdgcn_s_sleep(1);
    if ((++sp & 255u) == 0u) { if (xb_ld(&bar[XB_TMO])) break; if (sp > XB_SPIN_CAP) { atomicAdd(&bar[XB_TMO], 1u); break; } }
  }
  nloc = mine > 0u ? mine : 1u; nx = cnt > 0u ? cnt : 1u;
}
DI void xcd_barrier(const XcdBarrier& b) {
  asm volatile("s_waitcnt vmcnt(0)" ::: "memory");
  __syncthreads();
  if (threadIdx.x == 0) {
    unsigned* bar = b.bar;
    __builtin_amdgcn_s_waitcnt(0);
    unsigned nloc = b.st[0], nx = b.st[1];
    if (nloc == 0u) { xcd_barrier_complete(bar, b.x, nloc, nx); b.st[0] = nloc; b.st[1] = nx; }
    const unsigned old = xb_add(&bar[XB_XSUB(b.x)], 1u);
    const unsigned gen = old / nloc;
    if (old + 1u == (gen + 1u) * nloc) {
      __builtin_amdgcn_fence(__ATOMIC_RELEASE, "agent");
      asm volatile("s_waitcnt vmcnt(0)" ::: "memory");
      const unsigned og = xb_add(&bar[XB_TOP], 1u);
      const unsigned tg = og / nx;
      if (og + 1u == (tg + 1u) * nx) xb_add(&bar[XB_TOPGEN], 1u);
      else XB_SPIN(xb_ld(&bar[XB_TOPGEN]) == tg, bar);
      __builtin_amdgcn_fence(__ATOMIC_ACQUIRE, "agent");
      xb_add(&bar[XB_XGEN(b.x)], 1u);
      asm volatile("s_waitcnt vmcnt(0)" ::: "memory");
    } else {
      XB_SPIN(xb_ld(&bar[XB_XGEN(b.x)]) == gen, bar);
      __builtin_amdgcn_fence(__ATOMIC_ACQUIRE, "agent");
      asm volatile("s_waitcnt vmcnt(0)" ::: "memory");
    }
  }
  __syncthreads();
}

constexpr int N_PHASES = 10;
#define PHASE_G(k, n, call) \
  if (p.ph_lo <= (k) && (k) < p.ph_hi) { \
    for (int it = blockIdx.x; it < (n); it += gridDim.x) { __syncthreads(); call; } \
  }
#define PHASE_H(k, n, call) \
  if (p.ph_lo <= (k) && (k) < p.ph_hi) { \
    for (int it = 2 * blockIdx.x + half; it < (n); it += 2 * gridDim.x) { __syncthreads(); call; } \
  }
#define SEAM(k) \
  if (p.ph_lo <= (k) && (k) + 1 < p.ph_hi) { if (p.ph_hi > 1000) grid.sync(); xcd_barrier(xb); }

__global__ void __launch_bounds__(512, 2) mega(P p) {
  __shared__ __attribute__((aligned(16))) char smem[SMEM_BYTES + 16];
  cg::grid_group grid = cg::this_grid();
  volatile LAS unsigned* xst = (volatile LAS unsigned*)(smem + SMEM_BYTES);
  if (threadIdx.x == 0) { xst[0] = 0u; xst[1] = 0u; }
  __syncthreads();
  XcdBarrier xb = xcd_barrier_post((unsigned*)(p.ws + WS_BAR), xst);
  const int half = threadIdx.x >> 8;
  char* hsm = smem + half * HALF_SMEM;
  PHASE_H(0, P0_ITEMS, p0_item(p, it, hsm))
  SEAM(0)
  PHASE_H(1, 256, p0_item(p, it, hsm, 1))
  PHASE_H(1, 1536, modnorm_item(p, it, 0))
  SEAM(1)
  PHASE_G(2, 14 * 128, gemm_item<1>(p, it, smem))
  SEAM(2)
  if (!(p.flags & 1)) { PHASE_H(3, P3_NA + P3_CTX, attn_item(p, it, hsm)) }
  if (!(p.flags & 2)) { PHASE_H(3, P3_CONV, conv_item(p, it, hsm)) }
  SEAM(3)
  PHASE_G(4, 4 * 192, gemm_item<2>(p, it, smem))
  if (p.ph_lo <= 4 && 6 < p.ph_hi) { if (p.ph_hi > 1000) grid.sync(); xcd_barrier(xb); }
  PHASE_G(6, 8 * 96, gemm_item<3>(p, it, smem))
  if (p.ph_lo <= 6 && 8 < p.ph_hi) { if (p.ph_hi > 1000) grid.sync(); xcd_barrier(xb); }
  PHASE_G(8, 4 * 192, gemm_item<4>(p, it, smem))
  SEAM(8)
  PHASE_G(9, 4 * 192, gemm_item<5>(p, it, smem))
}

extern "C" void kernel_launch(void* const* d_in, const int* in_sizes, int n_in, void* d_out, int out_size, void* d_ws, size_t ws_size, hipStream_t stream) {
  static int grid_blocks = 0;
  if (!grid_blocks) {
    int dev = 0, cus = 0, per_cu = 0;
    hipGetDevice(&dev);
    hipDeviceGetAttribute(&cus, hipDeviceAttributeMultiprocessorCount, dev);
    hipOccupancyMaxActiveBlocksPerMultiprocessor(&per_cu, mega, 512, 0);
    per_cu = 1;
    grid_blocks = cus * per_cu;
    if (ws_size < WS_END) fprintf(stderr, "kernel_launch: workspace too small: %zu < %zu\n", ws_size, (size_t)WS_END);
  }
  P p{};
  const float** f = (const float**)&p;
  for (int i = 0; i < 25; ++i) f[i] = (const float*)d_in[i];
  p.out = (float*)d_out;
  p.ws = (char*)d_ws;
#if MK_MULTI
  for (int ph = 0; ph < N_PHASES; ++ph) {
    p.ph_lo = ph; p.ph_hi = ph + 1;
#ifdef PROBE_PH
    if (ph == PROBE_PH) { p.flags = PROBE_FLAGS; for (int rr = 0; rr < PROBE_N; ++rr) hipLaunchKernelGGL(mega, dim3(grid_blocks), dim3(512), 0, stream, p); p.flags = 0; }
#endif
    hipLaunchKernelGGL(mega, dim3(grid_blocks), dim3(512), 0, stream, p);
  }
#else
  p.ph_lo = 0; p.ph_hi = N_PHASES;
  hipMemsetAsync((char*)d_ws + WS_BAR, 0, XCD_BAR_WORDS * 4, stream);
  void* args[] = {&p};
  hipError_t e = hipLaunchCooperativeKernel((void*)mega, dim3(grid_blocks), dim3(512), args, 0, stream);
  if (e != hipSuccess) fprintf(stderr, "cooperative launch failed: %s (grid %d)\n", hipGetErrorString(e), grid_blocks);
#endif
}
```
